# Optimizing an MI355X kernel written in HIP

```python
import math
import jax, jax.numpy as jnp
from jax import lax
import numpy as np

D_MODEL = 2048
BATCH = 2
SEQ = 16384
DEPTH = 2

N_MIXERS = 4
GROUP_W = D_MODEL // N_MIXERS
HEAD_DIM = 64
N_HEADS = GROUP_W // HEAD_DIM
N_KV_HEADS = 2
GQA_GROUP = N_HEADS // N_KV_HEADS
KV_W = N_KV_HEADS * HEAD_DIM
SHORT_CONV = 3
GDN_CHUNK = 64
HY_ORDER = 2
HY_EMB = 33
HY_BANDS = (HY_EMB - 1) // 2
HY_FFN = 64
HY_DECAY_TARGET = 1e-2
HY_FAST_DECAY = 0.3
HY_SLOW_DECAY = 1.5
WINDOW = 128
BLOCK = 128
GRID_W = 64
ROPE_THETA = 10000.0
N_EXPERT_GROUPS = 4
EXPERTS_PER_GROUP = 8
N_EXPERTS = N_EXPERT_GROUPS * EXPERTS_PER_GROUP
TOP_K = 2
D_EXPERT = 512
MOE_BLOCK = 128
EPS = 1e-6
IN_SPLIT_SIZES = (3 * GROUP_W, GROUP_W, 2 * N_HEADS, 2 * N_HEADS, 3 * GROUP_W,
                  GROUP_W, 2 * KV_W, GROUP_W, 2 * KV_W)
D_IN = sum(IN_SPLIT_SIZES)

kernel_name = 'hybrid_parallel_heads_encoder'


def _split_points():
    return [int(v) for v in np.cumsum(IN_SPLIT_SIZES)[:-1]]


def rmsnorm(x, g):
    xf = x.astype(jnp.float32)
    y = xf * lax.rsqrt(jnp.mean(xf * xf, axis=-1, keepdims=True) + EPS)
    return (y * g.astype(jnp.float32)).astype(x.dtype)


def l2norm(x):
    return x * lax.rsqrt(jnp.sum(x * x, axis=-1, keepdims=True) + EPS)


def short_conv(u, w):
    k_w = w.shape[0]
    p = k_w // 2
    s_len = u.shape[1]
    up = jnp.pad(u, ((0, 0), (p, p), (0, 0)))
    out = up[:, 0:s_len] * w[0]
    for j in range(1, k_w):
        out = out + up[:, j:j + s_len] * w[j]
    return out


def gdn_chunked(q, k, v, beta, g):
    b_, s_, h_, dk = q.shape
    dv = v.shape[-1]
    c = GDN_CHUNK
    n = s_ // c

    def chunks(t):
        return t.reshape(b_, n, c, h_, -1).transpose(0, 3, 1, 2, 4)

    q = chunks(q) * (dk ** -0.5)
    k = chunks(k)
    v = chunks(v)
    beta = beta.reshape(b_, n, c, h_).transpose(0, 3, 1, 2)
    gc = jnp.cumsum(g.reshape(b_, n, c, h_).transpose(0, 3, 1, 2), axis=-1)
    idx = jnp.arange(c)
    incl = idx[:, None] >= idx[None, :]
    strict = idx[:, None] > idx[None, :]
    decay = jnp.exp(jnp.where(incl, gc[..., :, None] - gc[..., None, :], -jnp.inf))
    kb = k * beta[..., None]
    a_strict = jnp.where(strict, jnp.einsum('bhnid,bhnjd->bhnij', kb, k) * decay, 0.0)
    rhs = jnp.concatenate([v * beta[..., None], kb * jnp.exp(gc)[..., None]], axis=-1)
    sol = lax.linalg.triangular_solve(a_strict, rhs, left_side=True, lower=True,
                                      unit_diagonal=True)
    value, k_cumdecay = sol[..., :dv], sol[..., dv:]
    attn = jnp.einsum('bhnid,bhnjd->bhnij', q, k) * decay
    q_dec = q * jnp.exp(gc)[..., None]
    k_dec = k * jnp.exp(gc[..., -1:] - gc)[..., None]
    chunk_dec = jnp.exp(gc[..., -1])

    def step(state, xs):
        value_n, kcd_n, attn_n, qd_n, kd_n, cd_n = xs
        v_new = value_n - jnp.einsum('bhck,bhkv->bhcv', kcd_n, state)
        o = (jnp.einsum('bhck,bhkv->bhcv', qd_n, state)
             + jnp.einsum('bhij,bhjv->bhiv', attn_n, v_new))
        state = state * cd_n[..., None, None] + jnp.einsum('bhck,bhcv->bhkv', kd_n, v_new)
        return state, o

    xs = tuple(jnp.moveaxis(t, 2, 0) for t in (value, k_cumdecay, attn, q_dec, k_dec, chunk_dec))
    state0 = jnp.zeros((b_, h_, dk, dv), jnp.float32)
    _, o = lax.scan(step, state0, xs)
    return o.transpose(1, 0, 3, 2, 4).reshape(b_, s_, h_, dv)


def gdn_mixer(qkv, z, b_in, a_in, conv_w, a_log, dt_bias, norm_g):
    b_, s_, _ = qkv.shape
    dtype = qkv.dtype
    qkv = jax.nn.silu(short_conv(qkv, conv_w)).astype(jnp.float32)
    q, k, v = jnp.split(qkv, 3, axis=-1)
    q = l2norm(q.reshape(b_, s_, N_HEADS, HEAD_DIM))
    k = l2norm(k.reshape(b_, s_, N_HEADS, HEAD_DIM))
    v = v.reshape(b_, s_, N_HEADS, HEAD_DIM)
    b_in = b_in.astype(jnp.float32).reshape(b_, s_, 2, N_HEADS)
    a_in = a_in.astype(jnp.float32).reshape(b_, s_, 2, N_HEADS)
    beta = jax.nn.sigmoid(b_in)
    g = -jnp.exp(a_log.astype(jnp.float32)) * jax.nn.softplus(a_in + dt_bias.astype(jnp.float32))
    flip = lambda t: jnp.flip(t, axis=1)
    o_fwd = gdn_chunked(q, k, v, beta[:, :, 0], g[:, :, 0])
    o_bwd = flip(gdn_chunked(flip(q), flip(k), flip(v), flip(beta[:, :, 1]), flip(g[:, :, 1])))
    o = o_fwd + o_bwd
    zg = jax.nn.silu(z.astype(jnp.float32)).reshape(b_, s_, N_HEADS, HEAD_DIM)
    o = rmsnorm(o, norm_g) * zg
    return o.reshape(b_, s_, GROUP_W).astype(dtype)


def hyena_pos_features(length):
    t = jnp.linspace(0.0, 1.0, length, dtype=jnp.float32)[:, None]
    w = 2.0 * math.pi * jnp.arange(length, dtype=jnp.float32) / length
    f = jnp.linspace(1e-4, HY_BANDS - 1, HY_BANDS, dtype=jnp.float32)
    fw = w[:, None] * f[None, :]
    return jnp.concatenate([t, jnp.cos(fw), -jnp.sin(fw)], axis=-1)


def hyena_filters_f(z, w1, b1, f1, w2, b2, f2, w3, deltas):
    f32 = jnp.float32
    length = z.shape[0]
    t = z[:, :1]
    h = jnp.sin(f1.astype(f32) * (z @ w1.astype(f32) + b1.astype(f32)))
    h = jnp.sin(f2.astype(f32) * (h @ w2.astype(f32) + b2.astype(f32)))
    h = (h @ w3.astype(f32)) * jnp.exp(-t * jnp.abs(deltas.astype(f32)))
    h = h.reshape(length, HY_ORDER, 2, GROUP_W)
    kern = jnp.concatenate([h[:, :, 0], jnp.zeros((1, HY_ORDER, GROUP_W), f32),
                            h[:0:-1, :, 1]], axis=0)
    kern = kern / (jnp.sum(jnp.abs(kern), axis=0, keepdims=True) + EPS)
    return jnp.fft.rfft(kern, axis=0)


def fft_conv(u, kf, bias):
    length = u.shape[1]
    uf = jnp.fft.rfft(u, n=2 * length, axis=1)
    y = jnp.fft.irfft(uf * kf[None], n=2 * length, axis=1)[:, :length]
    return y + u * bias


def hyena_mixer(u, conv_w, kf, bias, norm_g):
    dtype = u.dtype
    u = short_conv(u, conv_w).astype(jnp.float32)
    x1, x2, v = jnp.split(u, 3, axis=-1)
    bias = bias.astype(jnp.float32)
    y = x1 * fft_conv(v, kf[:, 0], bias[0])
    y = x2 * fft_conv(y, kf[:, 1], bias[1])
    return rmsnorm(y.astype(dtype), norm_g)


def alibi_slopes(n):
    return 2.0 ** (-8.0 * jnp.arange(1, n + 1, dtype=jnp.float32) / n)


def window_mixer(c_q, c_kv, sink, slopes, norm_g):
    b_, s_, _ = c_q.shape
    nb = s_ // BLOCK
    q = c_q.reshape(b_, nb, BLOCK, N_KV_HEADS, GQA_GROUP, HEAD_DIM)
    k, v = jnp.split(c_kv, 2, axis=-1)

    def band(t):
        tp = jnp.pad(t.reshape(b_, s_, N_KV_HEADS, HEAD_DIM), ((0, 0), (BLOCK, BLOCK), (0, 0), (0, 0)))
        tp = tp.reshape(b_, nb + 2, BLOCK, N_KV_HEADS, HEAD_DIM)
        return jnp.concatenate([tp[:, :-2], tp[:, 1:-1], tp[:, 2:]], axis=2)

    kb, vb = band(k), band(v)
    s = jnp.einsum('bnqkgd,bnskd->bnkgqs', q, kb).astype(jnp.float32) * (HEAD_DIM ** -0.5)
    rel = BLOCK + jnp.arange(BLOCK)[:, None] - jnp.arange(3 * BLOCK)[None, :]
    key_pos = jnp.arange(nb)[:, None] * BLOCK - BLOCK + jnp.arange(3 * BLOCK)[None, :]
    valid = (jnp.abs(rel) <= WINDOW)[None] & ((key_pos >= 0) & (key_pos < s_))[:, None, :]
    dist = jnp.abs(rel).astype(jnp.float32)
    logits = s - slopes.reshape(N_KV_HEADS, GQA_GROUP)[None, None, :, :, None, None] * dist
    logits = jnp.where(valid[None, :, None, None], logits, -jnp.inf)
    sink_col = jnp.broadcast_to(
        sink.astype(jnp.float32).reshape(N_KV_HEADS, GQA_GROUP)[None, None, :, :, None, None],
        logits.shape[:-1] + (1,))
    p = jax.nn.softmax(jnp.concatenate([logits, sink_col], axis=-1), axis=-1)[..., :-1]
    o = jnp.einsum('bnkgqs,bnskd->bnqkgd', p.astype(c_q.dtype), vb)
    return rmsnorm(o.reshape(b_, s_, GROUP_W), norm_g)


def rope_1d(x, pos):
    d = x.shape[-1]
    inv = ROPE_THETA ** (-jnp.arange(0, d, 2, dtype=jnp.float32) / d)
    ang = pos.astype(jnp.float32)[:, None] * inv[None, :]
    cos = jnp.cos(ang)[None, :, None, :]
    sin = jnp.sin(ang)[None, :, None, :]
    xf = x.astype(jnp.float32)
    x1, x2 = xf[..., :d // 2], xf[..., d // 2:]
    return jnp.concatenate([x1 * cos - x2 * sin, x2 * cos + x1 * sin], axis=-1).astype(x.dtype)


def axial_rope(x, row_idx, col_idx):
    half = HEAD_DIM // 2
    return jnp.concatenate([rope_1d(x[..., :half], row_idx), rope_1d(x[..., half:], col_idx)], axis=-1)


def global_mixer(d_q, d_kv, q_norm_g, k_norm_g, row_idx, col_idx, norm_g):
    b_, s_, _ = d_q.shape
    nb = s_ // BLOCK
    q = d_q.reshape(b_, s_, N_HEADS, HEAD_DIM)
    k, v = jnp.split(d_kv, 2, axis=-1)
    k = k.reshape(b_, s_, N_KV_HEADS, HEAD_DIM)
    v = v.reshape(b_, s_, N_KV_HEADS, HEAD_DIM)
    q = axial_rope(rmsnorm(q, q_norm_g), row_idx, col_idx)
    k = axial_rope(rmsnorm(k, k_norm_g), row_idx, col_idx)
    qb = q.reshape(b_, nb, BLOCK, N_KV_HEADS, GQA_GROUP, HEAD_DIM).transpose(1, 0, 3, 4, 2, 5)
    kt = k.transpose(0, 2, 1, 3)
    vt = v.transpose(0, 2, 1, 3)

    def one_block(q_blk):
        s = jnp.einsum('bkgqd,bksd->bkgqs', q_blk, kt).astype(jnp.float32) * (HEAD_DIM ** -0.5)
        p = jax.nn.softmax(s, axis=-1)
        return jnp.einsum('bkgqs,bksd->bkgqd', p.astype(vt.dtype), vt)

    o = lax.map(one_block, qb)
    o = o.transpose(1, 0, 4, 2, 3, 5).reshape(b_, s_, GROUP_W)
    return rmsnorm(o, norm_g)


def hier_moe(x, w_group, b_group, w_expert, b_expert, w_gate, w_up, w_down):
    b_, s_, d_ = x.shape
    n_tok = b_ * s_
    xt = x.reshape(n_tok, d_)
    gp = jax.nn.softmax((xt @ w_group).astype(jnp.float32) + b_group.astype(jnp.float32), axis=-1)
    g_w, g_idx = lax.top_k(gp, 1)
    elog = (xt @ w_expert).astype(jnp.float32) + b_expert.astype(jnp.float32)
    elog = elog.reshape(n_tok, N_EXPERT_GROUPS, EXPERTS_PER_GROUP)
    elog_sel = elog[jnp.arange(n_tok), g_idx[:, 0]]
    e_w, e_idx = lax.top_k(jax.nn.softmax(elog_sel, axis=-1), TOP_K)
    e_w = e_w / jnp.sum(e_w, axis=-1, keepdims=True)
    weights = (g_w * e_w).reshape(-1)
    experts = (g_idx * EXPERTS_PER_GROUP + e_idx).reshape(-1)
    tokens = jnp.repeat(jnp.arange(n_tok), TOP_K)
    n_assign = n_tok * TOP_K
    order = jnp.argsort(experts)
    e_s, w_s, tok_s = experts[order], weights[order], tokens[order]
    counts = jnp.bincount(experts, length=N_EXPERTS)
    start = jnp.cumsum(counts) - counts
    padded = ((counts + MOE_BLOCK - 1) // MOE_BLOCK) * MOE_BLOCK
    pend = jnp.cumsum(padded)
    pstart = pend - padded
    pos = pstart[e_s] + jnp.arange(n_assign) - start[e_s]
    n_pad = n_assign + N_EXPERTS * MOE_BLOCK
    n_blk = n_pad // MOE_BLOCK
    tok_pad = jnp.zeros((n_pad,), jnp.int32).at[pos].set(tok_s.astype(jnp.int32))
    w_pad = jnp.zeros((n_pad,), jnp.float32).at[pos].set(w_s)
    blk_e = jnp.minimum(jnp.searchsorted(pend, jnp.arange(n_blk) * MOE_BLOCK, side='right'),
                        N_EXPERTS - 1)

    def run_block(args):
        tok_b, w_b, e = args
        xb = xt[tok_b]
        h = jax.nn.silu(xb @ w_gate[e]) * (xb @ w_up[e])
        out = h @ w_down[e]
        return out * w_b[:, None].astype(out.dtype)

    out = lax.map(run_block, (tok_pad.reshape(n_blk, MOE_BLOCK), w_pad.reshape(n_blk, MOE_BLOCK), blk_e))
    y = jnp.zeros((n_tok, d_), x.dtype).at[tok_pad].add(out.reshape(n_pad, d_).astype(x.dtype))
    return y.reshape(b_, s_, d_)


def setup_inputs(seed: int = 0) -> dict:
    key = jax.random.key(seed)
    ks = iter(jax.random.split(key, 40))
    f32 = jnp.float32

    def nrm(shape, scale):
        return scale * jax.random.normal(next(ks), shape, f32)

    def gain(shape):
        return 1.0 + nrm(shape, 0.01)

    dt = jnp.exp(jax.random.uniform(next(ks), (DEPTH, 2, N_HEADS), f32, math.log(1e-3), math.log(1e-1)))
    a_init = jax.random.uniform(next(ks), (DEPTH, 2, N_HEADS), f32, 1.0, 16.0)
    decay_lin = jnp.linspace(-math.log(HY_DECAY_TARGET) / HY_SLOW_DECAY,
                             -math.log(HY_DECAY_TARGET) / HY_FAST_DECAY,
                             HY_ORDER * 2 * GROUP_W, dtype=f32)
    return {
        'x': nrm((BATCH, SEQ, D_MODEL), 1.0),
        'norm_mix': gain((DEPTH, D_MODEL)),
        'w_in': nrm((DEPTH, D_MODEL, D_IN), D_MODEL ** -0.5),
        'gdn_conv': nrm((DEPTH, SHORT_CONV, 3 * GROUP_W), SHORT_CONV ** -0.5),
        'gdn_a_log': jnp.log(a_init),
        'gdn_dt_bias': dt + jnp.log(-jnp.expm1(-dt)),
        'gdn_norm': gain((DEPTH, HEAD_DIM)),
        'hy_conv': nrm((DEPTH, SHORT_CONV, 3 * GROUP_W), SHORT_CONV ** -0.5),
        'hy_w1': nrm((DEPTH, HY_EMB, HY_FFN), HY_EMB ** -0.5),
        'hy_b1': nrm((DEPTH, HY_FFN), 0.1),
        'hy_freq1': gain((DEPTH, HY_FFN)),
        'hy_w2': nrm((DEPTH, HY_FFN, HY_FFN), HY_FFN ** -0.5),
        'hy_b2': nrm((DEPTH, HY_FFN), 0.1),
        'hy_freq2': gain((DEPTH, HY_FFN)),
        'hy_w3': nrm((DEPTH, HY_FFN, HY_ORDER * 2 * GROUP_W), HY_FFN ** -0.5),
        'hy_deltas': decay_lin[None] * (1.0 + nrm((DEPTH, HY_ORDER * 2 * GROUP_W), 0.01)),
        'hy_bias': nrm((DEPTH, HY_ORDER, GROUP_W), 1.0),
        'hy_norm': gain((DEPTH, GROUP_W)),
        'swa_sink': nrm((DEPTH, N_HEADS), 0.5),
        'swa_norm': gain((DEPTH, GROUP_W)),
        'ga_q_norm': gain((DEPTH, HEAD_DIM)),
        'ga_k_norm': gain((DEPTH, HEAD_DIM)),
        'ga_norm': gain((DEPTH, GROUP_W)),
        'w_out': nrm((DEPTH, D_MODEL, D_MODEL), D_MODEL ** -0.5),
        'norm_ffn': gain((DEPTH, D_MODEL)),
        'moe_w_group': nrm((DEPTH, D_MODEL, N_EXPERT_GROUPS), D_MODEL ** -0.5),
        'moe_b_group': nrm((DEPTH, N_EXPERT_GROUPS), 0.01),
        'moe_w_expert': nrm((DEPTH, D_MODEL, N_EXPERTS), D_MODEL ** -0.5),
        'moe_b_expert': nrm((DEPTH, N_EXPERTS), 0.01),
        'moe_w_gate': nrm((DEPTH, N_EXPERTS, D_MODEL, D_EXPERT), D_MODEL ** -0.5),
        'moe_w_up': nrm((DEPTH, N_EXPERTS, D_MODEL, D_EXPERT), D_MODEL ** -0.5),
        'moe_w_down': nrm((DEPTH, N_EXPERTS, D_EXPERT, D_MODEL), D_EXPERT ** -0.5),
        'norm_final': gain((D_MODEL,)),
    }


def reference(x, norm_mix, w_in, gdn_conv, gdn_a_log, gdn_dt_bias, gdn_norm, hy_conv, hy_w1,
              hy_b1, hy_freq1, hy_w2, hy_b2, hy_freq2, hy_w3, hy_deltas, hy_bias, hy_norm,
              swa_sink, swa_norm, ga_q_norm, ga_k_norm, ga_norm, w_out, norm_ffn, moe_w_group,
              moe_b_group, moe_w_expert, moe_b_expert, moe_w_gate, moe_w_up, moe_w_down,
              norm_final):
    b_, s_, _ = x.shape
    rows = s_ // GRID_W
    row_idx = jnp.repeat(jnp.arange(rows), GRID_W)
    col_idx = jnp.tile(jnp.arange(GRID_W), rows)
    pos_feat = hyena_pos_features(s_)
    slopes = alibi_slopes(N_HEADS)
    splits = _split_points()
    for l in range(DEPTH):
        xn = rmsnorm(x, norm_mix[l])
        proj = xn @ w_in[l]
        a_qkv, a_z, a_beta, a_alpha, b_in, c_q, c_kv, d_q, d_kv = jnp.split(proj, splits, axis=-1)
        y_a = gdn_mixer(a_qkv, a_z, a_beta, a_alpha, gdn_conv[l], gdn_a_log[l], gdn_dt_bias[l], gdn_norm[l])
        kf = hyena_filters_f(pos_feat, hy_w1[l], hy_b1[l], hy_freq1[l], hy_w2[l], hy_b2[l],
                             hy_freq2[l], hy_w3[l], hy_deltas[l])
        y_b = hyena_mixer(b_in, hy_conv[l], kf, hy_bias[l], hy_norm[l])
        y_c = window_mixer(c_q, c_kv, swa_sink[l], slopes, swa_norm[l])
        y_d = global_mixer(d_q, d_kv, ga_q_norm[l], ga_k_norm[l], row_idx, col_idx, ga_norm[l])
        x = x + jnp.concatenate([y_a, y_b, y_c, y_d], axis=-1) @ w_out[l]
        x = x + hier_moe(rmsnorm(x, norm_ffn[l]), moe_w_group[l], moe_b_group[l], moe_w_expert[l],
                         moe_b_expert[l], moe_w_gate[l], moe_w_up[l], moe_w_down[l])
    return rmsnorm(x, norm_final)
```

```cpp
#include <hip/hip_runtime.h>
#include <cstdio>
#include <cstdint>
#include <cmath>
namespace pg8 {
#define PG8_LAS __attribute__((address_space(3)))
typedef unsigned short bf16_t;
typedef short bf16x8 __attribute__((ext_vector_type(8)));
typedef float f32x4 __attribute__((ext_vector_type(4)));
typedef unsigned u32x4 __attribute__((ext_vector_type(4)));
constexpr int BM = 256, BK = 64, HALF = 128, HTB = HALF * BK * 2  , STAGE_BYTES = 8 * HTB, NXCD = 8, WGM = 4;

__host__ __device__ __forceinline__ int lds_byte(int r, int c) { const int st = (r >> 4) * 2 + (c >> 5), rr = r & 15, cc = c & 31, ob = rr * 64 + cc * 2; return st * 1024 + (ob ^ (((ob >> 9) & 1) << 5)); }
__host__ __device__ __forceinline__ void stage_rc(int b, int& R, int& C) { const int st = b / 1024, sb = b % 1024, swz = sb ^ (((sb >> 9) & 1) << 5); R = (st >> 1) * 16 + swz / 64; C = (st & 1) * 32 + (swz % 64) / 2; }
__host__ __device__ __forceinline__ int perm32(int rho) { const int n = rho >> 4, i = rho & 15; return 8 * (i >> 2) + 4 * n + (i & 3); }

struct Unit { int pm, pn, pb; };
struct Gemm { const bf16_t* A; const bf16_t* Bt; int M, N, K; };

struct StaticOrder {
    int nM, nN, nwg, G, c;
    __host__ __device__ void init(int M, int N, int G_, int c_) { nM = M / BM; nN = N / BM; nwg = nM * nN; G = G_; c = c_; }
    __host__ __device__ bool next(int i, Unit& u) const {
        const long L = (long)i * G + c; if (L >= nwg) return false;
        int wgid = (int)L; { const int q = nwg / NXCD, r = nwg % NXCD, xcd = wgid % NXCD, off = wgid / NXCD; wgid = (xcd < r ? xcd * (q + 1) : r * (q + 1) + (xcd - r) * q) + off; }
        const int nig = WGM * nN, gid = wgid / nig, fm = gid * WGM, gsz = (nM - fm) < WGM ? (nM - fm) : WGM;
        u.pm = fm + ((wgid % nig) % gsz); u.pn = (wgid % nig) / gsz; u.pb = u.pn; return true;
    }
    __device__ __forceinline__ void a_ready(const Unit&) const {}
    __device__ __forceinline__ void done(const Unit&) const {}
    static constexpr bool GATHER = false;
    __device__ __forceinline__ unsigned arow(const Unit&, int) const { return 0u; }
};

__device__ __forceinline__ unsigned cvt_pk_bf16(float lo, float hi) { unsigned r; asm volatile("v_cvt_pk_bf16_f32 %0, %1, %2" : "=v"(r) : "v"(lo), "v"(hi)); return r; }
typedef float f32x2 __attribute__((ext_vector_type(2)));
__device__ __forceinline__ f32x2 gelu_pk(f32x2 v) {
    const f32x2 av = __builtin_elementwise_abs(v), d = av * 0.2316418882f + 1.0f;
    f32x2 t; t.x = __builtin_amdgcn_rcpf(d.x); t.y = __builtin_amdgcn_rcpf(d.y);
    f32x2 q = t * 0.5307027145f + (-0.7265760135f); q = q * t + 0.7107068705f; q = q * t + (-0.142248368f); q = q * t + 0.127414796f; q = q * t;
    const f32x2 s = (v * v) * (-0.72134752044f);
    f32x2 e; e.x = __builtin_amdgcn_exp2f(s.x); e.y = __builtin_amdgcn_exp2f(s.y);
    const f32x2 m = v * (q * e), r = v - m;
    f32x2 o; o.x = v.x < 0.f ? m.x : r.x; o.y = v.y < 0.f ? m.y : r.y; return o;
}

template <int ACT  > struct EpiBf16 {
    static constexpr bool PERM = true, PERM64 = false, AFTER_DRAIN = false; static_assert(ACT == 0 || ACT == 1, "EpiBf16: ACT is 0 (none) or 1 (gelu_pk)");
    bf16_t* O; int ldc; const float* bias; int split_cols; size_t split_stride; float scale0;
    __device__ __forceinline__ void operator()(const f32x4 (&acc)[2][2][4][2], const Unit& u, int wr, int wc, int fr, int fq) const {
        const int row0 = u.pm * BM + wr * 64 + fr; int colt = u.pn * BM; bf16_t* base = O;
        float sc = 1.f; if (split_cols) { const int t = colt / split_cols; base += (size_t)t * split_stride; colt -= t * split_cols; if (t == 0) sc = scale0; }
        const int col0 = colt + wc * 32 + 8 * fq, bcol0 = u.pn * BM + wc * 32 + 8 * fq;
        f32x4 bv[2][2];
#pragma unroll
        for (int bj = 0; bj < 2; ++bj)
#pragma unroll
            for (int n = 0; n < 2; ++n) bv[bj][n] = bias ? *(const f32x4*)(bias + bcol0 + bj * HALF + 4 * n) : (f32x4){0.f, 0.f, 0.f, 0.f};
#pragma unroll
        for (int ai = 0; ai < 2; ++ai)
#pragma unroll
            for (int m = 0; m < 4; ++m) { bf16_t* rowp = base + (size_t)(row0 + ai * HALF + m * 16) * ldc + col0;
#pragma unroll
                for (int bj = 0; bj < 2; ++bj) { f32x4 v0 = acc[ai][bj][m][0] + bv[bj][0], v1 = acc[ai][bj][m][1] + bv[bj][1];
                    if (ACT == 1) { f32x2 a = gelu_pk((f32x2){v0[0], v0[1]}), b = gelu_pk((f32x2){v0[2], v0[3]}), c = gelu_pk((f32x2){v1[0], v1[1]}), d = gelu_pk((f32x2){v1[2], v1[3]});
                        v0 = (f32x4){a.x, a.y, b.x, b.y}; v1 = (f32x4){c.x, c.y, d.x, d.y}; }
                    v0 = v0 * sc; v1 = v1 * sc; u32x4 w; w.x = cvt_pk_bf16(v0[0], v0[1]); w.y = cvt_pk_bf16(v0[2], v0[3]); w.z = cvt_pk_bf16(v1[0], v1[1]); w.w = cvt_pk_bf16(v1[2], v1[3]);
                    *(u32x4*)(rowp + bj * HALF) = w; } }
    }
};

#ifndef EPI_NT
#define EPI_NT 1
#endif
#if EPI_NT
#define EPI_ST(v, p) __builtin_nontemporal_store((v), (p))
#else
#define EPI_ST(v, p) (*(p) = (v))
#endif
__device__ __forceinline__ unsigned dpp_ror8(unsigned x) { return (unsigned)__builtin_amdgcn_update_dpp(0, (int)x, 0x128, 0xf, 0xf, false); }
__device__ __forceinline__ unsigned bperm(int a, unsigned x) { return (unsigned)__builtin_amdgcn_ds_bpermute(a, (int)x); }
__device__ __forceinline__ f32x4 dpp_ror8_v4(f32x4 v) { const u32x4 u = __builtin_bit_cast(u32x4, v); u32x4 r; r.x = dpp_ror8(u.x); r.y = dpp_ror8(u.y); r.z = dpp_ror8(u.z); r.w = dpp_ror8(u.w); return __builtin_bit_cast(f32x4, r); }
__device__ __forceinline__ f32x4 bperm_v4(int a, f32x4 v) { const u32x4 u = __builtin_bit_cast(u32x4, v); u32x4 r; r.x = bperm(a, u.x); r.y = bperm(a, u.y); r.z = bperm(a, u.z); r.w = bperm(a, u.w); return __builtin_bit_cast(f32x4, r); }
struct EpiResF32 {
    static constexpr bool PERM = false, PERM64 = false, AFTER_DRAIN = false;
    const float* base; float* out; int ldc;
    __device__ __forceinline__ void operator()(const f32x4 (&acc)[2][2][4][2], const Unit& u, int wr, int wc, int fr, int fq) const {
        const int hi8 = fr >> 3, l = fq * 16 + fr, dr = l >> 3, dc = l & 7;
        const int srcA = (((dc & 3) * 16 + (dc >> 2) * 8 + dr) << 2), srcB = (((dc & 3) * 16 + ((dc >> 2) ^ 1) * 8 + dr) << 2);
        const size_t offa = (size_t)(u.pm * BM + wr * 64 + dr) * ldc + u.pn * BM + wc * 32 + dc * 4, offb = offa + (size_t)8 * ldc;
#pragma unroll
        for (int ai = 0; ai < 2; ++ai)
#pragma unroll
            for (int m = 0; m < 4; ++m)
#pragma unroll
                for (int bj = 0; bj < 2; ++bj) { const size_t ro = (size_t)(ai * HALF + m * 16) * ldc + bj * HALF;
                    const f32x4 ba = *(const f32x4*)(base + offa + ro), bb = *(const f32x4*)(base + offb + ro);
                    const f32x4 w0 = acc[ai][bj][m][0], t = dpp_ror8_v4(acc[ai][bj][m][1]);
                    const f32x4 sa = hi8 ? t : w0, sb = hi8 ? w0 : t;
                    EPI_ST(bperm_v4(srcA, sa) + ba, (f32x4*)(out + offa + ro)); EPI_ST(bperm_v4(srcB, sb) + bb, (f32x4*)(out + offb + ro)); }
    }
};
struct EpiBf16L {
    static constexpr bool PERM = true, PERM64 = true, AFTER_DRAIN = false;
    bf16_t* O; int ldc;
    __device__ __forceinline__ void operator()(const f32x4 (&acc)[2][2][4][2], const Unit& u, int wr, int wc, int fr, int fq) const {
        const int hi8 = fr >> 3, l = fq * 16 + fr, dr = l >> 3, dc = l & 7;
        const int srcA = (((dc & 3) * 16 + (dc >> 2) * 8 + dr) << 2), srcB = (((dc & 3) * 16 + ((dc >> 2) ^ 1) * 8 + dr) << 2);
        bf16_t* pa = O + (size_t)(u.pm * BM + wr * 64 + dr) * ldc + u.pn * BM + wc * 64 + dc * 8;
        bf16_t* pb = pa + (size_t)8 * ldc;
#pragma unroll
        for (int ai = 0; ai < 2; ++ai)
#pragma unroll
            for (int m = 0; m < 4; ++m) { const size_t ro = (size_t)(ai * HALF + m * 16) * ldc;
                u32x4 w0, w1, t;
                w0.x = cvt_pk_bf16(acc[ai][0][m][0][0], acc[ai][0][m][0][1]); w0.y = cvt_pk_bf16(acc[ai][0][m][0][2], acc[ai][0][m][0][3]); w0.z = cvt_pk_bf16(acc[ai][0][m][1][0], acc[ai][0][m][1][1]); w0.w = cvt_pk_bf16(acc[ai][0][m][1][2], acc[ai][0][m][1][3]);
                w1.x = cvt_pk_bf16(acc[ai][1][m][0][0], acc[ai][1][m][0][1]); w1.y = cvt_pk_bf16(acc[ai][1][m][0][2], acc[ai][1][m][0][3]); w1.z = cvt_pk_bf16(acc[ai][1][m][1][0], acc[ai][1][m][1][1]); w1.w = cvt_pk_bf16(acc[ai][1][m][1][2], acc[ai][1][m][1][3]);
                t.x = dpp_ror8(w1.x); t.y = dpp_ror8(w1.y); t.z = dpp_ror8(w1.z); t.w = dpp_ror8(w1.w);
                const u32x4 sa = hi8 ? t : w0, sb = hi8 ? w0 : t;
                u32x4 oa, ob;
                oa.x = bperm(srcA, sa.x); oa.y = bperm(srcA, sa.y); oa.z = bperm(srcA, sa.z); oa.w = bperm(srcA, sa.w);
                ob.x = bperm(srcB, sb.x); ob.y = bperm(srcB, sb.y); ob.z = bperm(srcB, sb.z); ob.w = bperm(srcB, sb.w);
                EPI_ST(oa, (u32x4*)(pa + ro)); EPI_ST(ob, (u32x4*)(pb + ro)); }
    }
};
struct EpiSwiGLU {
    static constexpr bool PERM = true, PERM64 = false, AFTER_DRAIN = false;
    bf16_t* H; int ldh;
    __device__ __forceinline__ void operator()(const f32x4 (&acc)[2][2][4][2], const Unit& u, int wr, int wc, int fr, int fq) const {
        const int l = fq * 16 + fr, dr = l >> 2, dc = l & 3, src = (dc * 16 + dr) << 2;
        const int row0 = u.pm * BM + wr * 64 + dr, col0 = u.pn * HALF + wc * 32 + 8 * dc;
#pragma unroll
        for (int ai = 0; ai < 2; ++ai)
#pragma unroll
            for (int m = 0; m < 4; ++m) { bf16_t* rowp = H + (size_t)(row0 + ai * HALF + m * 16) * ldh + col0;
                float r[8];
#pragma unroll
                for (int n = 0; n < 2; ++n)
#pragma unroll
                    for (int i = 0; i < 4; ++i) { const float g = acc[ai][0][m][n][i], up = acc[ai][1][m][n][i]; r[n * 4 + i] = g / (1.0f + __expf(-g)) * up; }
                u32x4 w; w.x = cvt_pk_bf16(r[0], r[1]); w.y = cvt_pk_bf16(r[2], r[3]); w.z = cvt_pk_bf16(r[4], r[5]); w.w = cvt_pk_bf16(r[6], r[7]);
                u32x4 o; o.x = bperm(src, w.x); o.y = bperm(src, w.y); o.z = bperm(src, w.z); o.w = bperm(src, w.w);
                EPI_ST(o, (u32x4*)rowp); }
    }
};
#ifndef MOE_XCD_ORDER
#define MOE_XCD_ORDER 1
#endif
template <int NPN> struct MoeOrder {
    const PG8_LAS int* tile_e; int ntiles, G, c;
    __device__ __forceinline__ bool next(int i, Unit& u) const {
        if (MOE_XCD_ORDER && (G & 7) == 0) {
            const int x = c & 7, j = c >> 3, w = G >> 3;
            const int tb = ntiles >> 3, ex = ntiles & 7, cntx = tb + (x < ex ? 1 : 0), start = x * tb + (x < ex ? x : ex);
            const int q = i * w + j, tl = q / NPN; if (tl >= cntx) return false;
            u.pm = start + tl; u.pn = q % NPN;
        } else { const int L = i * G + c; if (L >= ntiles * NPN) return false; u.pm = L / NPN; u.pn = L % NPN; }
        u.pb = __builtin_amdgcn_readfirstlane(tile_e[u.pm]) * NPN + u.pn; return true;
    }
    __device__ __forceinline__ void a_ready(const Unit&) const {}
    __device__ __forceinline__ void done(const Unit&) const {}
    static constexpr bool GATHER = false;
    __device__ __forceinline__ unsigned arow(const Unit&, int) const { return 0u; }
};
template <int NPN, int LT, unsigned ROWBYTES> struct MoeGatherOrder {
    const PG8_LAS int* tile_e; const PG8_LAS int* tile0; const PG8_LAS int* cnt; const int* list; int ntiles, G, c;
    __device__ __forceinline__ bool next(int i, Unit& u) const {
        if (MOE_XCD_ORDER && (G & 7) == 0) {
            const int x = c & 7, j = c >> 3, w = G >> 3;
            const int tb = ntiles >> 3, ex = ntiles & 7, cntx = tb + (x < ex ? 1 : 0), start = x * tb + (x < ex ? x : ex);
            const int q = i * w + j, tl = q / NPN; if (tl >= cntx) return false;
            u.pm = start + tl; u.pn = q % NPN;
        } else { const int L = i * G + c; if (L >= ntiles * NPN) return false; u.pm = L / NPN; u.pn = L % NPN; }
        u.pb = __builtin_amdgcn_readfirstlane(tile_e[u.pm]) * NPN + u.pn; return true;
    }
    __device__ __forceinline__ void a_ready(const Unit&) const {}
    __device__ __forceinline__ void done(const Unit&) const {}
    static constexpr bool GATHER = true;
    __device__ __forceinline__ unsigned arow(const Unit& u, int r) const {
        const int e = __builtin_amdgcn_readfirstlane(tile_e[u.pm]); const int rr = (u.pm - __builtin_amdgcn_readfirstlane(tile0[e])) * 256 + r;
        const int tok = (rr < __builtin_amdgcn_readfirstlane(cnt[e])) ? list[(size_t)e * LT + rr] : 0;
        return (unsigned)tok * ROWBYTES;
    }
};
template <class Epi, class Sched, bool ALIGN_EPI = false, bool SP2 = false, bool THIN = false>
__device__ __forceinline__ void gemm_phase(PG8_LAS unsigned char* lds, const Gemm g, const Sched& S, const Epi& E) {
    int tid_ = threadIdx.x; asm volatile("" : "+v"(tid_));
    const int tid = tid_, wid = __builtin_amdgcn_readfirstlane(tid >> 6), lane = tid & 63, wr = wid >> 2, wc = wid & 3, fr = lane & 15, fq = lane >> 4;
    const int K = g.K, nt = K / BK;
    unsigned voffA[2], voffB[2]; int rowA[2]; unsigned colA2[2];
#pragma unroll
    for (int i = 0; i < 2; ++i) { int R, C; stage_rc(tid * 16 + i * 8192, R, C); const int Rb = Epi::PERM64 ? (64 * (R >> 5) + perm32(R & 31)) : Epi::PERM ? ((R & ~31) + perm32(R & 31)) : R;
        voffA[i] = (unsigned)(R * K + C) * 2u; voffB[i] = (unsigned)(Rb * K + C) * 2u; rowA[i] = R; colA2[i] = (unsigned)C * 2u; }
    unsigned cOff[2][2], nOff[2][2];
#define PG8_AOFFS(dst, u_) do { _Pragma("unroll") for (int h_ = 0; h_ < 2; ++h_) _Pragma("unroll") for (int i_ = 0; i_ < 2; ++i_) dst[h_][i_] = S.arow(u_, h_ * HALF + rowA[i_]) + colA2[i_]; } while (0)
    const size_t kstep = (size_t)(BK * 2);
    const size_t hstep = (size_t)HALF * K * 2;
    const size_t hstepB = Epi::PERM64 ? (size_t)32 * K * 2 : hstep;
    const size_t tstep = 2 * hstep;
    const unsigned ldsw = (unsigned)wid * 1024u;
    const int aoff = lds_byte(wr * 64 + fr, fq * 8), boff = lds_byte(wc * 32 + fr, fq * 8);
#define PG8_SA(b, h) (((b) * 2 + (h)) * HTB)
#define PG8_SB(b, h) ((4 + (b) * 2 + (h)) * HTB)
#define PG8_STAGE(bufoff, gbase, voff) do { _Pragma("unroll") for (int _i = 0; _i < 2; ++_i) \
        __builtin_amdgcn_global_load_lds((const unsigned*)((const char*)(gbase) + (voff)[_i]), (PG8_LAS unsigned*)(lds + (bufoff) + ldsw + _i * 8192), 16, 0, 0); } while (0)
#define PG8_LDA(dst, b, h) do { _Pragma("unroll") for (int m = 0; m < 4; ++m) _Pragma("unroll") for (int k = 0; k < 2; ++k) dst[m][k] = *(const PG8_LAS bf16x8*)(lds + PG8_SA(b, h) + aoff + m * 2048 + k * 1024); } while (0)
#define PG8_LDB(dst, b, h) do { _Pragma("unroll") for (int n = 0; n < 2; ++n) _Pragma("unroll") for (int k = 0; k < 2; ++k) dst[n][k] = *(const PG8_LAS bf16x8*)(lds + PG8_SB(b, h) + boff + n * 2048 + k * 1024); } while (0)
#define PG8_MMA(ai, bj, At, Bt) do { __builtin_amdgcn_s_setprio(1); _Pragma("unroll") for (int m = 0; m < 4; ++m) _Pragma("unroll") for (int n = 0; n < 2; ++n) _Pragma("unroll") for (int k = 0; k < 2; ++k) \
        acc[ai][bj][m][n] = __builtin_amdgcn_mfma_f32_16x16x32_bf16(Bt[n][k], At[m][k], acc[ai][bj][m][n], 0, 0, 0); __builtin_amdgcn_s_setprio(0); } while (0)
#define PG8_MMA2(ai) do { if constexpr (THIN) { if (wc == 0) PG8_MMA(ai, 0, At, B0); } else { PG8_MMA(ai, 0, At, B0); PG8_MMA(ai, 1, At, B1); } } while (0)
#define PG8_VC(h) (GA ? cOff[h] : voffA)
#define PG8_VN(h) (GA ? vN[h] : voffA)
#define PG8_WAIT_V(n) asm volatile("s_waitcnt vmcnt(" #n ")" ::: "memory")
#define PG8_WAIT_L(n) asm volatile("s_waitcnt lgkmcnt(" #n ")" ::: "memory")
#define PG8_BAR __builtin_amdgcn_s_barrier()
#define PG8_SCHED __builtin_amdgcn_sched_barrier(0)
    Unit cur, nxt; int ui = 0;
    if (!S.next(0, cur)) return;
    f32x4 acc[2][2][4][2];
#pragma unroll
    for (int a = 0; a < 2; ++a)
#pragma unroll
        for (int b = 0; b < 2; ++b)
#pragma unroll
            for (int m = 0; m < 4; ++m)
#pragma unroll
                for (int n = 0; n < 2; ++n) acc[a][b][m][n] = (f32x4){0.f, 0.f, 0.f, 0.f};
    bf16x8 At[4][2], B0[2][2], B1[2][2];
    constexpr bool GA = Sched::GATHER;
    const size_t hstepA = GA ? (size_t)0 : hstep;
    const char* cA = (const char*)g.A + (GA ? (size_t)0 : (size_t)cur.pm * tstep); const char* cB = (const char*)g.Bt + (size_t)cur.pb * tstep;
    if constexpr (GA) PG8_AOFFS(cOff, cur);
    S.a_ready(cur);
    if constexpr (SP2) {
        PG8_STAGE(PG8_SB(0, 0), cB, voffB); PG8_STAGE(PG8_SB(0, 1), cB + hstepB, voffB); PG8_STAGE(PG8_SA(0, 0), cA, PG8_VC(0)); PG8_STAGE(PG8_SA(0, 1), cA + hstepA, PG8_VC(1));
        if (wr == 1) PG8_BAR;
        PG8_WAIT_V(2); PG8_BAR;
        PG8_STAGE(PG8_SB(1, 0), cB + kstep, voffB); PG8_STAGE(PG8_SA(1, 0), cA + kstep, PG8_VC(0)); PG8_STAGE(PG8_SB(1, 1), cB + hstepB + kstep, voffB);
        PG8_WAIT_V(6); PG8_BAR;
    } else {
        PG8_STAGE(PG8_SB(0, 0), cB, voffB); PG8_STAGE(PG8_SA(0, 0), cA, PG8_VC(0)); PG8_STAGE(PG8_SB(0, 1), cB + hstepB, voffB); PG8_STAGE(PG8_SA(0, 1), cA + hstepA, PG8_VC(1));
        if (wr == 1) PG8_BAR;
        PG8_WAIT_V(4); PG8_BAR;
        PG8_STAGE(PG8_SB(1, 0), cB + kstep, voffB); PG8_STAGE(PG8_SA(1, 0), cA + kstep, PG8_VC(0)); PG8_STAGE(PG8_SB(1, 1), cB + hstepB + kstep, voffB);
        PG8_WAIT_V(6); PG8_BAR;
    }
    for (;;) {
        const bool has_next = S.next(ui + 1, nxt);
        if constexpr (GA) { if (has_next) PG8_AOFFS(nOff, nxt); else { _Pragma("unroll") for (int h_ = 0; h_ < 2; ++h_) _Pragma("unroll") for (int i_ = 0; i_ < 2; ++i_) nOff[h_][i_] = cOff[h_][i_]; } }
        const char* nA = (has_next && !GA) ? (const char*)g.A + (size_t)nxt.pm * tstep : cA; const char* nB = has_next ? (const char*)g.Bt + (size_t)nxt.pb * tstep : cB;
        for (int t = 0; t < nt; t += 2) {
            const bool last = (t == nt - 2);
            const char* a1 = cA + (size_t)(t + 1) * kstep;
            const char* a2 = last ? nA : cA + (size_t)(t + 2) * kstep; const char* b2 = last ? nB : cB + (size_t)(t + 2) * kstep;
            const char* a3 = a2 + kstep; const char* b3 = b2 + kstep;
            unsigned vN[2][2];
            if constexpr (GA) { _Pragma("unroll") for (int h_ = 0; h_ < 2; ++h_) _Pragma("unroll") for (int i_ = 0; i_ < 2; ++i_) vN[h_][i_] = last ? nOff[h_][i_] : cOff[h_][i_]; }
            if (last && has_next) S.a_ready(nxt);
            if constexpr (SP2) {
            PG8_LDB(B0, 0, 0); PG8_LDB(B1, 0, 1); PG8_SCHED; PG8_LDA(At, 0, 0); PG8_STAGE(PG8_SA(1, 1), a1 + hstepA, PG8_VC(1));
            PG8_WAIT_V(8); PG8_WAIT_L(0); PG8_BAR; PG8_MMA2(0); PG8_BAR; PG8_SCHED;
            PG8_LDA(At, 0, 1); PG8_STAGE(PG8_SB(0, 0), b2, voffB); PG8_STAGE(PG8_SB(0, 1), b2 + hstepB, voffB); PG8_STAGE(PG8_SA(0, 0), a2, PG8_VN(0));
            PG8_WAIT_V(8); PG8_WAIT_L(0); PG8_BAR; PG8_MMA2(1); PG8_BAR; PG8_SCHED;
            PG8_LDB(B0, 1, 0); PG8_LDB(B1, 1, 1); PG8_SCHED; PG8_LDA(At, 1, 0); PG8_STAGE(PG8_SA(0, 1), a2 + hstepA, PG8_VN(1));
            PG8_WAIT_V(8); PG8_WAIT_L(0); PG8_BAR; PG8_MMA2(0); PG8_BAR; PG8_SCHED;
            PG8_LDA(At, 1, 1); PG8_STAGE(PG8_SB(1, 0), b3, voffB); PG8_STAGE(PG8_SB(1, 1), b3 + hstepB, voffB); PG8_STAGE(PG8_SA(1, 0), a3, PG8_VN(0));
            PG8_WAIT_V(8); PG8_WAIT_L(0); PG8_BAR; PG8_MMA2(1); PG8_BAR; PG8_SCHED;
            } else {
            PG8_LDB(B0, 0, 0); PG8_SCHED; PG8_LDA(At, 0, 0); PG8_STAGE(PG8_SA(1, 1), a1 + hstepA, PG8_VC(1));
            PG8_WAIT_L(8); PG8_BAR; PG8_WAIT_L(0); PG8_MMA(0, 0, At, B0); PG8_BAR; PG8_SCHED;
            PG8_LDB(B1, 0, 1); PG8_STAGE(PG8_SB(0, 0), b2, voffB);
            PG8_BAR; PG8_WAIT_L(0); PG8_MMA(0, 1, At, B1); PG8_BAR;
            PG8_LDA(At, 0, 1); PG8_STAGE(PG8_SA(0, 0), a2, PG8_VN(0));
            PG8_BAR; PG8_WAIT_L(0); PG8_MMA(1, 0, At, B0); PG8_BAR; PG8_SCHED;
            PG8_STAGE(PG8_SB(0, 1), b2 + hstepB, voffB);
            PG8_WAIT_V(6); PG8_BAR; PG8_MMA(1, 1, At, B1); PG8_BAR;
            PG8_LDB(B0, 1, 0); PG8_SCHED; PG8_LDA(At, 1, 0); PG8_STAGE(PG8_SA(0, 1), a2 + hstepA, PG8_VN(1));
            PG8_WAIT_L(8); PG8_BAR; PG8_WAIT_L(0); PG8_MMA(0, 0, At, B0); PG8_BAR; PG8_SCHED;
            PG8_LDB(B1, 1, 1); PG8_STAGE(PG8_SB(1, 0), b3, voffB);
            PG8_BAR; PG8_WAIT_L(0); PG8_MMA(0, 1, At, B1); PG8_BAR;
            PG8_LDA(At, 1, 1); PG8_STAGE(PG8_SA(1, 0), a3, PG8_VN(0));
            PG8_BAR; PG8_WAIT_L(0); PG8_MMA(1, 0, At, B0); PG8_BAR; PG8_SCHED;
            PG8_STAGE(PG8_SB(1, 1), b3 + hstepB, voffB);
            PG8_WAIT_V(6); PG8_BAR; PG8_MMA(1, 1, At, B1); PG8_BAR;
            }
        }
        if constexpr (ALIGN_EPI) { if (wr == 0) PG8_BAR; }
        if constexpr (!Epi::AFTER_DRAIN) { E(acc, cur, wr, wc, fr, fq); S.done(cur); }
        if (!has_next) break;
#pragma unroll
        for (int a = 0; a < 2; ++a)
#pragma unroll
            for (int b = 0; b < 2; ++b)
#pragma unroll
                for (int m = 0; m < 4; ++m)
#pragma unroll
                    for (int n = 0; n < 2; ++n) acc[a][b][m][n] = (f32x4){0.f, 0.f, 0.f, 0.f};
        cur = nxt; cA = nA; cB = nB; ++ui;
        if constexpr (GA) { _Pragma("unroll") for (int h_ = 0; h_ < 2; ++h_) _Pragma("unroll") for (int i_ = 0; i_ < 2; ++i_) cOff[h_][i_] = nOff[h_][i_]; }
        if constexpr (ALIGN_EPI) { if (wr == 1) PG8_BAR; }
    }
    PG8_WAIT_V(0);
    if constexpr (!ALIGN_EPI) { if (wr == 0) PG8_BAR; }
    PG8_BAR;
    if constexpr (Epi::AFTER_DRAIN) { E.fused(acc, cur, wr, wc, fr, fq, lds, wid, lane); S.done(cur); }
#undef PG8_SA
#undef PG8_SB
#undef PG8_STAGE
#undef PG8_LDA
#undef PG8_LDB
#undef PG8_MMA
#undef PG8_MMA2
#undef PG8_VC
#undef PG8_VN
#undef PG8_AOFFS
#undef PG8_WAIT_V
#undef PG8_WAIT_L
#undef PG8_BAR
#undef PG8_SCHED
}
}
#include <hip/hip_bf16.h>
namespace attn_body {
using bf16=__hip_bfloat16;
using bf16x8=__attribute__((ext_vector_type(8)))short;
using s16x4=__attribute__((ext_vector_type(4)))short;
using f32x16=__attribute__((ext_vector_type(16)))float;
using u32x4=__attribute__((ext_vector_type(4)))unsigned;
constexpr int D=64;
constexpr int NW=8,QBLK=32,QB=QBLK*NW,KVBLK=64;
constexpr int ATTN_UNIT_ROWS=QB;
__device__ __forceinline__ int crow(int r,int hi){return (r&3)+8*(r>>2)+4*hi;}
#define SBAR() __builtin_amdgcn_sched_barrier(0)
__device__ __forceinline__ void cmask(f32x16&p0,f32x16&p1,int jb,int qrel,int hi){
  const float NEG=-INFINITY; int kb=64*jb+4*hi;
  #pragma unroll
  for(int r=0;r<16;++r){int kv=kb+(r&3)+8*(r>>2); if(kv>qrel)p0[r]=NEG; if(kv+32>qrel)p1[r]=NEG;}
}

constexpr int NSLOT=3, SLOTB=8192;
constexpr int LDS_K=0, LDS_V=NSLOT*SLOTB, LDS_WS=2*NSLOT*SLOTB, LDS_OST=LDS_WS+NW*64*4, LDS_BYTES=LDS_OST+NW*4096;
constexpr float C2=0.125f*1.4426950408889634f;
__device__ __forceinline__ void glds16(const void*gsrc,unsigned lds_dst){unsigned keep;
  asm volatile("s_mov_b32 %0, m0\n\ts_mov_b32 m0, %2\n\ts_nop 0\n\tglobal_load_lds_dwordx4 %1, off\n\ts_mov_b32 m0, %0":"=&s"(keep):"v"(gsrc),"s"(lds_dst):"memory");}
__device__ __forceinline__ float max3f(float a,float b,float c){float r;asm("v_max3_f32 %0, %1, %2, %3":"=v"(r):"v"(a),"v"(b),"v"(c));return r;}
__device__ __forceinline__ float max2f(float a,float b){float r;asm("v_max_f32_e32 %0, %1, %2":"=v"(r):"v"(a),"v"(b));return r;}
__device__ __forceinline__ float fadd_s(float a,float b){float r;asm("v_add_f32_e32 %0, %1, %2":"=v"(r):"v"(a),"v"(b));return r;}
__device__ __forceinline__ float fsub_s(float a,float b){float r;asm("v_sub_f32_e32 %0, %1, %2":"=v"(r):"v"(a),"v"(b));return r;}
typedef float f32x2_t __attribute__((ext_vector_type(2))); typedef __bf16 bf16x2_t __attribute__((ext_vector_type(2)));
__device__ __forceinline__ unsigned cvtpk_s(float lo,float hi){f32x2_t v={lo,hi};bf16x2_t b=__builtin_convertvector(v,bf16x2_t);return __builtin_bit_cast(unsigned,b);}
#define WAIT_BAR(N) asm volatile("s_waitcnt vmcnt(" #N ") lgkmcnt(0)\n\ts_barrier":::"memory")

__device__ __forceinline__ void qkt(f32x16&p0,f32x16&p1,const char*Kslot,const bf16x8*qr,const f32x16&negm,int r32,int hi){
  const char*kb=Kslot+hi*1024+r32*16;
  #pragma unroll
  for(int d0=0;d0<4;++d0){
    const bf16x8 b0=*reinterpret_cast<const bf16x8*>(kb+d0*2048);
    const bf16x8 b1=*reinterpret_cast<const bf16x8*>(kb+d0*2048+512);
    if(d0==0){p0=__builtin_amdgcn_mfma_f32_32x32x16_bf16(b0,qr[0],negm,0,0,0);p1=__builtin_amdgcn_mfma_f32_32x32x16_bf16(b1,qr[0],negm,0,0,0);}
    else{p0=__builtin_amdgcn_mfma_f32_32x32x16_bf16(b0,qr[d0],p0,0,0,0);p1=__builtin_amdgcn_mfma_f32_32x32x16_bf16(b1,qr[d0],p1,0,0,0);}}
}
typedef __attribute__((address_space(3))) const char* lds_cptr;
typedef short v4i16_t __attribute__((ext_vector_type(4)));
__device__ __forceinline__ void kload8(bf16x8*kf,lds_cptr kp){
  kf[0]=*(const __attribute__((address_space(3))) bf16x8*)(kp);      kf[1]=*(const __attribute__((address_space(3))) bf16x8*)(kp+512);
  kf[2]=*(const __attribute__((address_space(3))) bf16x8*)(kp+2048); kf[3]=*(const __attribute__((address_space(3))) bf16x8*)(kp+2560);
  kf[4]=*(const __attribute__((address_space(3))) bf16x8*)(kp+4096); kf[5]=*(const __attribute__((address_space(3))) bf16x8*)(kp+4608);
  kf[6]=*(const __attribute__((address_space(3))) bf16x8*)(kp+6144); kf[7]=*(const __attribute__((address_space(3))) bf16x8*)(kp+6656);
}
__device__ __forceinline__ void kload2(bf16x8*kf,lds_cptr kp,int j){ kf[2*j]=*(const __attribute__((address_space(3))) bf16x8*)(kp+j*2048); kf[2*j+1]=*(const __attribute__((address_space(3))) bf16x8*)(kp+j*2048+512); }
__device__ __forceinline__ s16x4 vtr(lds_cptr p){ return __builtin_bit_cast(s16x4,__builtin_amdgcn_ds_read_tr16_b64_v4i16((__attribute__((address_space(3))) v4i16_t*)p)); }
__device__ __forceinline__ float rowmax(const f32x16&p0,const f32x16&p1){
  float a=max3f(p0[0],p0[1],p1[0]),b=max3f(p0[2],p0[3],p1[1]);a=max3f(a,p1[2],p1[3]);
  #pragma unroll
  for(int r=4;r<16;r+=4){a=max3f(a,p0[r],p0[r+1]);b=max3f(b,p0[r+2],p0[r+3]);a=max3f(a,p1[r],p1[r+1]);b=max3f(b,p1[r+2],p1[r+3]);}
  const float m=max2f(a,b);
  auto rr=__builtin_amdgcn_permlane32_swap(__float_as_uint(m),__float_as_uint(m),false,false);
  return max2f(__uint_as_float(rr[0]),__uint_as_float(rr[1]));
}
__device__ __forceinline__ void pv(f32x16*o,int vb,bf16x8 pa0,bf16x8 pa1,bf16x8 pa2,bf16x8 pa3){
  #pragma unroll
  for(int d0=0;d0<2;++d0){s16x4 lo[4],hi[4];
    #pragma unroll
    for(int ks=0;ks<4;++ks){
      asm volatile("ds_read_b64_tr_b16 %0,%1 offset:%c2":"=&v"(lo[ks]):"v"(vb),"i"(d0*4096+ks*1024):"memory");
      asm volatile("ds_read_b64_tr_b16 %0,%1 offset:%c2":"=&v"(hi[ks]):"v"(vb),"i"(d0*4096+ks*1024+512):"memory");}
    asm volatile("s_waitcnt lgkmcnt(0)":::"memory");SBAR();
    #define PK(k) (bf16x8){lo[k][0],lo[k][1],lo[k][2],lo[k][3],hi[k][0],hi[k][1],hi[k][2],hi[k][3]}
    o[d0]=__builtin_amdgcn_mfma_f32_32x32x16_bf16(pa0,PK(0),o[d0],0,0,0);
    o[d0]=__builtin_amdgcn_mfma_f32_32x32x16_bf16(pa1,PK(1),o[d0],0,0,0);
    o[d0]=__builtin_amdgcn_mfma_f32_32x32x16_bf16(pa2,PK(2),o[d0],0,0,0);
    o[d0]=__builtin_amdgcn_mfma_f32_32x32x16_bf16(pa3,PK(3),o[d0],0,0,0);
    #undef PK
  }
}

#ifndef ATTN_STORE16
#define ATTN_STORE16(p,v) __builtin_nontemporal_store((v),(u32x4*)(p))
#endif
template<int THRL,int QP,int KP,int VP,int OP,bool FIXMAX> __device__ __forceinline__ void attn_unit(int q0,int NT,const bf16*Qb,const bf16*__restrict__ Kh,const bf16*__restrict__ Vh,bf16*Ob,char*shm,float mshift){
  int tid_=threadIdx.x; asm volatile("":"+v"(tid_));
  const int tid=tid_,lane=tid&63,r32=lane&31,hi=lane>>5; const int wid=__builtin_amdgcn_readfirstlane(tid>>6);
  const bf16*Qw=Qb+(long)(q0+wid*QBLK)*QP;
  const unsigned lds0=(unsigned)(uintptr_t)shm;
  float*wsf=(float*)(shm+LDS_WS)+wid*64;
  const bf16*ksrc=Kh+(long)lane*KP+wid*8;
  const bf16*vsrc=Vh+(long)(16*(wid&3)+(lane>>2))*VP+(wid>>2)*32+(lane&3)*8;
  const unsigned kdst=lds0+LDS_K+wid*1024, vdst=lds0+LDS_V+wid*1024;
  #define DMA_K(t,slot) glds16(ksrc+(long)(t)*KVBLK*KP,(unsigned)__builtin_amdgcn_readfirstlane(kdst+(slot)))
  #define DMA_V(t,slot) glds16(vsrc+(long)(t)*KVBLK*VP,(unsigned)__builtin_amdgcn_readfirstlane(vdst+(slot)))
  const int vb0=(int)(lds0+LDS_V)+((lane>>4)&1)*32+(lane&3)*8+(4*hi+((lane&15)>>2))*64;
  const char*Kbase=shm+LDS_K; bf16x8 kf[8];
  const lds_cptr shm3=(lds_cptr)shm; const lds_cptr kp0=shm3+LDS_K+hi*1024+r32*16; const lds_cptr vp0=shm3+LDS_V+((lane>>4)&1)*32+(lane&3)*8+(4*hi+((lane&15)>>2))*64;
  DMA_K(0,0);DMA_V(0,0);DMA_K(1,SLOTB);
  bf16x8 qr[4];
  #pragma unroll
  for(int d0=0;d0<4;++d0)qr[d0]=*reinterpret_cast<const bf16x8*>(&Qw[(long)r32*QP+d0*16+hi*8]);
  float mhat=0.f,l_reg=0.f;f32x16 o[2];o[0]=f32x16{};o[1]=f32x16{};f32x16 negm=f32x16{};asm volatile("":"+v"(negm));
  #define CMASK(P0,P1,t) do{}while(0)
  bool resc=false;
  #define START(P0,P1) do{ const float rm=FIXMAX?mshift:rowmax(P0,P1); resc=false; \
    { const float dl=rm; mhat=fadd_s(mhat,dl); \
      _Pragma("unroll") for(int r=0;r<16;++r){P0[r]=fsub_s(P0[r],dl);P1[r]=fsub_s(P1[r],dl);} \
      _Pragma("unroll") for(int r=0;r<16;++r)negm[r]=-mhat; asm volatile("":"+v"(negm)); } \
    _Pragma("unroll") for(int r=0;r<16;++r)P0[r]=__builtin_amdgcn_exp2f(P0[r]); }while(0)
  #define RESC() do{ if(resc){ asm volatile("s_waitcnt lgkmcnt(0)":::"memory"); \
      _Pragma("unroll") for(int d_=0;d_<2;++d_) _Pragma("unroll") for(int r=0;r<16;++r)o[d_][r]*=wsf[crow(r,hi)]; } }while(0)
  f32x16 pA0,pA1,pB0,pB1;
  int sl_prev=0,sl_cur=0,sl_next=SLOTB;
  #define ROT() do{sl_prev=sl_cur;sl_cur=sl_next;sl_next=(sl_next==(NSLOT-1)*SLOTB)?0:sl_next+SLOTB;}while(0)
  DMA_K(2,2*SLOTB);
  WAIT_BAR(3);
  qkt(pA0,pA1,Kbase,qr,negm,r32,hi);asm volatile("s_nop 15\n\ts_nop 7":"+v"(pA0),"+v"(pA1));CMASK(pA0,pA1,0);
  START(pA0,pA1);
  _Pragma("unroll") for(int r=0;r<16;++r)pA1[r]=__builtin_amdgcn_exp2f(pA1[r]);
  WAIT_BAR(0);
  DMA_K(3,0);DMA_V(1,SLOTB);
  ROT();
  kload8(kf,kp0+sl_cur);
  WAIT_BAR(2);
  s16x4 vlo[8],vhi[8]; u32x4 pw0,pw1,pw2,pw3;
  #define PKW(P,B) cvtpk_s(P[B],P[B+1])
  #define PAF(k) __builtin_bit_cast(bf16x8,pw##k)
  #define VFR(i) (bf16x8){vlo[i][0],vlo[i][1],vlo[i][2],vlo[i][3],vhi[i][0],vhi[i][1],vhi[i][2],vhi[i][3]}
  #define PIN(x) asm volatile("":"+v"(x))
  #define MX3(a,b,c) __builtin_fmaxf(__builtin_fmaxf((a),(b)),(c))
  #define GAPA(MF,A0,A1,A2,A3,W0,W1,PW) do{ MF; sacc+=A0; sacc+=A1; sacc+=A2; sacc+=A3; PIN(sacc); W0; W1; PIN(PW); SBAR(); }while(0)
  #define EX(v) __builtin_amdgcn_exp2f(v)
  #define GAPB(MF,X,B) do{ MF; X[B]=EX(X[B]); X[B+1]=EX(X[B+1]); X[B+2]=EX(X[B+2]); X[B+3]=EX(X[B+3]); PIN(X); SBAR(); }while(0)
  #define VRD(i) do{ vlo[i]=vtr(vp_+(((i)>>2)*4096+((i)&3)*1024)); vhi[i]=vtr(vp_+(((i)>>2)*4096+((i)&3)*1024+512)); }while(0)
  #define KRD(G,j) do{ if(G){ kload2(kf,kp0+sl_next,j); SBAR(); } }while(0)
  #define STEP(C0,C1,P0,P1,t,GK,GV,GL) do{ SBAR(); \
    const lds_cptr vp_=vp0+sl_prev; \
    VRD(0); SBAR(); float sacc=(P0[0]+P0[1]); \
    GAPA(C0=__builtin_amdgcn_mfma_f32_32x32x16_bf16(kf[0],qr[0],negm,0,0,0), P0[2],P0[3],P0[4],P0[5],     pw0[0]=PKW(P0,0), pw0[1]=PKW(P0,2), pw0); \
    VRD(4); SBAR(); GAPA(C1=__builtin_amdgcn_mfma_f32_32x32x16_bf16(kf[1],qr[0],negm,0,0,0), P0[6],P0[7],P0[8],P0[9],     pw0[2]=PKW(P0,4), pw0[3]=PKW(P0,6), pw0); \
    VRD(1); SBAR(); GAPA(C0=__builtin_amdgcn_mfma_f32_32x32x16_bf16(kf[2],qr[1],C0,0,0,0),   P0[10],P0[11],P0[12],P0[13], pw1[0]=PKW(P0,8), pw1[1]=PKW(P0,10), pw1); \
    VRD(5); SBAR(); GAPA(C1=__builtin_amdgcn_mfma_f32_32x32x16_bf16(kf[3],qr[1],C1,0,0,0),   P0[14],P0[15],P1[0],P1[1],   pw1[2]=PKW(P0,12),pw1[3]=PKW(P0,14), pw1); \
    VRD(2); SBAR(); GAPA(C0=__builtin_amdgcn_mfma_f32_32x32x16_bf16(kf[4],qr[2],C0,0,0,0),   P1[2],P1[3],P1[4],P1[5],     pw2[0]=PKW(P1,0), pw2[1]=PKW(P1,2), pw2); \
    VRD(6); SBAR(); GAPA(C1=__builtin_amdgcn_mfma_f32_32x32x16_bf16(kf[5],qr[2],C1,0,0,0),   P1[6],P1[7],P1[8],P1[9],     pw2[2]=PKW(P1,4), pw2[3]=PKW(P1,6), pw2); \
    VRD(3); SBAR(); GAPA(C0=__builtin_amdgcn_mfma_f32_32x32x16_bf16(kf[6],qr[3],C0,0,0,0),   P1[10],P1[11],P1[12],P1[13], pw3[0]=PKW(P1,8), pw3[1]=PKW(P1,10), pw3); \
    VRD(7); SBAR(); GAPA(C1=__builtin_amdgcn_mfma_f32_32x32x16_bf16(kf[7],qr[3],C1,0,0,0),   P1[14],P1[15],0.f,0.f,       pw3[2]=PKW(P1,12),pw3[3]=PKW(P1,14), pw3); \
    l_reg+=sacc; \
    if(GK){DMA_K((t)+3,sl_cur);} if(GV){DMA_V((t)+1,sl_next);} \
    CMASK(C0,C1,t); \
    if(!FIXMAX){ float a=MX3(C0[0],C0[1],C1[0]),b=MX3(C0[2],C0[3],C1[1]); a=MX3(a,C1[2],C1[3]); \
      _Pragma("unroll") for(int r=4;r<16;r+=4){a=MX3(a,C0[r],C0[r+1]);b=MX3(b,C0[r+2],C0[r+3]);a=MX3(a,C1[r],C1[r+1]);b=MX3(b,C1[r+2],C1[r+3]);} \
      float rm=__builtin_fmaxf(a,b); { auto rr=__builtin_amdgcn_permlane32_swap(__float_as_uint(rm),__float_as_uint(rm),false,false); rm=__builtin_fmaxf(__uint_as_float(rr[0]),__uint_as_float(rr[1])); } \
      resc=false; \
      if(__builtin_expect(__any(rm>(float)THRL),0)){ const float dl=__builtin_fmaxf(rm,0.f); mhat+=dl; \
        _Pragma("unroll") for(int r=0;r<16;++r){C0[r]-=dl;C1[r]-=dl;} \
        _Pragma("unroll") for(int r=0;r<16;++r)negm[r]=-mhat; asm volatile("":"+v"(negm)); \
        const float f=__builtin_amdgcn_exp2f(-dl); l_reg*=f; if(hi==0)wsf[r32]=f; resc=true; } } \
    SBAR(); \
    GAPB(o[0]=__builtin_amdgcn_mfma_f32_32x32x16_bf16(PAF(0),VFR(0),o[0],0,0,0), C0,0); \
    GAPB(o[1]=__builtin_amdgcn_mfma_f32_32x32x16_bf16(PAF(0),VFR(4),o[1],0,0,0), C0,4); \
    KRD(GL,0); GAPB(o[0]=__builtin_amdgcn_mfma_f32_32x32x16_bf16(PAF(1),VFR(1),o[0],0,0,0), C0,8); \
    KRD(GL,1); GAPB(o[1]=__builtin_amdgcn_mfma_f32_32x32x16_bf16(PAF(1),VFR(5),o[1],0,0,0), C0,12); \
    KRD(GL,2); GAPB(o[0]=__builtin_amdgcn_mfma_f32_32x32x16_bf16(PAF(2),VFR(2),o[0],0,0,0), C1,0); \
    KRD(GL,3); GAPB(o[1]=__builtin_amdgcn_mfma_f32_32x32x16_bf16(PAF(2),VFR(6),o[1],0,0,0), C1,4); \
    GAPB(o[0]=__builtin_amdgcn_mfma_f32_32x32x16_bf16(PAF(3),VFR(3),o[0],0,0,0), C1,8); \
    GAPB(o[1]=__builtin_amdgcn_mfma_f32_32x32x16_bf16(PAF(3),VFR(7),o[1],0,0,0), C1,12); \
    }while(0)
  int t=1;
  #undef CMASK
  #define CMASK(P0,P1,t) do{}while(0)
  for(;t+5<NT;t+=2){
    STEP(pB0,pB1,pA0,pA1,t,true,true,true);     WAIT_BAR(2); RESC(); ROT();
    STEP(pA0,pA1,pB0,pB1,t+1,true,true,true);   WAIT_BAR(2); RESC(); ROT();
  }
  #undef CMASK
  #define CMASK(P0,P1,t) do{}while(0)
  #define ENDW(tt) do{ if((tt)+3<NT){WAIT_BAR(2);} else if((tt)+2<NT){WAIT_BAR(1);} else {WAIT_BAR(0);} }while(0)
  for(;t+1<NT;t+=2){
    STEP(pB0,pB1,pA0,pA1,t,(t+3<NT),(t+1<NT),(t+1<NT));       ENDW(t);   RESC(); ROT();
    STEP(pA0,pA1,pB0,pB1,t+1,(t+4<NT),(t+2<NT),(t+2<NT));     ENDW(t+1); RESC(); ROT();
  }
  STEP(pB0,pB1,pA0,pA1,NT-1,false,false,false); RESC();
  { float sacc=pB0[0]+pB0[1]; _Pragma("unroll") for(int r=2;r<16;++r)sacc+=pB0[r]; _Pragma("unroll") for(int r=0;r<16;++r)sacc+=pB1[r]; l_reg+=sacc;
    pw0=(u32x4){PKW(pB0,0),PKW(pB0,2),PKW(pB0,4),PKW(pB0,6)};pw1=(u32x4){PKW(pB0,8),PKW(pB0,10),PKW(pB0,12),PKW(pB0,14)};pw2=(u32x4){PKW(pB1,0),PKW(pB1,2),PKW(pB1,4),PKW(pB1,6)};pw3=(u32x4){PKW(pB1,8),PKW(pB1,10),PKW(pB1,12),PKW(pB1,14)};
    SBAR(); pv(o,vb0+sl_cur,PAF(0),PAF(1),PAF(2),PAF(3)); }
  #undef PKW
  #undef PAF
  #undef VFR
  #undef PIN
  #undef MX3
  #undef GAPA
  #undef GAPB
  #undef EX
  #undef VRD
  #undef KRD
  #undef STEP
  #undef ENDW
  {auto rr=__builtin_amdgcn_permlane32_swap(__float_as_uint(l_reg),__float_as_uint(l_reg),false,false);l_reg=__uint_as_float(rr[0])+__uint_as_float(rr[1]);}
  if(hi==0)wsf[32+r32]=l_reg;asm volatile("s_waitcnt lgkmcnt(0)":::"memory");
  float rli[16];
  #pragma unroll
  for(int r=0;r<16;++r)rli[r]=__builtin_amdgcn_rcpf(wsf[32+crow(r,hi)]);
  bf16*Ow=Ob+(long)(q0+wid*QBLK)*OP;
  { bf16*stg=(bf16*)(shm+LDS_OST)+wid*2048;
    #pragma unroll
    for(int r=0;r<16;++r){const int orow=crow(r,hi);
      #pragma unroll
      for(int d0=0;d0<2;++d0)stg[orow*64+d0*32+r32]=__float2bfloat16(o[d0][r]*rli[r]);}
    asm volatile("s_waitcnt lgkmcnt(0)":::"memory");
    #pragma unroll
    for(int i=0;i<4;++i){const int row=i*8+(lane>>3),ch=lane&7; const u32x4 v=*(const u32x4*)(stg+row*64+ch*8); ATTN_STORE16(Ow+(long)row*OP+ch*8,v);} }
  asm volatile("s_waitcnt lgkmcnt(0)\n\ts_barrier":::"memory");
  #undef DMA_K
  #undef DMA_V
  #undef CMASK
  #undef START
  #undef RESC
  #undef ROT
}
constexpr int ATTN_LDS_BYTES=LDS_BYTES;
#undef SBAR
#undef WAIT_BAR
}

#define GAS __attribute__((address_space(1)))
#define LAS __attribute__((address_space(3)))
#define CAS __attribute__((address_space(4)))
typedef const GAS float* cfp;
typedef unsigned short bf16;
typedef unsigned v4u __attribute__((ext_vector_type(4)));
typedef unsigned v2u __attribute__((ext_vector_type(2)));
typedef float f32x4 __attribute__((ext_vector_type(4)));
typedef float f32x2 __attribute__((ext_vector_type(2)));
typedef float f32x16 __attribute__((ext_vector_type(16)));
typedef short bf16x8 __attribute__((ext_vector_type(8)));
typedef short s16x4 __attribute__((ext_vector_type(4)));
typedef GAS unsigned gu32;
#define RLX_AGENT __ATOMIC_RELAXED, __HIP_MEMORY_SCOPE_AGENT
#define NTST(p_, v_) __builtin_nontemporal_store((v_), (p_))
#define LDS_WAIT() asm volatile("s_waitcnt lgkmcnt(0)" ::: "memory")
#define VM_WAIT() asm volatile("s_waitcnt vmcnt(0)" ::: "memory")
#define LDS_BARRIER() do { asm volatile("s_waitcnt lgkmcnt(0)" ::: "memory"); __builtin_amdgcn_s_barrier(); asm volatile("" ::: "memory"); } while (0)

constexpr int NWAVES = 8, NTHR = 512;
constexpr int BATCH = 2, SEQ = 16384, T = BATCH * SEQ, D = 2048, DIN = 5152, DINP = 5376;
constexpr int GW = 512, HD = 64, NH = 8, NKV = 2, DIN_FULL = 5120;
constexpr int C_AQKV = 0, C_AZ = 1536, C_ABETA = 2048, C_AALPHA = 2064, C_B = 2080, C_CQ = 3616, C_CKV = 4128, C_DQ = 4384, C_DKV = 4896;
constexpr int NE = 32, DE = 512, MOE_ROWS = 2 * T + NE * 256;
constexpr int FL = SEQ;
constexpr float EPS = 1e-6f;
constexpr float LOG2E = 1.4426950408889634f;
constexpr float C2 = 0.125f * LOG2E;

enum { I_X = 0, I_NORM_MIX, I_W_IN, I_GDN_CONV, I_GDN_ALOG, I_GDN_DTB, I_GDN_NORM, I_HY_CONV, I_HY_W1, I_HY_B1, I_HY_F1, I_HY_W2, I_HY_B2, I_HY_F2, I_HY_W3,
       I_HY_DELTAS, I_HY_BIAS, I_HY_NORM, I_SWA_SINK, I_SWA_NORM, I_GA_QN, I_GA_KN, I_GA_NORM, I_W_OUT, I_NORM_FFN, I_MOE_WG, I_MOE_BG, I_MOE_WE, I_MOE_BE,
       I_MOE_GATE, I_MOE_UP, I_MOE_DOWN, I_NORM_FINAL, N_INPUTS };

constexpr size_t MiB = 1u << 20;
constexpr size_t WS_CTL = 0, CTL_ZERO_BYTES = 1 * MiB;
constexpr size_t WS_INFO = 1 * MiB;
constexpr size_t WS_H2T = 2 * MiB;
constexpr size_t WS_WRT = 6 * MiB;
constexpr size_t WS_WIN = 8 * MiB;
constexpr size_t WIN_BYTES = (size_t)DINP * D * 2;
constexpr size_t WS_WOUT = 50 * MiB;
constexpr size_t WOUT_BYTES = (size_t)D * D * 2;
constexpr size_t WS_XN = 66 * MiB;
constexpr size_t WS_P = 194 * MiB;
constexpr size_t WS_MOE_H = WS_P + 288 * MiB;
constexpr size_t WS_Y = 554 * MiB;
constexpr size_t WS_T = 682 * MiB;
constexpr size_t WS_GUT = WS_Y, WS_DT = WS_T;
constexpr size_t WS_ELIST = WS_T + 64 * MiB;
constexpr size_t WS_HT = WS_XN, WS_OF = WS_XN + 64 * MiB, WS_OB = WS_XN + 96 * MiB;
constexpr size_t WS_UT = WS_Y, WS_YT = WS_T, WS_FSCR = WS_T + 64 * MiB;
constexpr size_t WS_QP = WS_T + 384 * MiB, WS_KP = WS_Y + 96 * MiB, WS_VTC = WS_Y + 104 * MiB, WS_VP = WS_Y + 112 * MiB, WS_OGD = WS_T + 192 * MiB, WS_OGC = WS_T + 224 * MiB;
constexpr size_t WS_END = WS_T + 416 * MiB;
constexpr int CW_BAR = 4096;
constexpr int CW_CNT = 32768;

constexpr int RING_BYTES = 131072;
constexpr int FFT_LDS_BYTES = 139264;
constexpr int MISC_OFF = FFT_LDS_BYTES;
constexpr int TILE_E_OFF = MISC_OFF + 1024;
constexpr int LDS_BYTES = 147456;

typedef __bf16 hwbf16x2 __attribute__((ext_vector_type(2)));
__device__ __forceinline__ unsigned pk2(float lo, float hi) { const f32x2 v = {lo, hi}; return __builtin_bit_cast(unsigned, __builtin_convertvector(v, hwbf16x2)); }
__device__ __forceinline__ unsigned f2bf(float f) { return pk2(f, 0.f) & 0xffffu; }
__device__ __forceinline__ float bf2f(bf16 h) { return __builtin_bit_cast(float, (unsigned)h << 16); }
__device__ __forceinline__ float bflo(unsigned w) { return __builtin_bit_cast(float, w << 16); }
__device__ __forceinline__ float bfhi(unsigned w) { return __builtin_bit_cast(float, w & 0xffff0000u); }
__device__ __forceinline__ float wave_sum(float v) {
#pragma unroll
    for (int o = 1; o < 64; o <<= 1) v += __shfl_xor(v, o);
    return v;
}
__device__ __forceinline__ int crow(int r, int hi) { return (r & 3) + 8 * (r >> 2) + 4 * hi; }
__device__ __forceinline__ float siluf(float a) { return a / (1.0f + __expf(-a)); }

#define XB_TMO      128
#define XB_XCNT(j)  (256  + 64 * (j))
#define XB_XSUB(j)  (1280 + 64 * (j))
#define XB_XGEN(j)  (2304 + 64 * (j))
#define XB_TOP      3328
#define XB_TOPGEN   3392
#define XCD_BAR_WORDS 3456
#define XB_SPIN_CAP (1u << 18)

__device__ __forceinline__ unsigned xb_ld(unsigned* p)              { return __hip_atomic_load(p, __ATOMIC_RELAXED, __HIP_MEMORY_SCOPE_AGENT); }
__device__ __forceinline__ unsigned xb_add(unsigned* p, unsigned v) { return __hip_atomic_fetch_add(p, v, __ATOMIC_RELAXED, __HIP_MEMORY_SCOPE_AGENT); }
__device__ __forceinline__ unsigned xb_xcc_id() { return (unsigned)__builtin_amdgcn_s_getreg((3 << 11) | 20) & 0xFu; }
#define XB_SPIN(cond, bar) do { unsigned _sp = 0; while (cond) { __builtin_amdgcn_s_sleep(1); \
    if ((++_sp & 255u) == 0u) { if (xb_ld(&(bar)[XB_TMO])) break; if (_sp > XB_SPIN_CAP) { atomicAdd(&(bar)[XB_TMO], 1u); break; } } } } while (0)

struct XcdBarrier {
    unsigned* bar; unsigned x;
    volatile LAS unsigned* st;
};

__device__ __forceinline__ XcdBarrier xcd_barrier_post(unsigned* bar, volatile LAS unsigned* st) {
    XcdBarrier b; b.bar = bar; b.x = xb_xcc_id(); b.st = st;
    if (threadIdx.x == 0) (void)xb_add(&bar[XB_XCNT(b.x)], 1u);
    return b;
}
__device__ __forceinline__ void xcd_barrier_complete(unsigned* bar, unsigned x, unsigned& nloc, unsigned& nx) {
    const unsigned G = gridDim.x * gridDim.y * gridDim.z;
    unsigned sum, cnt, mine, sp = 0u;
    for (;;) {
        sum = 0u; cnt = 0u; mine = 0u;
#pragma unroll
        for (unsigned j = 0; j < 16; ++j) { const unsigned c = xb_ld(&bar[XB_XCNT(j)]); sum += c; cnt += (c > 0u) ? 1u : 0u; mine = (j == x) ? c : mine; }
        if (sum == G) break;
        __builtin_amdgcn_s_sleep(1);
        if ((++sp & 255u) == 0u) { if (xb_ld(&bar[XB_TMO])) break; if (sp > XB_SPIN_CAP) { atomicAdd(&bar[XB_TMO], 1u); break; } }
    }
    nloc = mine > 0u ? mine : 1u; nx = cnt > 0u ? cnt : 1u;
}

__device__ __forceinline__ void xcd_barrier(const XcdBarrier& b) {
    asm volatile("s_waitcnt vmcnt(0)" ::: "memory");
    __syncthreads();
    if (threadIdx.x == 0) {
        unsigned* bar = b.bar;
        __builtin_amdgcn_s_waitcnt(0);
        unsigned nloc = b.st[0], nx = b.st[1];
        if (nloc == 0u) { xcd_barrier_complete(bar, b.x, nloc, nx); b.st[0] = nloc; b.st[1] = nx; }
        const unsigned old = xb_add(&bar[XB_XSUB(b.x)], 1u);
        const unsigned gen = old / nloc;
        if (old + 1u == (gen + 1u) * nloc) {
            __builtin_amdgcn_fence(__ATOMIC_RELEASE, "agent");
            asm volatile("s_waitcnt vmcnt(0)" ::: "memory");
            const unsigned og = xb_add(&bar[XB_TOP], 1u);
            const unsigned tg = og / nx;
            if (og + 1u == (tg + 1u) * nx) xb_add(&bar[XB_TOPGEN], 1u);
            else XB_SPIN(xb_ld(&bar[XB_TOPGEN]) == tg, bar);
            __builtin_amdgcn_fence(__ATOMIC_ACQUIRE, "agent");
            xb_add(&bar[XB_XGEN(b.x)], 1u);
            asm volatile("s_waitcnt vmcnt(0)" ::: "memory");
        } else {
            XB_SPIN(xb_ld(&bar[XB_XGEN(b.x)]) == gen, bar);
            __builtin_amdgcn_fence(__ATOMIC_ACQUIRE, "agent");
            asm volatile("s_waitcnt vmcnt(0)" ::: "memory");
        }
    }
    __syncthreads();
}


#define INP(i) ((const float*)F.in[i])
struct Frame {
    LAS unsigned char* lds;
    volatile LAS unsigned* MISC;
    gu32* ctl;
    int tid, lane, wave, G, bid;
    const CAS cfp* in;
    float* out; unsigned char* ws;
};


__device__ __forceinline__ void transpose_tile(const float* W, int ldw, int k0, int n0, bf16* WT, int ldt, int dst_row0, LAS float* scr, int lane) {
#pragma unroll 8
    for (int i = 0; i < 32; ++i) { const int kk = 2 * i + (lane >> 5); scr[kk * 33 + (lane & 31)] = W[(size_t)(k0 + kk) * ldw + n0 + (lane & 31)]; }
    LDS_WAIT(); asm volatile("" ::: "memory");
    const int c = lane & 7;
#pragma unroll
    for (int j = 0; j < 4; ++j) { const int n = (lane >> 3) + 8 * j; const LAS float* s = scr + (8 * c) * 33 + n;
        v4u o; o.x = pk2(s[0 * 33], s[1 * 33]); o.y = pk2(s[2 * 33], s[3 * 33]); o.z = pk2(s[4 * 33], s[5 * 33]); o.w = pk2(s[6 * 33], s[7 * 33]);
        *(v4u*)(WT + (size_t)(dst_row0 + n) * ldt + k0 + 8 * c) = o; }
    LDS_WAIT(); asm volatile("" ::: "memory");
}

__device__ __forceinline__ void transpose_tile64(const float* W, int ldw, int k0, int n0, bf16* WT, int ldt, int dst_row0, LAS float* scr, int lane) {
    f32x4 v[16];
#pragma unroll
    for (int j = 0; j < 16; ++j) v[j] = *(const f32x4*)(W + (size_t)(k0 + 4 * j + (lane >> 4)) * ldw + n0 + 4 * (lane & 15));
#pragma unroll
    for (int j = 0; j < 16; ++j) { LAS float* d = scr + (4 * j + (lane >> 4)) * 65 + 4 * (lane & 15); d[0] = v[j].x; d[1] = v[j].y; d[2] = v[j].z; d[3] = v[j].w; }
    LDS_WAIT(); asm volatile("" ::: "memory");
    const int c = lane & 7;
#pragma unroll
    for (int j = 0; j < 8; ++j) { const int n = (lane >> 3) + 8 * j; const LAS float* s = scr + (8 * c) * 65 + n;
        v4u o; o.x = pk2(s[0 * 65], s[1 * 65]); o.y = pk2(s[2 * 65], s[3 * 65]); o.z = pk2(s[4 * 65], s[5 * 65]); o.w = pk2(s[6 * 65], s[7 * 65]);
        *(v4u*)(WT + (size_t)(dst_row0 + n) * ldt + k0 + 8 * c) = o; }
    LDS_WAIT(); asm volatile("" ::: "memory");
}

__device__ __forceinline__ void norm_row_bf16(const float* xrow, const float* g, bf16* orow, int lane) {
    f32x4 v[8]; float s = 0.f;
#pragma unroll
    for (int j = 0; j < 8; ++j) { v[j] = ((const f32x4*)xrow)[lane + 64 * j]; s += (v[j].x * v[j].x + v[j].y * v[j].y) + (v[j].z * v[j].z + v[j].w * v[j].w); }
    const float rstd = 1.0f / sqrtf(wave_sum(s) * (1.0f / D) + EPS);
#pragma unroll
    for (int j = 0; j < 8; ++j) { const f32x4 gv = ((const f32x4*)g)[lane + 64 * j]; const f32x4 o = v[j] * rstd * gv;
        v2u w; w.x = pk2(o.x, o.y); w.y = pk2(o.z, o.w); NTST((v2u*)orow + lane + 64 * j, w); }
}

__device__ __forceinline__ void ph_prologue(Frame& F) {
    LAS float* scr = (LAS float*)(F.lds + F.wave * 16640);
    const int gw = F.bid * NWAVES + F.wave, NGW = F.G * NWAVES;
    constexpr int IT_IN = (D / 64) * (DIN / 32), IT_OUT = (D / 64) * (D / 64);
    for (int it = gw; it < 2 * (IT_IN + IT_OUT); it += NGW) {
        const int l = it / (IT_IN + IT_OUT); int r = it % (IT_IN + IT_OUT);
        if (r < IT_IN) { const int nblk = DIN / 32, kb = r / nblk, nb = r % nblk;
            transpose_tile(INP(I_W_IN) + (size_t)l * D * DIN, DIN, kb * 64, nb * 32, (bf16*)(F.ws + WS_WIN + l * WIN_BYTES), D, nb * 32, scr, F.lane); }
        else { r -= IT_IN; const int nblk = D / 64, kb = r / nblk, nb = r % nblk;
            transpose_tile64(INP(I_W_OUT) + (size_t)l * D * D, D, kb * 64, nb * 64, (bf16*)(F.ws + WS_WOUT + l * WOUT_BYTES), D, nb * 64, scr, F.lane); }
    }
    { const int gt = F.bid * NTHR + F.tid, NGT = F.G * NTHR; constexpr int PADV = (DINP - DIN) * D * 2 / 16;
      for (int i = gt; i < 2 * PADV; i += NGT) { const int l = i / PADV, r = i % PADV; ((v4u*)(F.ws + WS_WIN + l * WIN_BYTES + (size_t)DIN * D * 2))[r] = (v4u){0u, 0u, 0u, 0u}; }
      float* wg = (float*)(F.ws + WS_WRT);
      for (int i = gt; i < 2 * D * 64; i += NGT) { const int l = i / (D * 64), r_ = i % (D * 64), k = r_ >> 6, j = r_ & 63; const float gk = INP(I_NORM_FFN)[l * D + k];
          wg[i] = (j < 32) ? gk * INP(I_MOE_WE)[((size_t)l * D + k) * 32 + j] : (j < 36) ? gk * INP(I_MOE_WG)[((size_t)l * D + k) * 4 + (j - 32)] : 0.f; } }
    for (int m = gw; m < T; m += NGW) norm_row_bf16(INP(I_X) + (size_t)m * D, INP(I_NORM_MIX), (bf16*)(F.ws + WS_XN) + (size_t)m * D, F.lane);
}

__device__ __forceinline__ void ph_in_rem(Frame& F, int l) {
    const int gw = F.bid * NWAVES + F.wave, NGW = F.G * NWAVES, lane = F.lane, fr = lane & 15, fq = lane >> 4;
    const bf16* xn = (const bf16*)(F.ws + WS_XN); const bf16* wt = (const bf16*)(F.ws + WS_WIN + l * WIN_BYTES) + (size_t)DIN_FULL * D;
    bf16* proj = (bf16*)(F.ws + WS_P);
    for (int u = gw; u < T / 16; u += NGW) {
        const bf16* ap = xn + (size_t)(u * 16 + fr) * D + 8 * fq; const bf16* bp0 = wt + (size_t)fr * D + 8 * fq; const bf16* bp1 = bp0 + (size_t)16 * D;
        f32x4 acc0 = (f32x4){0.f, 0.f, 0.f, 0.f}, acc1 = (f32x4){0.f, 0.f, 0.f, 0.f};
#pragma unroll 8
        for (int ks = 0; ks < D / 32; ++ks) { const bf16x8 a = *(const bf16x8*)(ap + 32 * ks), b0 = *(const bf16x8*)(bp0 + 32 * ks), b1 = *(const bf16x8*)(bp1 + 32 * ks);
            acc0 = __builtin_amdgcn_mfma_f32_16x16x32_bf16(b0, a, acc0, 0, 0, 0); acc1 = __builtin_amdgcn_mfma_f32_16x16x32_bf16(b1, a, acc1, 0, 0, 0); }
        bf16* o = proj + (size_t)(u * 16 + fr) * DINP + DIN_FULL + 4 * fq;
        *(v2u*)o = (v2u){pk2(acc0.x, acc0.y), pk2(acc0.z, acc0.w)}; *(v2u*)(o + 16) = (v2u){pk2(acc1.x, acc1.y), pk2(acc1.z, acc1.w)};
    }
}
constexpr int GREC_BYTES = 49152, GREC_W = 16384, GREC_A = 24576, GREC_Q = 32768, GREC_K = 40960;
constexpr size_t WS_GREC = WS_T;
constexpr size_t WS_GCD = 7 * MiB;
__device__ __forceinline__ void ph_gdn_prep(Frame& F, int l) {
    LAS float* Ks = (LAS float*)F.lds;
    LAS float* Qs = (LAS float*)(F.lds + 16640);
    LAS float* Vs = (LAS float*)(F.lds + 33280);
    LAS float* KK = (LAS float*)(F.lds + 49664);
    LAS float* QK = (LAS float*)(F.lds + 66304);
    LAS float* AT = (LAS float*)(F.lds + 82944);
    LAS float* gfv = (LAS float*)(F.lds + 100352);
    const bf16* proj = (const bf16*)(F.ws + WS_P);
    const float* cw = INP(I_GDN_CONV) + (size_t)l * 3 * 1536;
    for (int unit = F.bid; unit < 2 * 8 * 256; unit += F.G) {
        int tid_ = F.tid; asm volatile("" : "+v"(tid_));
        const int tid = tid_, lane = tid & 63, wave = __builtin_amdgcn_readfirstlane(tid >> 6);
        const int n = unit & 255, h = (unit >> 8) & 7, b = unit >> 11;
        { const int j = tid >> 3, p = tid & 7, t = n * 64 + j; const size_t m = (size_t)b * SEQ + t;
          const bf16* pr = proj + m * DINP + C_AQKV + h * 64 + p * 8;
          float sq = 0.f, sk = 0.f; float qv[8], kv[8], vv[8];
#pragma unroll
          for (int part = 0; part < 3; ++part) {
              const v4u xc = *(const v4u*)(pr + part * 512);
              v4u xm = (v4u){0u, 0u, 0u, 0u}, xp = (v4u){0u, 0u, 0u, 0u};
              if (t > 0) xm = *(const v4u*)(pr + part * 512 - DINP);
              if (t < SEQ - 1) xp = *(const v4u*)(pr + part * 512 + DINP);
              const int ch = part * 512 + h * 64 + p * 8;
              const f32x4 w0a = *(const f32x4*)(cw + ch), w0b = *(const f32x4*)(cw + ch + 4), w1a = *(const f32x4*)(cw + 1536 + ch), w1b = *(const f32x4*)(cw + 1536 + ch + 4),
                          w2a = *(const f32x4*)(cw + 3072 + ch), w2b = *(const f32x4*)(cw + 3072 + ch + 4);
              const float c0[8] = {bflo(xm.x), bfhi(xm.x), bflo(xm.y), bfhi(xm.y), bflo(xm.z), bfhi(xm.z), bflo(xm.w), bfhi(xm.w)};
              const float c1[8] = {bflo(xc.x), bfhi(xc.x), bflo(xc.y), bfhi(xc.y), bflo(xc.z), bfhi(xc.z), bflo(xc.w), bfhi(xc.w)};
              const float c2[8] = {bflo(xp.x), bfhi(xp.x), bflo(xp.y), bfhi(xp.y), bflo(xp.z), bfhi(xp.z), bflo(xp.w), bfhi(xp.w)};
              const float ww0[8] = {w0a.x, w0a.y, w0a.z, w0a.w, w0b.x, w0b.y, w0b.z, w0b.w}, ww1[8] = {w1a.x, w1a.y, w1a.z, w1a.w, w1b.x, w1b.y, w1b.z, w1b.w}, ww2[8] = {w2a.x, w2a.y, w2a.z, w2a.w, w2b.x, w2b.y, w2b.z, w2b.w};
#pragma unroll
              for (int i = 0; i < 8; ++i) { float a = ww0[i] * c0[i] + ww1[i] * c1[i] + ww2[i] * c2[i]; a = a * __builtin_amdgcn_rcpf(1.0f + __expf(-a));
                  if (part == 0) { qv[i] = a; sq += a * a; } else if (part == 1) { kv[i] = a; sk += a * a; } else vv[i] = a; }
          }
          sq += __shfl_xor(sq, 1); sq += __shfl_xor(sq, 2); sq += __shfl_xor(sq, 4);
          sk += __shfl_xor(sk, 1); sk += __shfl_xor(sk, 2); sk += __shfl_xor(sk, 4);
          const float rq = 0.125f / sqrtf(sq + EPS), rk = 1.0f / sqrtf(sk + EPS);
#pragma unroll
          for (int i = 0; i < 8; ++i) { Qs[j * 65 + p * 8 + i] = qv[i] * rq; Ks[j * 65 + p * 8 + i] = kv[i] * rk; Vs[j * 64 + p * 8 + i] = vv[i]; }
          if (tid < 64) { const size_t mm = (size_t)b * SEQ + n * 64 + tid; const bf16* pb_ = proj + mm * DINP;
              const float xbf = bf2f(pb_[C_ABETA + h]), xbb = bf2f(pb_[C_ABETA + 8 + h]);
              const float xaf = bf2f(pb_[C_AALPHA + h]) + INP(I_GDN_DTB)[l * 16 + h], xab = bf2f(pb_[C_AALPHA + 8 + h]) + INP(I_GDN_DTB)[l * 16 + 8 + h];
              const float spf = (xaf > 20.f) ? xaf : __logf(1.0f + __expf(xaf)), spb = (xab > 20.f) ? xab : __logf(1.0f + __expf(xab));
              const float g_f = -__expf(INP(I_GDN_ALOG)[l * 16 + h]) * spf, g_b = -__expf(INP(I_GDN_ALOG)[l * 16 + 8 + h]) * spb;
              gfv[256 + tid] = 1.0f / (1.0f + __expf(-xbf)); gfv[320 + tid] = 1.0f / (1.0f + __expf(-xbb));
              float sf = g_f; float sb = __shfl(g_b, 63 - lane);
#pragma unroll
              for (int o = 1; o < 64; o <<= 1) { const float uf = __shfl_up(sf, o), ub = __shfl_up(sb, o); if (lane >= o) { sf += uf; sb += ub; } }
              gfv[128 + tid] = sf; gfv[192 + 63 - tid] = sb; }
        }
        LDS_BARRIER();
        { const int mat = wave >> 2, mt = wave & 3, r16 = lane & 15, q4 = lane >> 4; const LAS float* Am = mat ? Qs : Ks; LAS float* Om = mat ? QK : KK;
          f32x4 acc[4];
#pragma unroll
          for (int nt = 0; nt < 4; ++nt) acc[nt] = (f32x4){0.f, 0.f, 0.f, 0.f};
#pragma unroll 4
          for (int ks = 0; ks < 16; ++ks) { const float a = Am[(16 * mt + r16) * 65 + 4 * ks + q4];
#pragma unroll
              for (int nt = 0; nt < 4; ++nt) acc[nt] = __builtin_amdgcn_mfma_f32_16x16x4f32(a, Ks[(16 * nt + r16) * 65 + 4 * ks + q4], acc[nt], 0, 0, 0); }
#pragma unroll
          for (int nt = 0; nt < 4; ++nt)
#pragma unroll
              for (int rg = 0; rg < 4; ++rg) Om[(16 * mt + 4 * q4 + rg) * 65 + 16 * nt + r16] = acc[nt][rg];
        }
        LDS_BARRIER();
#pragma unroll
        for (int q = 0; q < 8; ++q) { const int e = tid + NTHR * q, i = e >> 6, j = e & 63; float v = 0.f;
            if (j > i) v = gfv[256 + j] * KK[j * 65 + i] * __expf(gfv[128 + j] - gfv[128 + i]);
            else if (j < i) v = gfv[320 + j] * KK[j * 65 + i] * __expf(gfv[192 + j] - gfv[192 + i]);
            AT[i * 68 + j] = v; }
        LDS_BARRIER();
        unsigned char* recf = F.ws + WS_GREC + ((size_t)((b * 8 + h) * 2 + 0) * 256 + n) * GREC_BYTES;
        unsigned char* recb = F.ws + WS_GREC + ((size_t)((b * 8 + h) * 2 + 1) * 256 + n) * GREC_BYTES;
        if (wave < 4) {
            const int dirw = wave >> 1, isW = wave & 1; const LAS float* gc = gfv + 128 + dirw * 64; const LAS float* be = gfv + 256 + dirw * 64;
            const LAS float* ATl = AT; asm volatile("" : "+v"(ATl), "+v"(gc), "+v"(be));
#define NFMA(acc_, a_, x_) asm("v_fma_f32 %0, -%1, %2, %0" : "+v"(acc_) : "v"(a_), "v"(x_))
#define NPKFMA(acc2_, a2_, xp_, EL) do { if ((EL) == 0) asm("v_pk_fma_f32 %0, %1, %2, %0 op_sel_hi:[1,0,1] neg_lo:[1,0,0] neg_hi:[1,0,0]" : "+v"(acc2_) : "v"(a2_), "v"(xp_)); \
                                         else asm("v_pk_fma_f32 %0, %1, %2, %0 op_sel:[0,1,0] op_sel_hi:[1,1,1] neg_lo:[1,0,0] neg_hi:[1,0,0]" : "+v"(acc2_) : "v"(a2_), "v"(xp_)); } while (0)
            f32x2 R2[32];
#pragma unroll
            for (int j = 0; j < 64; ++j) R2[j >> 1][j & 1] = isW ? (be[j] * Ks[j * 65 + lane] * __expf(gc[j])) : (be[j] * Vs[j * 64 + lane]);
            f32x4 cb[2][8];
#define SV_ROW(t) (BW ? ((t) < 62 ? 63 - ((t) >> 1) : 32 - ((t) - 62)) : ((t) < 62 ? ((t) >> 1) : 31 + ((t) - 62)))
#define SV_K0(t)  (BW ? (((t) < 62 && ((t) & 1)) ? 8 : 0) : ((((SV_ROW(t)) + 1) >> 2) + (((t) < 62 && ((t) & 1)) ? 8 : 0)))
#define SV_K1(t)  (BW ? (((t) < 62 && !((t) & 1)) ? 7 : ((SV_ROW(t) - 1) >> 2)) : (((t) < 62 && !((t) & 1)) ? ((((SV_ROW(t)) + 1) >> 2) + 7) : 15))
#define SV_LOAD(t) do { _Pragma("unroll") for (int k = SV_K0(t); k <= SV_K1(t); ++k) cb[(t) & 1][k - SV_K0(t)] = *(const LAS f32x4*)(ATl + SV_ROW(t) * 68 + 4 * k); } while (0)
#define SV_PAIR(j0, alo, ahi) do { if (!BW) { if ((j0) > i) { const f32x2 a2 = (f32x2){alo, ahi}; NPKFMA(R2[(j0) >> 1], a2, xp, i & 1); } else if ((j0) + 1 > i) NFMA(R2[(j0) >> 1][1], ahi, xi); } \
                                   else { if ((j0) + 1 < i) { const f32x2 a2 = (f32x2){alo, ahi}; NPKFMA(R2[(j0) >> 1], a2, xp, i & 1); } else if ((j0) < i) NFMA(R2[(j0) >> 1][0], alo, xi); } } while (0)
#define SV_RUN() do { SV_LOAD(0); \
                _Pragma("clang loop unroll(full)") for (int t = 0; t < 94; ++t) { \
                    if (t + 1 < 94) SV_LOAD(t + 1); \
                    __builtin_amdgcn_sched_barrier(0); \
                    const int i = SV_ROW(t); const float xi = R2[i >> 1][i & 1]; const f32x2 xp = R2[i >> 1]; \
                    _Pragma("unroll") for (int k = SV_K0(t); k <= SV_K1(t); ++k) { const f32x4 v = cb[t & 1][k - SV_K0(t)]; SV_PAIR(4 * k, v.x, v.y); SV_PAIR(4 * k + 2, v.z, v.w); } \
                    __builtin_amdgcn_sched_barrier(0); } } while (0)
            if (dirw == 0) { constexpr bool BW = false; SV_RUN(); } else { constexpr bool BW = true; SV_RUN(); }
#undef SV_ROW
#undef SV_K0
#undef SV_K1
#undef SV_LOAD
#undef SV_PAIR
#undef SV_RUN
            float R[64];
#pragma unroll
            for (int j = 0; j < 64; ++j) R[j] = R2[j >> 1][j & 1];
            unsigned char* rec = dirw ? recb : recf;
            if (!isW) { LAS unsigned char* st = F.lds + (dirw ? 102400 : 49664);
#pragma unroll
                for (int j = 0; j < 16; ++j) *(LAS f32x4*)(st + lane * 256 + ((j ^ (lane & 15)) << 4)) = (f32x4){R[4 * j], R[4 * j + 1], R[4 * j + 2], R[4 * j + 3]};
#pragma unroll
                for (int i = 0; i < 16; ++i) { const int row = (lane >> 4) + 4 * i, ch = lane & 15;
                    NTST((f32x4*)(rec + (size_t)row * 256 + ch * 16), *(const LAS f32x4*)(st + row * 256 + ((ch ^ (row & 15)) << 4))); } }
            else { LAS unsigned char* st = F.lds + (dirw ? 128000 : 118784);
#pragma unroll
                for (int j = 0; j < 64; ++j) *(LAS bf16*)(st + j * 144 + lane * 2) = (bf16)f2bf(-R[j]);
#pragma unroll
                for (int i = 0; i < 8; ++i) { const int row = (lane >> 3) + 8 * i, ch = lane & 7;
                    NTST((v4u*)(rec + GREC_W + (size_t)row * 128 + ch * 16), *(const LAS v4u*)(st + row * 144 + ch * 16)); } }
        } else {
            const int tl = tid - 256;
#pragma unroll
            for (int q = 0; q < 2; ++q) { const int e = tl + 256 * q, i = e >> 3, j0 = (e & 7) * 8;
                const float gfi = gfv[128 + i], gbi = gfv[192 + i], egf = __expf(gfi), egb = __expf(gbi), gfl = gfv[128 + 63], gbl = gfv[192 + 0];
                float af[8], ab[8], qf_[8], qb_[8], kf_[8], kb_[8];
#pragma unroll
                for (int c = 0; c < 8; ++c) { const int j = j0 + c; const float qk = QK[i * 65 + j];
                    af[c] = (j <= i) ? qk * __expf(gfi - gfv[128 + j]) : 0.f; ab[c] = (j >= i) ? qk * __expf(gbi - gfv[192 + j]) : 0.f;
                    const float qq = Qs[i * 65 + j]; qf_[c] = qq * egf; qb_[c] = qq * egb;
                    const float kk = Ks[j * 65 + i]; kf_[c] = kk * __expf(gfl - gfv[128 + j]); kb_[c] = kk * __expf(gbl - gfv[192 + j]); }
                const size_t off = (size_t)i * 128 + j0 * 2;
                NTST((v4u*)(recf + GREC_A + off), ((v4u){pk2(af[0], af[1]), pk2(af[2], af[3]), pk2(af[4], af[5]), pk2(af[6], af[7])}));
                NTST((v4u*)(recb + GREC_A + off), ((v4u){pk2(ab[0], ab[1]), pk2(ab[2], ab[3]), pk2(ab[4], ab[5]), pk2(ab[6], ab[7])}));
                NTST((v4u*)(recf + GREC_Q + off), ((v4u){pk2(qf_[0], qf_[1]), pk2(qf_[2], qf_[3]), pk2(qf_[4], qf_[5]), pk2(qf_[6], qf_[7])}));
                NTST((v4u*)(recb + GREC_Q + off), ((v4u){pk2(qb_[0], qb_[1]), pk2(qb_[2], qb_[3]), pk2(qb_[4], qb_[5]), pk2(qb_[6], qb_[7])}));
                NTST((v4u*)(recf + GREC_K + off), ((v4u){pk2(kf_[0], kf_[1]), pk2(kf_[2], kf_[3]), pk2(kf_[4], kf_[5]), pk2(kf_[6], kf_[7])}));
                NTST((v4u*)(recb + GREC_K + off), ((v4u){pk2(kb_[0], kb_[1]), pk2(kb_[2], kb_[3]), pk2(kb_[4], kb_[5]), pk2(kb_[6], kb_[7])})); }
            if (tl == 0) { float* cd = (float*)(F.ws + WS_GCD); cd[((b * 8 + h) * 2 + 0) * 256 + n] = __expf(gfv[128 + 63]); cd[((b * 8 + h) * 2 + 1) * 256 + n] = __expf(gfv[192 + 0]); }
        }
        LDS_BARRIER();
    }
}

typedef float f32x4m __attribute__((ext_vector_type(4)));
constexpr int N_SCAN_WG = 64;
__device__ __forceinline__ void ph_gdn_scan(Frame& F) {
    if (F.bid >= N_SCAN_WG) return;
    constexpr int LB_U = 0, LB_W = 17408, LB_A = 17408 + 9216, LB_Q = 17408 + 2 * 9216, LB_K = 17408 + 3 * 9216, LBUF = 17408 + 4 * 9216;
    constexpr int L_ST = 2 * LBUF, L_VT = 2 * LBUF + 9216;
    const int chain = F.bid >> 1, vh = F.bid & 1, dir = chain & 1, h = (chain >> 1) & 7, b = chain >> 4;
    const int tid = F.tid, lane = F.lane, wave = F.wave, r = lane & 15, q = lane >> 4, mt = wave >> 1, nt = 2 * vh + (wave & 1);
    const unsigned char* recs = F.ws + WS_GREC + (size_t)chain * 256 * GREC_BYTES;
    const float* cdv = (const float*)(F.ws + WS_GCD) + chain * 256;
    bf16* od = (bf16*)(F.ws + (dir ? WS_OB : WS_OF));
    LAS unsigned char* lds = F.lds;
    v4u pre[3][5];
    const unsigned goff0 = (unsigned)((512 * vh + tid) * 16), goff1 = (unsigned)((1024 + tid) * 16);
    const int loff0 = LB_U + (32 * vh + (tid >> 4)) * 272 + (tid & 15) * 16, loff1 = LB_W + (tid >> 3) * 144 + (tid & 7) * 16;
#define GS_LOAD(s_, n_) do { const unsigned char* rp_ = recs + (size_t)(n_) * GREC_BYTES; asm volatile("global_load_dwordx4 %0, %1, off" : "=v"(pre[s_][0]) : "v"(rp_ + goff0) : "memory"); \
        _Pragma("unroll") for (int i_ = 1; i_ < 5; ++i_) asm volatile("global_load_dwordx4 %0, %1, off" : "=v"(pre[s_][i_]) : "v"(rp_ + goff1 + (size_t)(i_ - 1) * 8192) : "memory"); } while (0)
#define GS_WAIT(s_, N_) GS_WAIT2(s_, N_)
#define GS_WAIT2(s_, N_) asm volatile("s_waitcnt vmcnt(" #N_ ")" : "+v"(pre[s_][0]), "+v"(pre[s_][1]), "+v"(pre[s_][2]), "+v"(pre[s_][3]), "+v"(pre[s_][4]) :: "memory")
#define GS_STORE(s_, bufo_) do { *(LAS v4u*)(lds + (bufo_) + loff0) = pre[s_][0]; _Pragma("unroll") for (int i_ = 1; i_ < 5; ++i_) *(LAS v4u*)(lds + (bufo_) + loff1 + (i_ - 1) * 9216) = pre[s_][i_]; } while (0)
    for (int i = tid; i < 9216 / 4; i += NTHR) ((LAS unsigned*)(lds + L_ST))[i] = 0u;
    LAS float* lcd = (LAS float*)(lds + L_VT + 9216);
    if (tid < 256) lcd[tid] = cdv[tid];
    f32x4m Sacc = {0.f, 0.f, 0.f, 0.f};
    const int n_first = dir ? 255 : 0, n_step = dir ? -1 : 1;
    GS_LOAD(0, n_first); GS_WAIT(0, 0); GS_STORE(0, 0);
    GS_LOAD(1, n_first + n_step); GS_LOAD(2, n_first + 2 * n_step);
    __syncthreads();
#define GS_STEP(SL_NEXT, SL_FREE, WAITN) do { \
        const int n = n_first + it * n_step, bo = (it & 1) * LBUF, bn = ((it + 1) & 1) * LBUF; \
        if (it + 3 < 256) GS_LOAD(SL_FREE, n + 3 * n_step); \
        const float cd = lcd[n]; \
        bf16x8 aw[2], aq[2], bs[2]; \
        _Pragma("unroll") for (int ks = 0; ks < 2; ++ks) { aw[ks] = *(const LAS bf16x8*)(lds + bo + LB_W + (16 * mt + r) * 144 + ks * 64 + q * 16); aq[ks] = *(const LAS bf16x8*)(lds + bo + LB_Q + (16 * mt + r) * 144 + ks * 64 + q * 16); \
            bs[ks] = *(const LAS bf16x8*)(lds + L_ST + (16 * nt + r) * 144 + ks * 64 + q * 16); } \
        f32x4m vn = *(const LAS f32x4m*)(lds + bo + LB_U + (16 * nt + r) * 272 + (16 * mt + 4 * q) * 4), oa = (f32x4m){0.f, 0.f, 0.f, 0.f}; \
        _Pragma("unroll") for (int ks = 0; ks < 2; ++ks) { vn = __builtin_amdgcn_mfma_f32_16x16x32_bf16(aw[ks], bs[ks], vn, 0, 0, 0); oa = __builtin_amdgcn_mfma_f32_16x16x32_bf16(aq[ks], bs[ks], oa, 0, 0, 0); } \
        *(LAS v2u*)(lds + L_VT + (16 * nt + r) * 144 + (16 * mt + 4 * q) * 2) = (v2u){pk2(vn.x, vn.y), pk2(vn.z, vn.w)}; \
        LDS_BARRIER(); \
        bf16x8 aa[2], ak[2], bv[2]; \
        _Pragma("unroll") for (int ks = 0; ks < 2; ++ks) { aa[ks] = *(const LAS bf16x8*)(lds + bo + LB_A + (16 * mt + r) * 144 + ks * 64 + q * 16); ak[ks] = *(const LAS bf16x8*)(lds + bo + LB_K + (16 * mt + r) * 144 + ks * 64 + q * 16); \
            bv[ks] = *(const LAS bf16x8*)(lds + L_VT + (16 * nt + r) * 144 + ks * 64 + q * 16); } \
        Sacc = Sacc * cd; \
        _Pragma("unroll") for (int ks = 0; ks < 2; ++ks) { oa = __builtin_amdgcn_mfma_f32_16x16x32_bf16(aa[ks], bv[ks], oa, 0, 0, 0); Sacc = __builtin_amdgcn_mfma_f32_16x16x32_bf16(ak[ks], bv[ks], Sacc, 0, 0, 0); } \
          \
        if (it + 1 < 256) { GS_WAIT(SL_NEXT, WAITN); GS_STORE(SL_NEXT, bn); } \
        *(LAS v2u*)(lds + L_ST + (16 * nt + r) * 144 + (16 * mt + 4 * q) * 2) = (v2u){pk2(Sacc.x, Sacc.y), pk2(Sacc.z, Sacc.w)}; \
        { bf16* op = od + ((size_t)b * SEQ + n * 64 + 16 * mt + 4 * q) * 512 + h * 64 + 16 * nt + r; \
          op[0] = (bf16)f2bf(oa.x); op[512] = (bf16)f2bf(oa.y); op[1024] = (bf16)f2bf(oa.z); op[1536] = (bf16)f2bf(oa.w); } \
        LDS_BARRIER(); ++it; } while (0)
    int it = 0;
    GS_STEP(1, 0, 10); GS_STEP(2, 1, 14);
    for (; it < 251; ) { GS_STEP(0, 2, 18); GS_STEP(1, 0, 18); GS_STEP(2, 1, 18); }
    GS_STEP(0, 2, 18); GS_STEP(1, 0, 18);
    GS_STEP(2, 1, 0); GS_STEP(0, 2, 0); GS_STEP(1, 0, 0);
#undef GS_STEP
#undef GS_LOAD
#undef GS_STORE
#undef GS_WAIT
#undef GS_WAIT2
}

__device__ __forceinline__ void ph_gdn_fin(Frame& F, int l) {
    const int gw = F.bid * NWAVES + F.wave, NGW = F.G * NWAVES, lane = F.lane;
    const bf16* of = (const bf16*)(F.ws + WS_OF); const bf16* ob = (const bf16*)(F.ws + WS_OB);
    const bf16* proj = (const bf16*)(F.ws + WS_P); bf16* y = (bf16*)(F.ws + WS_Y);
    const float* gnp = INP(I_GDN_NORM) + l * 64 + (lane & 7) * 8;
    const f32x4 g0 = *(const f32x4*)gnp, g1 = *(const f32x4*)(gnp + 4);
    const float gn[8] = {g0.x, g0.y, g0.z, g0.w, g1.x, g1.y, g1.z, g1.w};
    for (int m = gw; m < T; m += NGW) {
        const v4u a = *(const v4u*)(of + (size_t)m * 512 + lane * 8), c = *(const v4u*)(ob + (size_t)m * 512 + lane * 8), zz = *(const v4u*)(proj + (size_t)m * DINP + C_AZ + lane * 8);
        const float o[8] = {bflo(a.x) + bflo(c.x), bfhi(a.x) + bfhi(c.x), bflo(a.y) + bflo(c.y), bfhi(a.y) + bfhi(c.y), bflo(a.z) + bflo(c.z), bfhi(a.z) + bfhi(c.z), bflo(a.w) + bflo(c.w), bfhi(a.w) + bfhi(c.w)};
        const float z[8] = {bflo(zz.x), bfhi(zz.x), bflo(zz.y), bfhi(zz.y), bflo(zz.z), bfhi(zz.z), bflo(zz.w), bfhi(zz.w)};
        float ss = 0.f;
#pragma unroll
        for (int i = 0; i < 8; ++i) ss += o[i] * o[i];
        ss += __shfl_xor(ss, 1); ss += __shfl_xor(ss, 2); ss += __shfl_xor(ss, 4);
        const float r_ = 1.0f / sqrtf(ss * (1.0f / 64.0f) + EPS);
        float v[8];
#pragma unroll
        for (int i = 0; i < 8; ++i) v[i] = o[i] * r_ * gn[i] * (z[i] * __builtin_amdgcn_rcpf(1.0f + __expf(-z[i])));
        NTST((v4u*)(y + (size_t)m * D + lane * 8), ((v4u){pk2(v[0], v[1]), pk2(v[2], v[3]), pk2(v[4], v[5]), pk2(v[6], v[7])}));
    }
}

__device__ __forceinline__ void ph_hy_mlp(Frame& F, int l) {
    LAS float* zf = (LAS float*)F.lds;
    LAS float* h1 = (LAS float*)(F.lds + 16384);
    const float* w1 = INP(I_HY_W1) + (size_t)l * 33 * 64; const float* b1 = INP(I_HY_B1) + l * 64; const float* f1 = INP(I_HY_F1) + l * 64;
    const float* w2 = INP(I_HY_W2) + (size_t)l * 64 * 64; const float* b2 = INP(I_HY_B2) + l * 64; const float* f2 = INP(I_HY_F2) + l * 64;
    bf16* h2b = (bf16*)(F.ws + WS_H2T + (size_t)l * 2 * MiB);
    const int tid = F.tid, tl = tid & 63, jg = tid >> 6;
    for (int it = F.bid; it < FL / 64; it += F.G) {
        const int t0 = it * 64;
        for (int e = tid; e < 64 * 33; e += NTHR) { const int p = e / 33, f = e % 33, t = t0 + p; float val;
            if (f == 0) val = (float)t / (float)(FL - 1);
            else { const int i = (f - 1) & 15; const float fi = 1e-4f + (float)i * ((15.0f - 1e-4f) / 15.0f); const float w = 6.283185307179586f * (float)t / (float)FL; const float a = w * fi;
                   val = (f <= 16) ? cosf(a) : -sinf(a); }
            zf[p * 33 + f] = val; }
        __syncthreads();
#pragma unroll
        for (int jj = 0; jj < 8; ++jj) { const int j = jg * 8 + jj; float acc = b1[j];
            for (int i = 0; i < 33; ++i) acc += zf[tl * 33 + i] * w1[i * 64 + j];
            h1[tl * 65 + j] = sinf(f1[j] * acc); }
        __syncthreads();
#pragma unroll
        for (int jj = 0; jj < 8; ++jj) { const int j = jg * 8 + jj; float acc = b2[j];
            for (int i = 0; i < 64; ++i) acc += h1[tl * 65 + i] * w2[i * 64 + j];
            h2b[(size_t)(t0 + tl) * 64 + j] = (bf16)f2bf(sinf(f2[j] * acc)); }
        __syncthreads();
    }
}

__device__ __forceinline__ void ph_hy_expand(Frame& F, int l) {
    const bf16* h2b = (const bf16*)(F.ws + WS_H2T + (size_t)l * 2 * MiB); bf16* hT = (bf16*)(F.ws + WS_HT);
    const float* w3 = INP(I_HY_W3) + (size_t)l * 64 * 2048; const float* dl = INP(I_HY_DELTAS) + (size_t)l * 2048;
    const int gw = F.bid * NWAVES + F.wave, NGW = F.G * NWAVES, lane = F.lane, r32 = lane & 31, hi = lane >> 5;
    for (int task = gw; task < 64 * 32; task += NGW) {
        const int jt = task >> 5, tg = task & 31, j0 = jt * 32;
        bf16x8 af[4];
#pragma unroll
        for (int s = 0; s < 4; ++s) { float w[8];
#pragma unroll
            for (int i = 0; i < 8; ++i) w[i] = w3[(size_t)(16 * s + 8 * hi + i) * 2048 + j0 + r32];
            af[s] = __builtin_bit_cast(bf16x8, (v4u){pk2(w[0], w[1]), pk2(w[2], w[3]), pk2(w[4], w[5]), pk2(w[6], w[7])}); }
        float ad[16];
#pragma unroll
        for (int rg = 0; rg < 16; ++rg) ad[rg] = fabsf(dl[j0 + crow(rg, hi)]);
        for (int tt = 0; tt < 16; ++tt) {
            const int t0 = (tg * 16 + tt) * 32, t = t0 + r32;
            f32x16 acc = {0};
#pragma unroll
            for (int s = 0; s < 4; ++s) { const bf16x8 bfr = *(const bf16x8*)(h2b + (size_t)t * 64 + 16 * s + 8 * hi); acc = __builtin_amdgcn_mfma_f32_32x32x16_bf16(af[s], bfr, acc, 0, 0, 0); }
            const float tn = (float)t / (float)(FL - 1);
#pragma unroll
            for (int rg = 0; rg < 16; ++rg) hT[(size_t)(j0 + crow(rg, hi)) * FL + t] = (bf16)f2bf(acc[rg] * __expf(-tn * ad[rg]));
        }
    }
}

__device__ __forceinline__ void ph_hy_tin(Frame& F, int l) {
    LAS float* tile = (LAS float*)F.lds;
    const bf16* proj = (const bf16*)(F.ws + WS_P); bf16* uT = (bf16*)(F.ws + WS_UT);
    const float* cw = INP(I_HY_CONV) + (size_t)l * 3 * 1536;
    const int tid = F.tid;
    for (int it = F.bid; it < 2 * 256 * 24; it += F.G) {
        const int b = it / (256 * 24), r = it % (256 * 24), tt = r / 24, ct = r % 24, t0 = tt * 64, c0 = ct * 64;
        for (int e = tid; e < 66 * 8; e += NTHR) { const int row = e >> 3, ck = e & 7, t = t0 - 1 + row;
            v4u w = (v4u){0u, 0u, 0u, 0u};
            if (t >= 0 && t < SEQ) w = *(const v4u*)(proj + ((size_t)b * SEQ + t) * DINP + C_B + c0 + ck * 8);
            LAS float* d = tile + row * 65 + ck * 8;
            d[0] = bflo(w.x); d[1] = bfhi(w.x); d[2] = bflo(w.y); d[3] = bfhi(w.y); d[4] = bflo(w.z); d[5] = bfhi(w.z); d[6] = bflo(w.w); d[7] = bfhi(w.w); }
        __syncthreads();
        { const int chl = tid >> 3, tq = tid & 7, ch = c0 + chl; const float w0 = cw[ch], w1 = cw[1536 + ch], w2 = cw[3072 + ch];
          float v[8];
#pragma unroll
          for (int i = 0; i < 8; ++i) { const int tl = tq * 8 + i; v[i] = w0 * tile[tl * 65 + chl] + w1 * tile[(tl + 1) * 65 + chl] + w2 * tile[(tl + 2) * 65 + chl]; }
          v4u o; o.x = pk2(v[0], v[1]); o.y = pk2(v[2], v[3]); o.z = pk2(v[4], v[5]); o.w = pk2(v[6], v[7]);
          NTST((v4u*)(uT + ((size_t)b * 1536 + ch) * SEQ + t0 + tq * 8), o); }
        __syncthreads();
    }
}

#define FA(i) ((i) + (((i) >> 6) << 2))
__device__ __forceinline__ f32x2 cmul(f32x2 a, f32x2 b) { return (f32x2){a.x * b.x - a.y * b.y, a.x * b.y + a.y * b.x}; }
template <int K> __device__ __forceinline__ f32x2 cmul16(f32x2 a, bool conj) {
    constexpr float c16[8] = {1.000000000f, 0.923879533f, 0.707106781f, 0.382683432f, 0.000000000f, -0.382683432f, -0.707106781f, -0.923879533f}, s16[8] = {0.000000000f, 0.382683432f, 0.707106781f, 0.923879533f, 1.000000000f, 0.923879533f, 0.707106781f, 0.382683432f};
    const float c = c16[K], sn = conj ? s16[K] : -s16[K];
    if (K == 0) return a;
    if (K == 4) return conj ? (f32x2){-a.y, a.x} : (f32x2){a.y, -a.x};
    return (f32x2){a.x * c - a.y * sn, a.x * sn + a.y * c};
}
__device__ __forceinline__ f32x2 cmul_pk1(f32x2 a, f32x2 b) {
    f32x2 t, d;
    asm("v_pk_mul_f32 %0, %2, %3 op_sel_hi:[0,1]\n\ts_nop 0\n\tv_pk_fma_f32 %1, %2, %3, %0 op_sel:[1,1,0] op_sel_hi:[1,0,1] neg_lo:[0,1,0]" : "=&v"(t), "=&v"(d) : "v"(a), "v"(b));
    return d;
}
__device__ __forceinline__ void cmul_pk2(f32x2 a1, f32x2 b1, f32x2 a2, f32x2 b2, f32x2& d1, f32x2& d2) {
    f32x2 t1, t2;
    asm("v_pk_mul_f32 %0, %4, %5 op_sel_hi:[0,1]\n\tv_pk_mul_f32 %1, %6, %7 op_sel_hi:[0,1]\n\t"
        "v_pk_fma_f32 %2, %4, %5, %0 op_sel:[1,1,0] op_sel_hi:[1,0,1] neg_lo:[0,1,0]\n\tv_pk_fma_f32 %3, %6, %7, %1 op_sel:[1,1,0] op_sel_hi:[1,0,1] neg_lo:[0,1,0]"
        : "=&v"(t1), "=&v"(t2), "=&v"(d1), "=&v"(d2) : "v"(a1), "v"(b1), "v"(a2), "v"(b2));
}
template <int SP, bool INV> __device__ __forceinline__ void fft_r16_pass(LAS f32x2* Z, int tid) {
    constexpr int STR = (SP >= 64) ? (SP + SP / 16) : SP;
#pragma unroll
    for (int g = 0; g < 2; ++g) {
        const int grp = tid + NTHR * g, p = grp & (SP - 1), i0 = (grp / SP) * (16 * SP) + p;
        LAS f32x2* zb = Z + FA(i0);
        f32x2 e[16];
#pragma unroll
        for (int k = 0; k < 16; ++k) e[k] = zb[k * STR];
        const float fr = (float)p * (1.0f / (16.0f * (float)SP));
        const f32x2 w1 = (f32x2){__builtin_amdgcn_cosf(fr), INV ? __builtin_amdgcn_sinf(fr) : -__builtin_amdgcn_sinf(fr)};
        const f32x2 W16 = (f32x2){0.923879533f, INV ? 0.382683432f : -0.382683432f};
        f32x2 t1[8], t2[4], t3[2], t4;
        t1[0] = w1; t1[1] = cmul_pk1(w1, W16);
        cmul_pk2(t1[1], W16, t1[1], t1[1], t1[2], t2[1]);
        cmul_pk2(t1[2], W16, w1, w1, t1[3], t2[0]);
        cmul_pk2(t1[3], W16, t1[2], t1[2], t1[4], t2[2]);
        cmul_pk2(t1[4], W16, t1[3], t1[3], t1[5], t2[3]);
        cmul_pk2(t1[5], W16, t2[0], t2[0], t1[6], t3[0]);
        cmul_pk2(t1[6], W16, t2[1], t2[1], t1[7], t3[1]);
        t4 = cmul_pk1(t3[0], t3[0]);
#define R16_BF2(a1_, b1_, T1, a2_, b2_, T2) do { if (!INV) { const f32x2 s1_ = e[a1_] + e[b1_], d1_ = e[a1_] - e[b1_], s2_ = e[a2_] + e[b2_], d2_ = e[a2_] - e[b2_]; e[a1_] = s1_; e[a2_] = s2_; cmul_pk2(d1_, T1, d2_, T2, e[b1_], e[b2_]); } \
                                               else { f32x2 u1_, u2_; cmul_pk2(e[b1_], T1, e[b2_], T2, u1_, u2_); e[b1_] = e[a1_] - u1_; e[a1_] = e[a1_] + u1_; e[b2_] = e[a2_] - u2_; e[a2_] = e[a2_] + u2_; } } while (0)
#define R16_ST1() do { R16_BF2(0, 8, t1[0], 1, 9, t1[1]); R16_BF2(2, 10, t1[2], 3, 11, t1[3]); R16_BF2(4, 12, t1[4], 5, 13, t1[5]); R16_BF2(6, 14, t1[6], 7, 15, t1[7]); } while (0)
#define R16_ST2() do { R16_BF2(0, 4, t2[0], 8, 12, t2[0]); R16_BF2(1, 5, t2[1], 9, 13, t2[1]); R16_BF2(2, 6, t2[2], 10, 14, t2[2]); R16_BF2(3, 7, t2[3], 11, 15, t2[3]); } while (0)
#define R16_ST3() do { R16_BF2(0, 2, t3[0], 4, 6, t3[0]); R16_BF2(8, 10, t3[0], 12, 14, t3[0]); R16_BF2(1, 3, t3[1], 5, 7, t3[1]); R16_BF2(9, 11, t3[1], 13, 15, t3[1]); } while (0)
#define R16_ST4() do { R16_BF2(0, 1, t4, 2, 3, t4); R16_BF2(4, 5, t4, 6, 7, t4); R16_BF2(8, 9, t4, 10, 11, t4); R16_BF2(12, 13, t4, 14, 15, t4); } while (0)
        if (!INV) { R16_ST1(); R16_ST2(); R16_ST3(); R16_ST4(); } else { R16_ST4(); R16_ST3(); R16_ST2(); R16_ST1(); }
#undef R16_BF2
#undef R16_ST1
#undef R16_ST2
#undef R16_ST3
#undef R16_ST4
#pragma unroll
        for (int k = 0; k < 16; ++k) zb[k * STR] = e[k];
    }
    __syncthreads();
}
template <bool INV> __device__ __forceinline__ void fft_r4_pass(LAS f32x2* Z, int tid) {
#pragma unroll 4
    for (int g = 0; g < 8; ++g) {
        const int i0 = (tid + NTHR * g) * 4;
        LAS f32x4* zp = (LAS f32x4*)(Z + FA(i0));
        const f32x4 u = zp[0], v = zp[1];
        const f32x2 e0 = (f32x2){u.x, u.y}, e1 = (f32x2){u.z, u.w}, e2 = (f32x2){v.x, v.y}, e3 = (f32x2){v.z, v.w};
        f32x2 r0, r1, r2, r3;
        if (!INV) { const f32x2 a0 = e0 + e2, a2 = e0 - e2, a1 = e1 + e3, d = e1 - e3; const f32x2 a3 = (f32x2){d.y, -d.x};
                    r0 = a0 + a1; r1 = a0 - a1; r2 = a2 + a3; r3 = a2 - a3; }
        else { const f32x2 s0 = e0 + e1, s1 = e0 - e1, s2 = e2 + e3, s3 = e2 - e3; const f32x2 c = (f32x2){-s3.y, s3.x};
               r0 = s0 + s2; r2 = s0 - s2; r1 = s1 + c; r3 = s1 - c; }
        zp[0] = (f32x4){r0.x, r0.y, r1.x, r1.y}; zp[1] = (f32x4){r2.x, r2.y, r3.x, r3.y};
    }
    __syncthreads();
}
__device__ __forceinline__ void fft_fwd(LAS f32x2* Z, int tid) { fft_r16_pass<1024, false>(Z, tid); fft_r16_pass<64, false>(Z, tid); fft_r16_pass<4, false>(Z, tid); fft_r4_pass<false>(Z, tid); }
__device__ __forceinline__ void fft_inv(LAS f32x2* Z, int tid) { fft_r4_pass<true>(Z, tid); fft_r16_pass<4, true>(Z, tid); fft_r16_pass<64, true>(Z, tid); fft_r16_pass<1024, true>(Z, tid); }
__device__ __forceinline__ void ld8bf(const bf16* p, float (&v)[8]) { const v4u w = *(const v4u*)p; v[0] = bflo(w.x); v[1] = bfhi(w.x); v[2] = bflo(w.y); v[3] = bfhi(w.y); v[4] = bflo(w.z); v[5] = bfhi(w.z); v[6] = bflo(w.w); v[7] = bfhi(w.w); }
__device__ __forceinline__ void ph_hy_fft(Frame& F, int l) {
    LAS f32x2* Z = (LAS f32x2*)F.lds;
    volatile LAS float* red = (volatile LAS float*)(F.lds + MISC_OFF + 64);
    const bf16* hT = (const bf16*)(F.ws + WS_HT);
    const bf16* uT = (const bf16*)(F.ws + WS_UT); float* yT = (float*)(F.ws + WS_YT);
    f32x2* scr = (f32x2*)(F.ws + WS_FSCR) + (size_t)F.bid * (4 * FL);
    f32x2* KE = scr; f32x2* KO = scr + FL; f32x2* R1 = scr + 2 * FL; f32x2* Y0 = scr + 3 * FL;
    const int tid = F.tid;
#define FQ_LOOP _Pragma("unroll 2") for (int q = 0; q < 4; ++q)
#define FQ_IDX const int ck = tid + NTHR * q, n0 = 8 * ck; LAS f32x4* z4 = (LAS f32x4*)(Z + FA(n0))
    for (int c = F.bid; c < 512; c += F.G) {
        for (int o = 0; o < 2; ++o) {
            const bf16* hf = hT + (size_t)((o * 2 + 0) * 512 + c) * FL; const bf16* hb = hT + (size_t)((o * 2 + 1) * 512 + c) * FL;
            const float bias = INP(I_HY_BIAS)[(l * 2 + o) * 512 + c];
            const bf16* v0 = uT + ((size_t)0 * 1536 + 1024 + c) * SEQ; const bf16* v1 = uT + ((size_t)1 * 1536 + 1024 + c) * SEQ;
#define FQ_LOADZ(zz) f32x4 zz[4]; if (o == 0) { float p0_[8], p1_[8]; ld8bf(v0 + n0, p0_); ld8bf(v1 + n0, p1_); _Pragma("unroll") for (int jj = 0; jj < 4; ++jj) zz[jj] = (f32x4){p0_[2 * jj], p1_[2 * jj], p0_[2 * jj + 1], p1_[2 * jj + 1]}; } \
                     else { const f32x4* y4_ = (const f32x4*)(Y0 + n0); _Pragma("unroll") for (int jj = 0; jj < 4; ++jj) zz[jj] = y4_[jj]; }
            float sc = 0.f;
#pragma nounroll
            for (int k = 0; k < 6; ++k) {
                if (k == 0) {
                    float part = 0.f;
                    FQ_LOOP { FQ_IDX; float a[8], bch[8], br[8]; ld8bf(hf + n0, a); ld8bf(hb + (FL - 8 - n0), bch);
                        br[0] = (ck >= 1) ? bf2f(hb[FL - n0]) : 0.f;
#pragma unroll
                        for (int j = 1; j < 8; ++j) br[j] = bch[8 - j];
#pragma unroll
                        for (int j = 0; j < 8; ++j) part += fabsf(a[j]) + fabsf(br[j]);
#pragma unroll
                        for (int jj = 0; jj < 4; ++jj) z4[jj] = (f32x4){a[2 * jj] + br[2 * jj], 0.f, a[2 * jj + 1] + br[2 * jj + 1], 0.f}; }
                    part = wave_sum(part);
                    if (F.lane == 0) red[F.wave] = part;
                    __syncthreads();
                    float nrm = 0.f;
#pragma unroll
                    for (int w = 0; w < NWAVES; ++w) nrm += red[w];
                    sc = 1.0f / (2.0f * (float)FL * (nrm + EPS));
                } else if (k == 1) {
                    FQ_LOOP { FQ_IDX; f32x4* k4 = (f32x4*)(KE + n0); float a[8], bch[8], br[8]; ld8bf(hf + n0, a); ld8bf(hb + (FL - 8 - n0), bch);
                        br[0] = (ck >= 1) ? bf2f(hb[FL - n0]) : 0.f;
#pragma unroll
                        for (int j = 1; j < 8; ++j) br[j] = bch[8 - j];
#pragma unroll
                        for (int jj = 0; jj < 4; ++jj) { k4[jj] = z4[jj];
                            const float d0 = a[2 * jj] - br[2 * jj], d1 = a[2 * jj + 1] - br[2 * jj + 1]; const float f0 = (float)(n0 + 2 * jj) * (0.5f / (float)FL), f1 = (float)(n0 + 2 * jj + 1) * (0.5f / (float)FL);
                            z4[jj] = (f32x4){d0 * __builtin_amdgcn_cosf(f0), -d0 * __builtin_amdgcn_sinf(f0), d1 * __builtin_amdgcn_cosf(f1), -d1 * __builtin_amdgcn_sinf(f1)}; } }
                } else if (k == 2) {
                    FQ_LOOP { FQ_IDX; f32x4* k4 = (f32x4*)(KO + n0); FQ_LOADZ(zv);
#pragma unroll
                        for (int jj = 0; jj < 4; ++jj) { k4[jj] = z4[jj]; z4[jj] = zv[jj]; } }
                } else if (k == 3 || k == 5) {
                    const f32x2* KX = (k == 3) ? KE : KO;
                    FQ_LOOP { FQ_IDX; const f32x4* k4 = (const f32x4*)(KX + n0);
#pragma unroll
                        for (int jj = 0; jj < 4; ++jj) { const f32x4 a = z4[jj], kk = k4[jj]; z4[jj] = (f32x4){a.x * kk.x - a.y * kk.y, a.x * kk.y + a.y * kk.x, a.z * kk.z - a.w * kk.w, a.z * kk.w + a.w * kk.z}; } }
                } else {
                    FQ_LOOP { FQ_IDX; f32x4* r4 = (f32x4*)(R1 + n0); FQ_LOADZ(zv);
#pragma unroll
                        for (int jj = 0; jj < 4; ++jj) { r4[jj] = z4[jj]; const float f0 = (float)(n0 + 2 * jj) * (0.5f / (float)FL), f1 = (float)(n0 + 2 * jj + 1) * (0.5f / (float)FL);
                            const float c0 = __builtin_amdgcn_cosf(f0), s0 = -__builtin_amdgcn_sinf(f0), c1 = __builtin_amdgcn_cosf(f1), s1 = -__builtin_amdgcn_sinf(f1); const f32x4 z = zv[jj];
                            z4[jj] = (f32x4){z.x * c0 - z.y * s0, z.x * s0 + z.y * c0, z.z * c1 - z.w * s1, z.z * s1 + z.w * c1}; } }
                }
                __syncthreads();
                if (k == 3 || k == 5) fft_inv(Z, tid); else fft_fwd(Z, tid);
            }
            const bf16* x0 = uT + ((size_t)0 * 1536 + o * 512 + c) * SEQ; const bf16* x1 = uT + ((size_t)1 * 1536 + o * 512 + c) * SEQ;
            FQ_LOOP { FQ_IDX; FQ_LOADZ(zv); float g0[8], g1[8]; ld8bf(x0 + n0, g0); ld8bf(x1 + n0, g1); const f32x4* r4 = (const f32x4*)(R1 + n0);
                f32x4 ov[4];
#pragma unroll
                for (int jj = 0; jj < 4; ++jj) { const float f0 = (float)(n0 + 2 * jj) * (0.5f / (float)FL), f1 = (float)(n0 + 2 * jj + 1) * (0.5f / (float)FL);
                    const float c0 = __builtin_amdgcn_cosf(f0), s0 = __builtin_amdgcn_sinf(f0), c1 = __builtin_amdgcn_cosf(f1), s1 = __builtin_amdgcn_sinf(f1);
                    const f32x4 r2 = z4[jj], r1 = r4[jj], z = zv[jj];
                    const float ax = (r1.x + (r2.x * c0 - r2.y * s0)) * sc, ay = (r1.y + (r2.x * s0 + r2.y * c0)) * sc, bx = (r1.z + (r2.z * c1 - r2.w * s1)) * sc, by = (r1.w + (r2.z * s1 + r2.w * c1)) * sc;
                    ov[jj] = (f32x4){g0[2 * jj] * (ax + z.x * bias), g1[2 * jj] * (ay + z.y * bias), g0[2 * jj + 1] * (bx + z.z * bias), g1[2 * jj + 1] * (by + z.w * bias)}; }
                if (o == 0) { f32x4* y4 = (f32x4*)(Y0 + n0);
#pragma unroll
                    for (int jj = 0; jj < 4; ++jj) y4[jj] = ov[jj]; }
                else { f32x4* ya = (f32x4*)(yT + ((size_t)0 * 512 + c) * SEQ + n0); f32x4* yb = (f32x4*)(yT + ((size_t)1 * 512 + c) * SEQ + n0);
                    NTST(ya, ((f32x4){ov[0].x, ov[0].z, ov[1].x, ov[1].z})); NTST(ya + 1, ((f32x4){ov[2].x, ov[2].z, ov[3].x, ov[3].z}));
                    NTST(yb, ((f32x4){ov[0].y, ov[0].w, ov[1].y, ov[1].w})); NTST(yb + 1, ((f32x4){ov[2].y, ov[2].w, ov[3].y, ov[3].w})); } }
            __syncthreads();
        }
    }
#undef FQ_LOOP
#undef FQ_IDX
#undef FQ_LOADZ
}

__device__ __forceinline__ void ph_hy_fin(Frame& F, int l) {
    LAS float* tile = (LAS float*)F.lds;
    const float* yT = (const float*)(F.ws + WS_YT); bf16* y = (bf16*)(F.ws + WS_Y);
    const float* hn = INP(I_HY_NORM) + l * 512;
    const int tid = F.tid, lane = F.lane;
    for (int it = F.bid; it < 2 * 512; it += F.G) {
        const int b = it >> 9, t0 = (it & 511) * 32;
        for (int e = tid; e < 512 * 8; e += NTHR) { const int ch = e >> 3, q = e & 7; const f32x4 v = *(const f32x4*)(yT + ((size_t)b * 512 + ch) * SEQ + t0 + q * 4);
            LAS float* d = tile + ch * 33 + q * 4; d[0] = v.x; d[1] = v.y; d[2] = v.z; d[3] = v.w; }
        __syncthreads();
#pragma unroll
        for (int k = 0; k < 4; ++k) { const int tl = F.wave * 4 + k; float v[8]; float ss = 0.f;
#pragma unroll
            for (int i = 0; i < 8; ++i) { v[i] = tile[(lane + 64 * i) * 33 + tl]; ss += v[i] * v[i]; }
            const float r = 1.0f / sqrtf(wave_sum(ss) * (1.0f / 512.0f) + EPS);
            bf16* yr = y + ((size_t)b * SEQ + t0 + tl) * D + 512;
#pragma unroll
            for (int i = 0; i < 8; ++i) yr[lane + 64 * i] = (bf16)f2bf(v[i] * r * hn[lane + 64 * i]); }
        __syncthreads();
    }
}

__device__ __forceinline__ void ph_at_prep(Frame& F, int l) {
    const int gw = F.bid * NWAVES + F.wave, NGW = F.G * NWAVES, lane = F.lane;
    const bf16* proj = (const bf16*)(F.ws + WS_P);
    bf16* Qp = (bf16*)(F.ws + WS_QP); bf16* Kp = (bf16*)(F.ws + WS_KP); bf16* VtC = (bf16*)(F.ws + WS_VTC); bf16* Vp = (bf16*)(F.ws + WS_VP);
    const float qg = INP(I_GA_QN)[l * 64 + lane], kg = INP(I_GA_KN)[l * 64 + lane];
    const int half = lane >> 5, i16 = lane & 15, second = (lane >> 4) & 1;
    const float invf_rev = exp2f(-(float)i16 * (1.0f / 16.0f) * 13.287712379549449f) * 0.15915494309189535f;
    for (int m = gw; m < T; m += NGW) {
        const int b = m / SEQ, t = m % SEQ;
        const bf16* pr = proj + (size_t)m * DINP;
        bf16 raw[14];
#pragma unroll
        for (int s = 0; s < 8; ++s) raw[s] = pr[C_DQ + s * 64 + lane];
        raw[8] = pr[C_DKV + lane]; raw[9] = pr[C_DKV + 64 + lane]; raw[10] = pr[C_CKV + 128 + lane]; raw[11] = pr[C_CKV + 192 + lane]; raw[12] = pr[C_DKV + 128 + lane]; raw[13] = pr[C_DKV + 192 + lane];
        const float rev = (float)(half ? (t & 63) : (t >> 6)) * invf_rev;
        const float sn = __builtin_amdgcn_sinf(rev), cs = __builtin_amdgcn_cosf(rev);
#pragma unroll
        for (int s = 0; s < 10; ++s) {
            const float x = bf2f(raw[s]);
            const float ss = wave_sum(x * x);
            const float xn = x * (1.0f / sqrtf(ss * (1.0f / 64.0f) + EPS)) * ((s < 8) ? qg : kg);
            const float other = __shfl_xor(xn, 16);
            const float o = second ? (xn * cs + other * sn) : (xn * cs - other * sn);
            if (s < 8) Qp[(size_t)m * 512 + s * 64 + lane] = (bf16)f2bf(o * C2);
            else Kp[(size_t)m * 128 + (s - 8) * 64 + lane] = (bf16)f2bf(o);
        }
#pragma unroll
        for (int kh = 0; kh < 2; ++kh) { VtC[((size_t)(b * 2 + kh) * 64 + lane) * SEQ + t] = raw[10 + kh]; Vp[(size_t)m * 128 + kh * 64 + lane] = raw[12 + kh]; }
    }
}

template <bool SWA>
__device__ __forceinline__ void attn_wave(const bf16* Q, int qpitch, const bf16* K, int kpitch, const bf16* Vt, bf16* O, int q0, int lane, float slope2, float sink2, float qscale) {
    const int r32 = lane & 31, hi = lane >> 5;
    bf16x8 qf[4];
#pragma unroll
    for (int s = 0; s < 4; ++s) qf[s] = *(const bf16x8*)(Q + (size_t)(q0 + r32) * qpitch + 16 * s + 8 * hi);
    f32x16 o0 = {0}, o1 = {0};
    float m_run = -1e30f, l_run = 0.f;
    int kt_lo, kt_hi;
    if (SWA) { kt_lo = (q0 - 128) / 32; if (kt_lo < 0) kt_lo = 0; kt_hi = (q0 + 31 + 128) / 32; if (kt_hi > SEQ / 32 - 1) kt_hi = SEQ / 32 - 1; }
    else { kt_lo = 0; kt_hi = SEQ / 32 - 1; }
    const int qpos = q0 + r32;
    for (int kt = kt_lo; kt <= kt_hi; ++kt) {
        const int k0 = kt * 32;
        f32x16 st = {0};
#pragma unroll
        for (int s = 0; s < 4; ++s) { const bf16x8 kf = *(const bf16x8*)(K + (size_t)(k0 + r32) * kpitch + 16 * s + 8 * hi);
            st = __builtin_amdgcn_mfma_f32_32x32x16_bf16(kf, qf[s], st, 0, 0, 0); }
        float mx = -1e30f;
#pragma unroll
        for (int r = 0; r < 16; ++r) {
            float v = st[r];
            if (SWA) { const int kv = k0 + crow(r, hi); int dist = qpos - kv; dist = dist < 0 ? -dist : dist; v = v * qscale - slope2 * (float)dist; if (dist > 128) v = -1e30f; }
            st[r] = v; mx = fmaxf(mx, v);
        }
        mx = fmaxf(mx, __shfl_xor(mx, 32));
        const float m_new = fmaxf(m_run, mx);
        const float alpha = exp2f(m_run - m_new);
        float rs = 0.f;
#pragma unroll
        for (int r = 0; r < 16; ++r) { const float p = (st[r] <= -1e29f) ? 0.f : exp2f(st[r] - m_new); st[r] = p; rs += p; }
        rs += __shfl_xor(rs, 32);
        l_run = l_run * alpha + rs; m_run = m_new;
#pragma unroll
        for (int r = 0; r < 16; ++r) { o0[r] *= alpha; o1[r] *= alpha; }
#pragma unroll
        for (int s = 0; s < 2; ++s) {
            v4u pw; pw.x = pk2(st[8 * s + 0], st[8 * s + 1]); pw.y = pk2(st[8 * s + 2], st[8 * s + 3]); pw.z = pk2(st[8 * s + 4], st[8 * s + 5]); pw.w = pk2(st[8 * s + 6], st[8 * s + 7]);
            const bf16x8 pf = __builtin_bit_cast(bf16x8, pw);
#pragma unroll
            for (int db = 0; db < 2; ++db) {
                const bf16* vp = Vt + (size_t)(db * 32 + r32) * SEQ + k0 + 16 * s + 4 * hi;
                const v2u a = *(const v2u*)vp, c = *(const v2u*)(vp + 8);
                const bf16x8 vf = __builtin_bit_cast(bf16x8, (v4u){a.x, a.y, c.x, c.y});
                if (db == 0) o0 = __builtin_amdgcn_mfma_f32_32x32x16_bf16(vf, pf, o0, 0, 0, 0);
                else o1 = __builtin_amdgcn_mfma_f32_32x32x16_bf16(vf, pf, o1, 0, 0, 0);
            }
        }
    }
    float den = l_run;
    if (SWA) den += exp2f(sink2 - m_run);
    const float inv = 1.0f / den;
    bf16* orow = O + (size_t)(q0 + r32) * 512;
#pragma unroll
    for (int g = 0; g < 4; ++g) {
        v2u w0, w1;
        w0.x = pk2(o0[4 * g] * inv, o0[4 * g + 1] * inv); w0.y = pk2(o0[4 * g + 2] * inv, o0[4 * g + 3] * inv);
        w1.x = pk2(o1[4 * g] * inv, o1[4 * g + 1] * inv); w1.y = pk2(o1[4 * g + 2] * inv, o1[4 * g + 3] * inv);
        *(v2u*)(orow + 8 * g + 4 * hi) = w0; *(v2u*)(orow + 32 + 8 * g + 4 * hi) = w1;
    }
}
__device__ __forceinline__ void ph_at_global(Frame& F, int l) {
    typedef attn_body::bf16 abf;
    const abf* Qp = (const abf*)(F.ws + WS_QP); const abf* Kp = (const abf*)(F.ws + WS_KP); const abf* Vp = (const abf*)(F.ws + WS_VP); abf* og = (abf*)(F.ws + WS_OGD);
    float gq = fabsf(INP(I_GA_QN)[l * 64 + F.lane]), gk = fabsf(INP(I_GA_KN)[l * 64 + F.lane]);
#pragma unroll
    for (int o = 1; o < 64; o <<= 1) { gq = fmaxf(gq, __shfl_xor(gq, o)); gk = fmaxf(gk, __shfl_xor(gk, o)); }
    const float mshift = 64.0f * C2 * gq * gk;
    for (int i = 0; ; ++i) {
        int b, hq, qb;
        if (F.G == 256) { if (i >= 4) break; const int x = F.bid & 7, ul = (F.bid >> 3) * 4 + i; b = x >> 2; hq = ((x >> 1) & 1) * 4 + (x & 1) * 2 + (ul >> 6); qb = ul & 63; }
        else { const int u = F.bid + i * F.G; if (u >= 1024) break; b = u >> 9; hq = (u >> 6) & 7; qb = u & 63; }
        const int kh = hq >> 2;
        attn_body::attn_unit<8, 512, 128, 128, 512, true>(qb * 256, SEQ / 64, Qp + (size_t)b * SEQ * 512 + hq * 64, Kp + (size_t)b * SEQ * 128 + kh * 64,
                                                     Vp + (size_t)b * SEQ * 128 + kh * 64, og + (size_t)b * SEQ * 512 + hq * 64, (char*)F.lds, mshift);
    }
}
__device__ __forceinline__ void ph_at_swa(Frame& F, int l) {
    const bf16* proj = (const bf16*)(F.ws + WS_P); const bf16* VtC = (const bf16*)(F.ws + WS_VTC); bf16* og = (bf16*)(F.ws + WS_OGC);
    for (int u = F.bid; u < 1024; u += F.G) {
        const int b = u >> 9, hq = (u >> 6) & 7, qt = u & 63, kh = hq >> 2;
        const float slope = exp2f(-(float)(hq + 1)); const float sink = INP(I_SWA_SINK)[l * 8 + hq];
        attn_wave<true>(proj + (size_t)b * SEQ * DINP + C_CQ + hq * 64, DINP, proj + (size_t)b * SEQ * DINP + C_CKV + kh * 64, DINP, VtC + (size_t)(b * 2 + kh) * 64 * SEQ,
                        og + (size_t)b * SEQ * 512 + hq * 64, qt * 256 + F.wave * 32, F.lane, slope * LOG2E, sink * LOG2E, C2);
    }
}
__device__ __forceinline__ void ph_at_fin(Frame& F, int l) {
    const int gw = F.bid * NWAVES + F.wave, NGW = F.G * NWAVES, lane = F.lane;
    bf16* y = (bf16*)(F.ws + WS_Y);
    const float* gnc = INP(I_SWA_NORM) + l * 512 + lane * 8; const float* gnd = INP(I_GA_NORM) + l * 512 + lane * 8;
    const f32x4 gc0 = *(const f32x4*)gnc, gc1 = *(const f32x4*)(gnc + 4), gd0 = *(const f32x4*)gnd, gd1 = *(const f32x4*)(gnd + 4);
    for (int m0 = gw * 2; m0 < T; m0 += NGW * 2) {
        v4u w[4];
#pragma unroll
        for (int k = 0; k < 4; ++k) w[k] = *(const v4u*)((const bf16*)(F.ws + ((k & 1) ? WS_OGD : WS_OGC)) + (size_t)(m0 + (k >> 1)) * 512 + lane * 8);
#pragma unroll
        for (int k = 0; k < 4; ++k) { const int grp = k & 1, m = m0 + (k >> 1);
            float v[8] = {bflo(w[k].x), bfhi(w[k].x), bflo(w[k].y), bfhi(w[k].y), bflo(w[k].z), bfhi(w[k].z), bflo(w[k].w), bfhi(w[k].w)};
            float ss = 0.f;
#pragma unroll
            for (int i = 0; i < 8; ++i) ss += v[i] * v[i];
            const float r = 1.0f / sqrtf(wave_sum(ss) * (1.0f / 512.0f) + EPS);
            const f32x4 g0 = grp ? gd0 : gc0, g1 = grp ? gd1 : gc1;
            v4u o; o.x = pk2(v[0] * r * g0.x, v[1] * r * g0.y); o.y = pk2(v[2] * r * g0.z, v[3] * r * g0.w); o.z = pk2(v[4] * r * g1.x, v[5] * r * g1.y); o.w = pk2(v[6] * r * g1.z, v[7] * r * g1.w);
            NTST((v4u*)(y + (size_t)m * D + 1024 + grp * 512 + lane * 8), o); }
    }
}

__device__ __forceinline__ void ph_moe_route(Frame& F, int l) {
    LAS float* scr = (LAS float*)(F.lds + F.wave * 16640);
    const int gw = F.bid * NWAVES + F.wave, NGW = F.G * NWAVES, lane = F.lane;
    constexpr int IT_G = (D / 64) * (DE / 64), IT_D = (DE / 64) * (D / 64);
    for (int it = gw; it < NE * (2 * IT_G + IT_D); it += NGW) {
        const int e = it / (2 * IT_G + IT_D); int r = it % (2 * IT_G + IT_D);
        if (r < 2 * IT_G) { const int up = r / IT_G; r %= IT_G; const int nblk = DE / 64, kb = r / nblk, nb = r % nblk, j0 = nb * 64;
            const float* W = (up ? INP(I_MOE_UP) : INP(I_MOE_GATE)) + ((size_t)l * NE + e) * D * DE;
            transpose_tile64(W, DE, kb * 64, j0, (bf16*)(F.ws + WS_GUT) + (size_t)e * 1024 * D, D, (j0 >> 7) * 256 + up * 128 + (j0 & 127), scr, lane); }
        else { r -= 2 * IT_G; const int nblk = D / 64, kb = r / nblk, nb = r % nblk;
            const float* W = INP(I_MOE_DOWN) + ((size_t)l * NE + e) * DE * D;
            transpose_tile64(W, D, kb * 64, nb * 64, (bf16*)(F.ws + WS_DT) + (size_t)e * D * DE, DE, nb * 64, scr, lane); }
    }
    const float* x = F.out; const float* g = INP(I_NORM_FFN) + (size_t)l * D;
    const float* wg = (const float*)(F.ws + WS_WRT) + (size_t)l * D * 64;
    bf16* xn = (bf16*)(F.ws + WS_XN); int* info = (int*)(F.ws + WS_INFO); int* elist = (int*)(F.ws + WS_ELIST);
    unsigned* cnt = (unsigned*)(F.ctl + CW_CNT + l * 64);
    LAS float* red = (LAS float*)F.lds;
    LAS float* part = (LAS float*)(F.lds + 36864);
    LAS float* fin = (LAS float*)(F.lds + 36864 + 1024);
    LAS float* rsd = (LAS float*)(F.lds + 36864 + 1024 + 4736);
    const int wave = F.wave, i32 = lane & 31, kk = lane >> 5;
    __syncthreads();
    for (int tile = F.bid; tile < T / 32; tile += F.G) {
        const int t0 = tile * 32;
        const float* xp = x + (size_t)(t0 + i32) * D + 256 * wave + 4 * kk;
        f32x4 x4[32]; float ss = 0.f;
#pragma unroll
        for (int m = 0; m < 32; ++m) x4[m] = *(const f32x4*)(xp + 8 * m);
        f32x16 acc0 = {0}, acc1 = {0};
        const float* wp = wg + (size_t)(256 * wave + 4 * kk) * 64 + i32;
        float bq[5][8];
        const float* wpm = wp;
#define RT_LOADB(slot_) do { _Pragma("unroll") for (int s = 0; s < 4; ++s) { bq[slot_][2 * s] = wpm[s * 64]; bq[slot_][2 * s + 1] = wpm[s * 64 + 32]; } wpm += 8 * 64; asm volatile("" : "+v"(wpm)); } while (0)
        RT_LOADB(0); RT_LOADB(1); RT_LOADB(2); RT_LOADB(3);
#pragma unroll
        for (int m = 0; m < 32; ++m) {
            if (m + 4 < 32) RT_LOADB((m + 4) % 5);
            __builtin_amdgcn_sched_barrier(0);
            ss += (x4[m].x * x4[m].x + x4[m].y * x4[m].y) + (x4[m].z * x4[m].z + x4[m].w * x4[m].w);
#pragma unroll
            for (int s = 0; s < 4; ++s) { acc0 = __builtin_amdgcn_mfma_f32_32x32x2f32(x4[m][s], bq[m % 5][2 * s], acc0, 0, 0, 0); acc1 = __builtin_amdgcn_mfma_f32_32x32x2f32(x4[m][s], bq[m % 5][2 * s + 1], acc1, 0, 0, 0); }
            __builtin_amdgcn_sched_barrier(0);
        }
#undef RT_LOADB
        ss += __shfl_xor(ss, 32);
        if (kk == 0) part[wave * 32 + i32] = ss;
#pragma unroll
        for (int rg = 0; rg < 16; ++rg) { const int row = crow(rg, kk); red[(wave * 32 + row) * 36 + i32] = acc0[rg]; if (i32 < 4) red[(wave * 32 + row) * 36 + 32 + i32] = acc1[rg]; }
        __syncthreads();
        for (int e_ = F.tid; e_ < 32 * 36; e_ += NTHR) { const int row = e_ / 36, col = e_ % 36; float a = 0.f;
#pragma unroll
            for (int w = 0; w < 8; ++w) a += red[(w * 32 + row) * 36 + col];
            fin[row * 37 + col] = a; }
        if (F.tid < 32) { float a = 0.f;
#pragma unroll
            for (int w = 0; w < 8; ++w) a += part[w * 32 + F.tid];
            rsd[F.tid] = 1.0f / sqrtf(a * (1.0f / D) + EPS); }
        __syncthreads();
        if (F.tid < 32) {
            const int m = t0 + F.tid; const float rstd = rsd[F.tid]; const LAS float* lg = fin + F.tid * 37;
            float gl[4];
#pragma unroll
            for (int q = 0; q < 4; ++q) gl[q] = lg[32 + q] * rstd + INP(I_MOE_BG)[l * 4 + q];
            int gi = 0; float gmax = gl[0];
#pragma unroll
            for (int q = 1; q < 4; ++q) if (gl[q] > gmax) { gmax = gl[q]; gi = q; }
            float gsum = 0.f;
#pragma unroll
            for (int q = 0; q < 4; ++q) gsum += expf(gl[q] - gmax);
            const float g_w = 1.0f / gsum;
            float el[8];
#pragma unroll
            for (int q = 0; q < 8; ++q) el[q] = lg[gi * 8 + q] * rstd + INP(I_MOE_BE)[l * 32 + gi * 8 + q];
            int i1 = 0; float v1 = el[0];
#pragma unroll
            for (int q = 1; q < 8; ++q) if (el[q] > v1) { v1 = el[q]; i1 = q; }
            int i2 = -1; float v2 = -3.0e38f;
#pragma unroll
            for (int q = 0; q < 8; ++q) if (q != i1 && el[q] > v2) { v2 = el[q]; i2 = q; }
            const float ex = expf(v2 - v1); const float w1 = g_w / (1.0f + ex), w2 = g_w * ex / (1.0f + ex);
            const int e1 = gi * 8 + i1, e2 = gi * 8 + i2;
            const unsigned s1 = __hip_atomic_fetch_add(cnt + e1, 1u, RLX_AGENT), s2 = __hip_atomic_fetch_add(cnt + e2, 1u, RLX_AGENT);
            int* rec = info + (size_t)m * 8; rec[0] = e1; rec[1] = e2; rec[2] = (int)s1; rec[3] = (int)s2; rec[4] = __builtin_bit_cast(int, w1); rec[5] = __builtin_bit_cast(int, w2);
            elist[(size_t)e1 * T + s1] = m; elist[(size_t)e2 * T + s2] = m;
        }
        { const float rstd = rsd[i32]; const float* gp = g + 256 * wave + 4 * kk; LAS unsigned char* stg = F.lds + 49152 + wave * 4608;
#pragma unroll
          for (int c = 0; c < 4; ++c) {
#pragma unroll
              for (int mm = 0; mm < 8; ++mm) { const int m = 8 * c + mm; const f32x4 gv = *(const f32x4*)(gp + 8 * m); const f32x4 o = x4[m] * rstd * gv;
                  *(LAS v2u*)(stg + i32 * 144 + mm * 16 + kk * 8) = (v2u){pk2(o.x, o.y), pk2(o.z, o.w)}; }
              LDS_WAIT();
#pragma unroll
              for (int q = 0; q < 4; ++q) { const int row = 8 * q + (lane >> 3), ch = lane & 7; const v4u v = *(const LAS v4u*)(stg + row * 144 + ch * 16);
                  *(v4u*)(xn + (size_t)(t0 + row) * D + 256 * wave + 64 * c + 8 * ch) = v; }
              LDS_WAIT(); } }
        __syncthreads();
    }
}
__device__ __forceinline__ int moe_bases(const unsigned* cnt, int lane, int& padded) {
    const int c = (lane < 32) ? (int)__hip_atomic_load(cnt + (lane & 31), RLX_AGENT) : 0;
    padded = (c + 255) & ~255;
    int incl = padded;
#pragma unroll
    for (int o = 1; o < 32; o <<= 1) { const int up = __shfl_up(incl, o); if (lane >= o) incl += up; }
    return incl - padded;
}
__device__ __forceinline__ int moe_tile_table(Frame& F, int l) {
    LAS int* tile_e = (LAS int*)(F.lds + TILE_E_OFF);
    const unsigned* cnt = (const unsigned*)(F.ctl + CW_CNT + l * 64);
    int padded; const int base = moe_bases(cnt, F.lane, padded);
    if (F.wave == 0 && F.lane < 32) { for (int ti = base >> 8; ti < ((base + padded) >> 8); ++ti) tile_e[ti] = F.lane;
        tile_e[320 + F.lane] = base >> 8; tile_e[352 + F.lane] = (int)__hip_atomic_load(cnt + F.lane, RLX_AGENT); }
    const int total = __builtin_amdgcn_readfirstlane(__shfl(base + padded, 31));
    __syncthreads();
    return total >> 8;
}
__device__ __forceinline__ void ph_combine(Frame& F, int l) {
    const int gw = F.bid * NWAVES + F.wave, NGW = F.G * NWAVES, lane = F.lane;
    const bf16* ob = (const bf16*)(F.ws + WS_P); const int* info = (const int*)(F.ws + WS_INFO);
    const bool last = (l == 1);
    const float* g = last ? INP(I_NORM_FINAL) : (INP(I_NORM_MIX) + D);
    bf16* xn = (bf16*)(F.ws + WS_XN);
    int padded_; const int base = moe_bases((const unsigned*)(F.ctl + CW_CNT + l * 64), lane, padded_);
    for (int m = gw; m < T; m += NGW) {
        const int* rec = info + (size_t)m * 8;
        const float w1 = __builtin_bit_cast(float, rec[4]), w2 = __builtin_bit_cast(float, rec[5]); const int p1 = __shfl(base, rec[0]) + rec[2], p2 = __shfl(base, rec[1]) + rec[3];
        float* xr = F.out + (size_t)m * D;
        f32x4 v[8]; float s = 0.f;
#pragma unroll
        for (int j = 0; j < 8; ++j) { v[j] = ((const f32x4*)xr)[lane + 64 * j];
            const v2u a = ((const v2u*)(ob + (size_t)p1 * D))[lane + 64 * j], c = ((const v2u*)(ob + (size_t)p2 * D))[lane + 64 * j];
            v[j].x += w1 * bflo(a.x) + w2 * bflo(c.x); v[j].y += w1 * bfhi(a.x) + w2 * bfhi(c.x); v[j].z += w1 * bflo(a.y) + w2 * bflo(c.y); v[j].w += w1 * bfhi(a.y) + w2 * bfhi(c.y);
            s += (v[j].x * v[j].x + v[j].y * v[j].y) + (v[j].z * v[j].z + v[j].w * v[j].w); }
        const float rstd = 1.0f / sqrtf(wave_sum(s) * (1.0f / D) + EPS);
#pragma unroll
        for (int j = 0; j < 8; ++j) { const f32x4 gv = ((const f32x4*)g)[lane + 64 * j];
            if (last) NTST((f32x4*)xr + lane + 64 * j, v[j] * rstd * gv);
            else { NTST((f32x4*)xr + lane + 64 * j, v[j]); const f32x4 o = v[j] * rstd * gv; v2u w; w.x = pk2(o.x, o.y); w.y = pk2(o.z, o.w); ((v2u*)(xn + (size_t)m * D))[lane + 64 * j] = w; } }
    }
}

constexpr int NPH = 11;
constexpr int N_PHASES = 1 + 2 * NPH;
struct Args { const float* in[N_INPUTS]; float* out; unsigned char* ws; int ph_lo, ph_hi, use_bar, pad; };

#define PH_BEGIN() do { \
        const CAS cfp* ip_ = (const CAS cfp*)__builtin_amdgcn_kernarg_segment_ptr(); asm volatile("" : "+s"(ip_)); F.in = ip_; \
        size_t zo_ = 0; asm volatile("" : "+s"(zo_));     \
        F.ws = args.ws + zo_; F.ctl = (gu32*)(args.ws + zo_); F.out = args.out + zo_; \
        int t_ = threadIdx.x; asm volatile("" : "+v"(t_)); F.tid = t_; F.lane = t_ & 63; F.wave = __builtin_amdgcn_readfirstlane(t_ >> 6); \
        int b_ = blockIdx.x; asm volatile("" : "+s"(b_)); F.bid = b_; int g_ = gridDim.x; asm volatile("" : "+s"(g_)); F.G = g_; \
    } while (0)
#ifndef PH_MASK
#define PH_MASK 0xFFFFFFFFu
#endif
#define IN(k) (lo <= (k) && (k) < hi)
#define INL(j) (IN(pb + (j)) && ((PH_MASK >> (1 + (j))) & 1u))
#define SEAM(k) do { if (IN(k) && IN((k) + 1)) { XcdBarrier b2_ = bar; asm volatile("" : "+s"(b2_.bar)); xcd_barrier(b2_); } } while (0)

__device__ __forceinline__ void run_layer(Frame& F, const Args& args, const XcdBarrier& bar, const int lo, const int hi, const int l) {
    const int pb = 1 + l * NPH;
    if (INL(0)) { PH_BEGIN();
        { pg8::Gemm g{(const bf16*)(F.ws + WS_XN), (const bf16*)(F.ws + WS_WIN + l * WIN_BYTES), T, DIN_FULL, D}; pg8::StaticOrder S; S.init(T, DIN_FULL, F.G, F.bid);
          pg8::EpiBf16L E{(bf16*)(F.ws + WS_P), DINP};
          pg8::gemm_phase<pg8::EpiBf16L, pg8::StaticOrder, true, true>(F.lds, g, S, E); }
        __syncthreads(); PH_BEGIN(); ph_in_rem(F, l);
    } SEAM(pb + 0);
    if (INL(1)) { PH_BEGIN(); ph_gdn_prep(F, l); } SEAM(pb + 1);
    if (INL(2)) {
        PH_BEGIN();
        const bool split = F.G > N_SCAN_WG;
        if (!split || F.bid < N_SCAN_WG) ph_gdn_scan(F);
        if (!split || F.bid >= N_SCAN_WG) {
            __syncthreads(); PH_BEGIN();
            if (split) { F.bid -= N_SCAN_WG; F.G -= N_SCAN_WG; }
            ph_hy_expand(F, l); ph_hy_tin(F, l); __syncthreads(); PH_BEGIN(); if (split) { F.bid -= N_SCAN_WG; F.G -= N_SCAN_WG; } ph_at_prep(F, l);
        }
    } SEAM(pb + 2);
    if (INL(3)) { PH_BEGIN(); ph_hy_fft(F, l); } SEAM(pb + 3);
    if (INL(4)) { PH_BEGIN(); ph_at_global(F, l); __syncthreads(); PH_BEGIN(); ph_at_swa(F, l); } SEAM(pb + 4);
    if (INL(5)) { PH_BEGIN(); ph_gdn_fin(F, l); ph_hy_fin(F, l); __syncthreads(); PH_BEGIN(); ph_at_fin(F, l); } SEAM(pb + 5);
    if (INL(6)) { PH_BEGIN();
        pg8::Gemm g{(const bf16*)(F.ws + WS_Y), (const bf16*)(F.ws + WS_WOUT + l * WOUT_BYTES), T, D, D}; pg8::StaticOrder S; S.init(T, D, F.G, F.bid);
        pg8::EpiResF32 E{(l == 0) ? INP(I_X) : (const float*)F.out, F.out, D};
        pg8::gemm_phase<pg8::EpiResF32, pg8::StaticOrder, true, true>(F.lds, g, S, E);
    } SEAM(pb + 6);
    if (INL(7)) { PH_BEGIN(); ph_moe_route(F, l); } SEAM(pb + 7);
    if (INL(8)) { PH_BEGIN();
        const int ntiles = moe_tile_table(F, l);
        pg8::Gemm g{(const bf16*)(F.ws + WS_XN), (const bf16*)(F.ws + WS_GUT), MOE_ROWS, 1024, D};
        const LAS int* tt = (const LAS int*)(F.lds + TILE_E_OFF);
        pg8::MoeGatherOrder<4, T, (unsigned)(D * 2)> S{tt, tt + 320, tt + 352, (const int*)(F.ws + WS_ELIST), ntiles, F.G, F.bid};
        pg8::EpiSwiGLU E{(bf16*)(F.ws + WS_MOE_H), DE};
        pg8::gemm_phase<pg8::EpiSwiGLU, pg8::MoeGatherOrder<4, T, (unsigned)(D * 2)>, true, true>(F.lds, g, S, E);
    } SEAM(pb + 8);
    if (INL(9)) { PH_BEGIN();
        const int ntiles = moe_tile_table(F, l);
        pg8::Gemm g{(const bf16*)(F.ws + WS_MOE_H), (const bf16*)(F.ws + WS_DT), MOE_ROWS, D, DE};
        pg8::MoeOrder<8> S{(const LAS int*)(F.lds + TILE_E_OFF), ntiles, F.G, F.bid};
        pg8::EpiBf16L E{(bf16*)(F.ws + WS_P), D};
        pg8::gemm_phase<pg8::EpiBf16L, pg8::MoeOrder<8>, false, true>(F.lds, g, S, E);
    } SEAM(pb + 9);
    if (INL(10)) { PH_BEGIN(); ph_combine(F, l); }
    if (l == 0) SEAM(pb + 10);
}

__global__ void __launch_bounds__(NTHR, 2) mk_fwd(Args args) {
    extern __shared__ __attribute__((aligned(16))) unsigned char lds[];
    Frame F;
    F.lds = (LAS unsigned char*)lds;
    F.MISC = (volatile LAS unsigned*)(F.lds + MISC_OFF);
    F.tid = threadIdx.x; F.lane = F.tid & 63; F.wave = __builtin_amdgcn_readfirstlane(F.tid >> 6);
    F.G = gridDim.x; F.bid = blockIdx.x;
    PH_BEGIN();
    for (int u = F.tid; u < (LDS_BYTES - MISC_OFF) / 4; u += NTHR) ((LAS unsigned*)(F.lds + MISC_OFF))[u] = 0u;
    __syncthreads();
    XcdBarrier bar; bar.bar = (unsigned*)(F.ctl + CW_BAR); bar.x = 0; bar.st = nullptr;
    if (args.use_bar) bar = xcd_barrier_post((unsigned*)(F.ctl + CW_BAR), F.MISC + 8);
    const int lo = args.ph_lo, hi = args.ph_hi;

    if (IN(0) && (PH_MASK & 1u)) { PH_BEGIN(); ph_prologue(F);
#pragma nounroll
        for (int l2 = 0; l2 < 2; ++l2) { asm volatile("" : "+s"(l2)); __syncthreads(); PH_BEGIN(); ph_hy_mlp(F, l2); } }
    SEAM(0);

#pragma nounroll
    for (int l = 0; l < 2; ++l) { asm volatile("" : "+s"(l)); run_layer(F, args, bar, lo, hi, l); }
}
#undef IN
#undef INL
#undef SEAM

#ifndef MK_ONE_LAUNCH
#define MK_ONE_LAUNCH 1
#endif
extern "C" void kernel_launch(void* const* d_in, const int* in_sizes, int n_in, void* d_out, int out_size, void* d_ws, size_t ws_size, hipStream_t stream) {
    static int grid = 0;
    if (grid == 0) {
        if (n_in != N_INPUTS || out_size != T * D || ws_size < WS_END) { fprintf(stderr, "kernel_launch: unexpected shapes (n_in %d out %d ws %zu)\n", n_in, out_size, ws_size); grid = -1; return; }
        if (hipFuncSetAttribute((const void*)mk_fwd, hipFuncAttributeMaxDynamicSharedMemorySize, LDS_BYTES) != hipSuccess) { fprintf(stderr, "kernel_launch: hipFuncSetAttribute failed\n"); grid = -1; return; }
        int dev = 0, cus = 0, per_cu = 0;
        hipGetDevice(&dev); hipDeviceGetAttribute(&cus, hipDeviceAttributeMultiprocessorCount, dev);
        hipOccupancyMaxActiveBlocksPerMultiprocessor(&per_cu, (const void*)mk_fwd, NTHR, LDS_BYTES);
        (void)hipGetLastError();
        grid = (cus >= 256) ? 256 : cus;
        if (per_cu < 1) fprintf(stderr, "kernel_launch: occupancy query reports %d\n", per_cu);
    }
    if (grid < 0) return;
    hipMemsetAsync((char*)d_ws + WS_CTL, 0, CTL_ZERO_BYTES, stream);
    Args a{};
    for (int i = 0; i < N_INPUTS; ++i) a.in[i] = (const float*)d_in[i];
    a.out = (float*)d_out; a.ws = (unsigned char*)d_ws; a.pad = 0;
#if MK_ONE_LAUNCH
    a.ph_lo = 0; a.ph_hi = N_PHASES; a.use_bar = 1;
    hipLaunchKernelGGL(mk_fwd, dim3(grid), dim3(NTHR), LDS_BYTES, stream, a);
#else
    for (int p = 0; p < N_PHASES; ++p) { a.ph_lo = p; a.ph_hi = p + 1; a.use_bar = 0; hipLaunchKernelGGL(mk_fwd, dim3(grid), dim3(NTHR), LDS_BYTES, stream, a); }
#endif
}
```

```cpp
#include <hip/hip_runtime.h>
#include <cstdio>
#include <cstdint>
#include <cmath>
namespace pg8 {
#define PG8_LAS __attribute__((address_space(3)))
typedef unsigned short bf16_t;
typedef short bf16x8 __attribute__((ext_vector_type(8)));
typedef float f32x4 __attribute__((ext_vector_type(4)));
typedef unsigned u32x4 __attribute__((ext_vector_type(4)));
constexpr int BM = 256, BK = 64, HALF = 128, HTB = HALF * BK * 2  , STAGE_BYTES = 8 * HTB, NXCD = 8, WGM = 8;

__host__ __device__ __forceinline__ int lds_byte(int r, int c) { const int st = (r >> 4) * 2 + (c >> 5), rr = r & 15, cc = c & 31, ob = rr * 64 + cc * 2; return st * 1024 + (ob ^ (((ob >> 9) & 1) << 5)); }
__host__ __device__ __forceinline__ void stage_rc(int b, int& R, int& C) { const int st = b / 1024, sb = b % 1024, swz = sb ^ (((sb >> 9) & 1) << 5); R = (st >> 1) * 16 + swz / 64; C = (st & 1) * 32 + (swz % 64) / 2; }
__host__ __device__ __forceinline__ int perm32(int rho) { const int n = rho >> 4, i = rho & 15; return 8 * (i >> 2) + 4 * n + (i & 3); }

struct Unit { int pm, pn, pb; };
struct Gemm { const bf16_t* A; const bf16_t* Bt; int M, N, K; };

struct StaticOrder {
    int nM, nN, nwg, G, c;
    __host__ __device__ void init(int M, int N, int G_, int c_) { nM = M / BM; nN = N / BM; nwg = nM * nN; G = G_; c = c_; }
    __host__ __device__ bool next(int i, Unit& u) const {
        const long L = (long)i * G + c; if (L >= nwg) return false;
        int wgid = (int)L; { const int q = nwg / NXCD, r = nwg % NXCD, xcd = wgid % NXCD, off = wgid / NXCD; wgid = (xcd < r ? xcd * (q + 1) : r * (q + 1) + (xcd - r) * q) + off; }
        const int nig = WGM * nN, gid = wgid / nig, fm = gid * WGM, gsz = (nM - fm) < WGM ? (nM - fm) : WGM;
        u.pm = fm + ((wgid % nig) % gsz); u.pn = (wgid % nig) / gsz; u.pb = u.pn; return true;
    }
    __device__ __forceinline__ void a_ready(const Unit&) const {}
    __device__ __forceinline__ void done(const Unit&) const {}
    static constexpr bool GATHER = false;
    __device__ __forceinline__ unsigned arow(const Unit&, int) const { return 0u; }
};

__device__ __forceinline__ unsigned cvt_pk_bf16(float lo, float hi) { unsigned r; asm volatile("v_cvt_pk_bf16_f32 %0, %1, %2" : "=v"(r) : "v"(lo), "v"(hi)); return r; }
typedef float f32x2 __attribute__((ext_vector_type(2)));
__device__ __forceinline__ f32x2 gelu_pk(f32x2 v) {
    const f32x2 av = __builtin_elementwise_abs(v), d = av * 0.2316418882f + 1.0f;
    f32x2 t; t.x = __builtin_amdgcn_rcpf(d.x); t.y = __builtin_amdgcn_rcpf(d.y);
    f32x2 q = t * 0.5307027145f + (-0.7265760135f); q = q * t + 0.7107068705f; q = q * t + (-0.142248368f); q = q * t + 0.127414796f; q = q * t;
    const f32x2 s = (v * v) * (-0.72134752044f);
    f32x2 e; e.x = __builtin_amdgcn_exp2f(s.x); e.y = __builtin_amdgcn_exp2f(s.y);
    const f32x2 m = v * (q * e), r = v - m;
    f32x2 o; o.x = v.x < 0.f ? m.x : r.x; o.y = v.y < 0.f ? m.y : r.y; return o;
}

template <int ACT  > struct EpiBf16 {
    static constexpr bool PERM = true, PERM64 = false, AFTER_DRAIN = false; static_assert(ACT == 0 || ACT == 1, "EpiBf16: ACT is 0 (none) or 1 (gelu_pk)");
    bf16_t* O; int ldc; const float* bias; int split_cols; size_t split_stride; float scale0;
    __device__ __forceinline__ void operator()(const f32x4 (&acc)[2][2][4][2], const Unit& u, int wr, int wc, int fr, int fq) const {
        const int row0 = u.pm * BM + wr * 64 + fr; int colt = u.pn * BM; bf16_t* base = O;
        float sc = 1.f; if (split_cols) { const int t = colt / split_cols; base += (size_t)t * split_stride; colt -= t * split_cols; if (t == 0) sc = scale0; }
        const int col0 = colt + wc * 32 + 8 * fq, bcol0 = u.pn * BM + wc * 32 + 8 * fq;
        f32x4 bv[2][2];
#pragma unroll
        for (int bj = 0; bj < 2; ++bj)
#pragma unroll
            for (int n = 0; n < 2; ++n) bv[bj][n] = bias ? *(const f32x4*)(bias + bcol0 + bj * HALF + 4 * n) : (f32x4){0.f, 0.f, 0.f, 0.f};
#pragma unroll
        for (int ai = 0; ai < 2; ++ai)
#pragma unroll
            for (int m = 0; m < 4; ++m) { bf16_t* rowp = base + (size_t)(row0 + ai * HALF + m * 16) * ldc + col0;
#pragma unroll
                for (int bj = 0; bj < 2; ++bj) { f32x4 v0 = acc[ai][bj][m][0] + bv[bj][0], v1 = acc[ai][bj][m][1] + bv[bj][1];
                    if (ACT == 1) { f32x2 a = gelu_pk((f32x2){v0[0], v0[1]}), b = gelu_pk((f32x2){v0[2], v0[3]}), c = gelu_pk((f32x2){v1[0], v1[1]}), d = gelu_pk((f32x2){v1[2], v1[3]});
                        v0 = (f32x4){a.x, a.y, b.x, b.y}; v1 = (f32x4){c.x, c.y, d.x, d.y}; }
                    v0 = v0 * sc; v1 = v1 * sc; u32x4 w; w.x = cvt_pk_bf16(v0[0], v0[1]); w.y = cvt_pk_bf16(v0[2], v0[3]); w.z = cvt_pk_bf16(v1[0], v1[1]); w.w = cvt_pk_bf16(v1[2], v1[3]);
                    *(u32x4*)(rowp + bj * HALF) = w; } }
    }
};

#ifndef EPI_NT
#define EPI_NT 1
#endif
#if EPI_NT
#define EPI_ST(v, p) __builtin_nontemporal_store((v), (p))
#else
#define EPI_ST(v, p) (*(p) = (v))
#endif
__device__ __forceinline__ unsigned dpp_ror8(unsigned x) { return (unsigned)__builtin_amdgcn_update_dpp(0, (int)x, 0x128, 0xf, 0xf, false); }
__device__ __forceinline__ unsigned bperm(int a, unsigned x) { return (unsigned)__builtin_amdgcn_ds_bpermute(a, (int)x); }
__device__ __forceinline__ f32x4 dpp_ror8_v4(f32x4 v) { const u32x4 u = __builtin_bit_cast(u32x4, v); u32x4 r; r.x = dpp_ror8(u.x); r.y = dpp_ror8(u.y); r.z = dpp_ror8(u.z); r.w = dpp_ror8(u.w); return __builtin_bit_cast(f32x4, r); }
__device__ __forceinline__ f32x4 bperm_v4(int a, f32x4 v) { const u32x4 u = __builtin_bit_cast(u32x4, v); u32x4 r; r.x = bperm(a, u.x); r.y = bperm(a, u.y); r.z = bperm(a, u.z); r.w = bperm(a, u.w); return __builtin_bit_cast(f32x4, r); }
struct EpiResF32 {
    static constexpr bool PERM = false, PERM64 = false, AFTER_DRAIN = false;
    const float* base; float* out; int ldc;
    __device__ __forceinline__ void operator()(const f32x4 (&acc)[2][2][4][2], const Unit& u, int wr, int wc, int fr, int fq) const {
        const int hi8 = fr >> 3, l = fq * 16 + fr, dr = l >> 3, dc = l & 7;
        const int srcA = (((dc & 3) * 16 + (dc >> 2) * 8 + dr) << 2), srcB = (((dc & 3) * 16 + ((dc >> 2) ^ 1) * 8 + dr) << 2);
        const size_t offa = (size_t)(u.pm * BM + wr * 64 + dr) * ldc + u.pn * BM + wc * 32 + dc * 4, offb = offa + (size_t)8 * ldc;
#pragma unroll
        for (int ai = 0; ai < 2; ++ai)
#pragma unroll
            for (int m = 0; m < 4; ++m)
#pragma unroll
                for (int bj = 0; bj < 2; ++bj) { const size_t ro = (size_t)(ai * HALF + m * 16) * ldc + bj * HALF;
                    const f32x4 ba = *(const f32x4*)(base + offa + ro), bb = *(const f32x4*)(base + offb + ro);
                    const f32x4 w0 = acc[ai][bj][m][0], t = dpp_ror8_v4(acc[ai][bj][m][1]);
                    const f32x4 sa = hi8 ? t : w0, sb = hi8 ? w0 : t;
                    EPI_ST(bperm_v4(srcA, sa) + ba, (f32x4*)(out + offa + ro)); EPI_ST(bperm_v4(srcB, sb) + bb, (f32x4*)(out + offb + ro)); }
    }
};
struct EpiBf16L {
    static constexpr bool PERM = true, PERM64 = true, AFTER_DRAIN = false;
    bf16_t* O; int ldc;
    __device__ __forceinline__ void operator()(const f32x4 (&acc)[2][2][4][2], const Unit& u, int wr, int wc, int fr, int fq) const {
        const int hi8 = fr >> 3, l = fq * 16 + fr, dr = l >> 3, dc = l & 7;
        const int srcA = (((dc & 3) * 16 + (dc >> 2) * 8 + dr) << 2), srcB = (((dc & 3) * 16 + ((dc >> 2) ^ 1) * 8 + dr) << 2);
        bf16_t* pa = O + (size_t)(u.pm * BM + wr * 64 + dr) * ldc + u.pn * BM + wc * 64 + dc * 8;
        bf16_t* pb = pa + (size_t)8 * ldc;
#pragma unroll
        for (int ai = 0; ai < 2; ++ai)
#pragma unroll
            for (int m = 0; m < 4; ++m) { const size_t ro = (size_t)(ai * HALF + m * 16) * ldc;
                u32x4 w0, w1, t;
                w0.x = cvt_pk_bf16(acc[ai][0][m][0][0], acc[ai][0][m][0][1]); w0.y = cvt_pk_bf16(acc[ai][0][m][0][2], acc[ai][0][m][0][3]); w0.z = cvt_pk_bf16(acc[ai][0][m][1][0], acc[ai][0][m][1][1]); w0.w = cvt_pk_bf16(acc[ai][0][m][1][2], acc[ai][0][m][1][3]);
                w1.x = cvt_pk_bf16(acc[ai][1][m][0][0], acc[ai][1][m][0][1]); w1.y = cvt_pk_bf16(acc[ai][1][m][0][2], acc[ai][1][m][0][3]); w1.z = cvt_pk_bf16(acc[ai][1][m][1][0], acc[ai][1][m][1][1]); w1.w = cvt_pk_bf16(acc[ai][1][m][1][2], acc[ai][1][m][1][3]);
                t.x = dpp_ror8(w1.x); t.y = dpp_ror8(w1.y); t.z = dpp_ror8(w1.z); t.w = dpp_ror8(w1.w);
                const u32x4 sa = hi8 ? t : w0, sb = hi8 ? w0 : t;
                u32x4 oa, ob;
                oa.x = bperm(srcA, sa.x); oa.y = bperm(srcA, sa.y); oa.z = bperm(srcA, sa.z); oa.w = bperm(srcA, sa.w);
                ob.x = bperm(srcB, sb.x); ob.y = bperm(srcB, sb.y); ob.z = bperm(srcB, sb.z); ob.w = bperm(srcB, sb.w);
                EPI_ST(oa, (u32x4*)(pa + ro)); EPI_ST(ob, (u32x4*)(pb + ro)); }
    }
};
struct EpiSwiGLU {
    static constexpr bool PERM = true, PERM64 = false, AFTER_DRAIN = false;
    bf16_t* H; int ldh;
    __device__ __forceinline__ void operator()(const f32x4 (&acc)[2][2][4][2], const Unit& u, int wr, int wc, int fr, int fq) const {
        const int l = fq * 16 + fr, dr = l >> 2, dc = l & 3, src = (dc * 16 + dr) << 2;
        const int row0 = u.pm * BM + wr * 64 + dr, col0 = u.pn * HALF + wc * 32 + 8 * dc;
#pragma unroll
        for (int ai = 0; ai < 2; ++ai)
#pragma unroll
            for (int m = 0; m < 4; ++m) { bf16_t* rowp = H + (size_t)(row0 + ai * HALF + m * 16) * ldh + col0;
                float r[8];
#pragma unroll
                for (int n = 0; n < 2; ++n)
#pragma unroll
                    for (int i = 0; i < 4; ++i) { const float g = acc[ai][0][m][n][i], up = acc[ai][1][m][n][i]; r[n * 4 + i] = g / (1.0f + __expf(-g)) * up; }
                u32x4 w; w.x = cvt_pk_bf16(r[0], r[1]); w.y = cvt_pk_bf16(r[2], r[3]); w.z = cvt_pk_bf16(r[4], r[5]); w.w = cvt_pk_bf16(r[6], r[7]);
                u32x4 o; o.x = bperm(src, w.x); o.y = bperm(src, w.y); o.z = bperm(src, w.z); o.w = bperm(src, w.w);
                EPI_ST(o, (u32x4*)rowp); }
    }
};
#ifndef MOE_XCD_ORDER
#define MOE_XCD_ORDER 1
#endif
template <int NPN> struct MoeOrder {
    const PG8_LAS int* tile_e; int ntiles, G, c;
    __device__ __forceinline__ bool next(int i, Unit& u) const {
        if (MOE_XCD_ORDER && (G & 7) == 0) {
            const int x = c & 7, j = c >> 3, w = G >> 3;
            const int tb = ntiles >> 3, ex = ntiles & 7, cntx = tb + (x < ex ? 1 : 0), start = x * tb + (x < ex ? x : ex);
            const int q = i * w + j, tl = q / NPN; if (tl >= cntx) return false;
            u.pm = start + tl; u.pn = q % NPN;
        } else { const int L = i * G + c; if (L >= ntiles * NPN) return false; u.pm = L / NPN; u.pn = L % NPN; }
        u.pb = __builtin_amdgcn_readfirstlane(tile_e[u.pm]) * NPN + u.pn; return true;
    }
    __device__ __forceinline__ void a_ready(const Unit&) const {}
    __device__ __forceinline__ void done(const Unit&) const {}
    static constexpr bool GATHER = false;
    __device__ __forceinline__ unsigned arow(const Unit&, int) const { return 0u; }
};
template <int NPN, int LT, unsigned ROWBYTES> struct MoeGatherOrder {
    const PG8_LAS int* tile_e; const PG8_LAS int* tile0; const PG8_LAS int* cnt; const int* list; int ntiles, G, c;
    __device__ __forceinline__ bool next(int i, Unit& u) const {
        if (MOE_XCD_ORDER && (G & 7) == 0) {
            const int x = c & 7, j = c >> 3, w = G >> 3;
            const int tb = ntiles >> 3, ex = ntiles & 7, cntx = tb + (x < ex ? 1 : 0), start = x * tb + (x < ex ? x : ex);
            const int q = i * w + j, tl = q / NPN; if (tl >= cntx) return false;
            u.pm = start + tl; u.pn = q % NPN;
        } else { const int L = i * G + c; if (L >= ntiles * NPN) return false; u.pm = L / NPN; u.pn = L % NPN; }
        u.pb = __builtin_amdgcn_readfirstlane(tile_e[u.pm]) * NPN + u.pn; return true;
    }
    __device__ __forceinline__ void a_ready(const Unit&) const {}
    __device__ __forceinline__ void done(const Unit&) const {}
    static constexpr bool GATHER = true;
    __device__ __forceinline__ unsigned arow(const Unit& u, int r) const {
        const int e = __builtin_amdgcn_readfirstlane(tile_e[u.pm]); const int rr = (u.pm - __builtin_amdgcn_readfirstlane(tile0[e])) * 256 + r;
        const int tok = (rr < __builtin_amdgcn_readfirstlane(cnt[e])) ? list[(size_t)e * LT + rr] : 0;
        return (unsigned)tok * ROWBYTES;
    }
};
template <class Epi, class Sched, bool ALIGN_EPI = false, bool SP2 = false, bool THIN = false>
__device__ __forceinline__ void gemm_phase(PG8_LAS unsigned char* lds, const Gemm g, const Sched& S, const Epi& E) {
    int tid_ = threadIdx.x; asm volatile("" : "+v"(tid_));
    const int tid = tid_, wid = __builtin_amdgcn_readfirstlane(tid >> 6), lane = tid & 63, wr = wid >> 2, wc = wid & 3, fr = lane & 15, fq = lane >> 4;
    const int K = g.K, nt = K / BK;
    unsigned voffA[2], voffB[2]; int rowA[2]; unsigned colA2[2];
#pragma unroll
    for (int i = 0; i < 2; ++i) { int R, C; stage_rc(tid * 16 + i * 8192, R, C); const int Rb = Epi::PERM64 ? (64 * (R >> 5) + perm32(R & 31)) : Epi::PERM ? ((R & ~31) + perm32(R & 31)) : R;
        voffA[i] = (unsigned)(R * K + C) * 2u; voffB[i] = (unsigned)(Rb * K + C) * 2u; rowA[i] = R; colA2[i] = (unsigned)C * 2u; }
    unsigned cOff[2][2], nOff[2][2];
#define PG8_AOFFS(dst, u_) do { _Pragma("unroll") for (int h_ = 0; h_ < 2; ++h_) _Pragma("unroll") for (int i_ = 0; i_ < 2; ++i_) dst[h_][i_] = S.arow(u_, h_ * HALF + rowA[i_]) + colA2[i_]; } while (0)
    const size_t kstep = (size_t)(BK * 2);
    const size_t hstep = (size_t)HALF * K * 2;
    const size_t hstepB = Epi::PERM64 ? (size_t)32 * K * 2 : hstep;
    const size_t tstep = 2 * hstep;
    const unsigned ldsw = (unsigned)wid * 1024u;
    const int aoff = lds_byte(wr * 64 + fr, fq * 8), boff = lds_byte(wc * 32 + fr, fq * 8);
#define PG8_SA(b, h) (((b) * 2 + (h)) * HTB)
#define PG8_SB(b, h) ((4 + (b) * 2 + (h)) * HTB)
#define PG8_STAGE(bufoff, gbase, voff) do { _Pragma("unroll") for (int _i = 0; _i < 2; ++_i) \
        __builtin_amdgcn_global_load_lds((const unsigned*)((const char*)(gbase) + (voff)[_i]), (PG8_LAS unsigned*)(lds + (bufoff) + ldsw + _i * 8192), 16, 0, 0); } while (0)
#define PG8_LDA(dst, b, h) do { _Pragma("unroll") for (int m = 0; m < 4; ++m) _Pragma("unroll") for (int k = 0; k < 2; ++k) dst[m][k] = *(const PG8_LAS bf16x8*)(lds + PG8_SA(b, h) + aoff + m * 2048 + k * 1024); } while (0)
#define PG8_LDB(dst, b, h) do { _Pragma("unroll") for (int n = 0; n < 2; ++n) _Pragma("unroll") for (int k = 0; k < 2; ++k) dst[n][k] = *(const PG8_LAS bf16x8*)(lds + PG8_SB(b, h) + boff + n * 2048 + k * 1024); } while (0)
#define PG8_MMA(ai, bj, At, Bt) do { __builtin_amdgcn_s_setprio(1); _Pragma("unroll") for (int m = 0; m < 4; ++m) _Pragma("unroll") for (int n = 0; n < 2; ++n) _Pragma("unroll") for (int k = 0; k < 2; ++k) \
        acc[ai][bj][m][n] = __builtin_amdgcn_mfma_f32_16x16x32_bf16(Bt[n][k], At[m][k], acc[ai][bj][m][n], 0, 0, 0); __builtin_amdgcn_s_setprio(0); } while (0)
#define PG8_MMA2(ai) do { if constexpr (THIN) { if (wc == 0) PG8_MMA(ai, 0, At, B0); } else { PG8_MMA(ai, 0, At, B0); PG8_MMA(ai, 1, At, B1); } } while (0)
#define PG8_VC(h) (GA ? cOff[h] : voffA)
#define PG8_VN(h) (GA ? vN[h] : voffA)
#define PG8_WAIT_V(n) asm volatile("s_waitcnt vmcnt(" #n ")" ::: "memory")
#define PG8_WAIT_L(n) asm volatile("s_waitcnt lgkmcnt(" #n ")" ::: "memory")
#define PG8_BAR __builtin_amdgcn_s_barrier()
#define PG8_SCHED __builtin_amdgcn_sched_barrier(0)
    Unit cur, nxt; int ui = 0;
    if (!S.next(0, cur)) return;
    f32x4 acc[2][2][4][2];
#pragma unroll
    for (int a = 0; a < 2; ++a)
#pragma unroll
        for (int b = 0; b < 2; ++b)
#pragma unroll
            for (int m = 0; m < 4; ++m)
#pragma unroll
                for (int n = 0; n < 2; ++n) acc[a][b][m][n] = (f32x4){0.f, 0.f, 0.f, 0.f};
    bf16x8 At[4][2], B0[2][2], B1[2][2];
    constexpr bool GA = Sched::GATHER;
    const size_t hstepA = GA ? (size_t)0 : hstep;
    const char* cA = (const char*)g.A + (GA ? (size_t)0 : (size_t)cur.pm * tstep); const char* cB = (const char*)g.Bt + (size_t)cur.pb * tstep;
    if constexpr (GA) PG8_AOFFS(cOff, cur);
    S.a_ready(cur);
    if constexpr (SP2) {
        PG8_STAGE(PG8_SB(0, 0), cB, voffB); PG8_STAGE(PG8_SB(0, 1), cB + hstepB, voffB); PG8_STAGE(PG8_SA(0, 0), cA, PG8_VC(0)); PG8_STAGE(PG8_SA(0, 1), cA + hstepA, PG8_VC(1));
        if (wr == 1) PG8_BAR;
        PG8_WAIT_V(2); PG8_BAR;
        PG8_STAGE(PG8_SB(1, 0), cB + kstep, voffB); PG8_STAGE(PG8_SA(1, 0), cA + kstep, PG8_VC(0)); PG8_STAGE(PG8_SB(1, 1), cB + hstepB + kstep, voffB);
        PG8_WAIT_V(6); PG8_BAR;
    } else {
        PG8_STAGE(PG8_SB(0, 0), cB, voffB); PG8_STAGE(PG8_SA(0, 0), cA, PG8_VC(0)); PG8_STAGE(PG8_SB(0, 1), cB + hstepB, voffB); PG8_STAGE(PG8_SA(0, 1), cA + hstepA, PG8_VC(1));
        if (wr == 1) PG8_BAR;
        PG8_WAIT_V(4); PG8_BAR;
        PG8_STAGE(PG8_SB(1, 0), cB + kstep, voffB); PG8_STAGE(PG8_SA(1, 0), cA + kstep, PG8_VC(0)); PG8_STAGE(PG8_SB(1, 1), cB + hstepB + kstep, voffB);
        PG8_WAIT_V(6); PG8_BAR;
    }
    for (;;) {
        const bool has_next = S.next(ui + 1, nxt);
        if constexpr (GA) { if (has_next) PG8_AOFFS(nOff, nxt); else { _Pragma("unroll") for (int h_ = 0; h_ < 2; ++h_) _Pragma("unroll") for (int i_ = 0; i_ < 2; ++i_) nOff[h_][i_] = cOff[h_][i_]; } }
        const char* nA = (has_next && !GA) ? (const char*)g.A + (size_t)nxt.pm * tstep : cA; const char* nB = has_next ? (const char*)g.Bt + (size_t)nxt.pb * tstep : cB;
        for (int t = 0; t < nt; t += 2) {
            const bool last = (t == nt - 2);
            const char* a1 = cA + (size_t)(t + 1) * kstep;
            const char* a2 = last ? nA : cA + (size_t)(t + 2) * kstep; const char* b2 = last ? nB : cB + (size_t)(t + 2) * kstep;
            const char* a3 = a2 + kstep; const char* b3 = b2 + kstep;
            unsigned vN[2][2];
            if constexpr (GA) { _Pragma("unroll") for (int h_ = 0; h_ < 2; ++h_) _Pragma("unroll") for (int i_ = 0; i_ < 2; ++i_) vN[h_][i_] = last ? nOff[h_][i_] : cOff[h_][i_]; }
            if (last && has_next) S.a_ready(nxt);
            if constexpr (SP2) {
            PG8_LDB(B0, 0, 0); PG8_LDB(B1, 0, 1); PG8_SCHED; PG8_LDA(At, 0, 0); PG8_STAGE(PG8_SA(1, 1), a1 + hstepA, PG8_VC(1));
            PG8_WAIT_V(8); PG8_WAIT_L(0); PG8_BAR; PG8_MMA2(0); PG8_BAR; PG8_SCHED;
            PG8_LDA(At, 0, 1); PG8_STAGE(PG8_SB(0, 0), b2, voffB); PG8_STAGE(PG8_SB(0, 1), b2 + hstepB, voffB); PG8_STAGE(PG8_SA(0, 0), a2, PG8_VN(0));
            PG8_WAIT_V(8); PG8_WAIT_L(0); PG8_BAR; PG8_MMA2(1); PG8_BAR; PG8_SCHED;
            PG8_LDB(B0, 1, 0); PG8_LDB(B1, 1, 1); PG8_SCHED; PG8_LDA(At, 1, 0); PG8_STAGE(PG8_SA(0, 1), a2 + hstepA, PG8_VN(1));
            PG8_WAIT_V(8); PG8_WAIT_L(0); PG8_BAR; PG8_MMA2(0); PG8_BAR; PG8_SCHED;
            PG8_LDA(At, 1, 1); PG8_STAGE(PG8_SB(1, 0), b3, voffB); PG8_STAGE(PG8_SB(1, 1), b3 + hstepB, voffB); PG8_STAGE(PG8_SA(1, 0), a3, PG8_VN(0));
            PG8_WAIT_V(8); PG8_WAIT_L(0); PG8_BAR; PG8_MMA2(1); PG8_BAR; PG8_SCHED;
            } else {
            PG8_LDB(B0, 0, 0); PG8_SCHED; PG8_LDA(At, 0, 0); PG8_STAGE(PG8_SA(1, 1), a1 + hstepA, PG8_VC(1));
            PG8_WAIT_L(8); PG8_BAR; PG8_WAIT_L(0); PG8_MMA(0, 0, At, B0); PG8_BAR; PG8_SCHED;
            PG8_LDB(B1, 0, 1); PG8_STAGE(PG8_SB(0, 0), b2, voffB);
            PG8_BAR; PG8_WAIT_L(0); PG8_MMA(0, 1, At, B1); PG8_BAR;
            PG8_LDA(At, 0, 1); PG8_STAGE(PG8_SA(0, 0), a2, PG8_VN(0));
            PG8_BAR; PG8_WAIT_L(0); PG8_MMA(1, 0, At, B0); PG8_BAR; PG8_SCHED;
            PG8_STAGE(PG8_SB(0, 1), b2 + hstepB, voffB);
            PG8_WAIT_V(6); PG8_BAR; PG8_MMA(1, 1, At, B1); PG8_BAR;
            PG8_LDB(B0, 1, 0); PG8_SCHED; PG8_LDA(At, 1, 0); PG8_STAGE(PG8_SA(0, 1), a2 + hstepA, PG8_VN(1));
            PG8_WAIT_L(8); PG8_BAR; PG8_WAIT_L(0); PG8_MMA(0, 0, At, B0); PG8_BAR; PG8_SCHED;
            PG8_LDB(B1, 1, 1); PG8_STAGE(PG8_SB(1, 0), b3, voffB);
            PG8_BAR; PG8_WAIT_L(0); PG8_MMA(0, 1, At, B1); PG8_BAR;
            PG8_LDA(At, 1, 1); PG8_STAGE(PG8_SA(1, 0), a3, PG8_VN(0));
            PG8_BAR; PG8_WAIT_L(0); PG8_MMA(1, 0, At, B0); PG8_BAR; PG8_SCHED;
            PG8_STAGE(PG8_SB(1, 1), b3 + hstepB, voffB);
            PG8_WAIT_V(6); PG8_BAR; PG8_MMA(1, 1, At, B1); PG8_BAR;
            }
        }
        if constexpr (ALIGN_EPI) { if (wr == 0) PG8_BAR; }
        if constexpr (!Epi::AFTER_DRAIN) { E(acc, cur, wr, wc, fr, fq); S.done(cur); }
        if (!has_next) break;
#pragma unroll
        for (int a = 0; a < 2; ++a)
#pragma unroll
            for (int b = 0; b < 2; ++b)
#pragma unroll
                for (int m = 0; m < 4; ++m)
#pragma unroll
                    for (int n = 0; n < 2; ++n) acc[a][b][m][n] = (f32x4){0.f, 0.f, 0.f, 0.f};
        cur = nxt; cA = nA; cB = nB; ++ui;
        if constexpr (GA) { _Pragma("unroll") for (int h_ = 0; h_ < 2; ++h_) _Pragma("unroll") for (int i_ = 0; i_ < 2; ++i_) cOff[h_][i_] = nOff[h_][i_]; }
        if constexpr (ALIGN_EPI) { if (wr == 1) PG8_BAR; }
    }
    PG8_WAIT_V(0);
    if constexpr (!ALIGN_EPI) { if (wr == 0) PG8_BAR; }
    PG8_BAR;
    if constexpr (Epi::AFTER_DRAIN) { E.fused(acc, cur, wr, wc, fr, fq, lds, wid, lane); S.done(cur); }
#undef PG8_SA
#undef PG8_SB
#undef PG8_STAGE
#undef PG8_LDA
#undef PG8_LDB
#undef PG8_MMA
#undef PG8_MMA2
#undef PG8_VC
#undef PG8_VN
#undef PG8_AOFFS
#undef PG8_WAIT_V
#undef PG8_WAIT_L
#undef PG8_BAR
#undef PG8_SCHED
}
}
#include <hip/hip_bf16.h>
namespace attn_body {
using bf16=__hip_bfloat16;
using bf16x8=__attribute__((ext_vector_type(8)))short;
using s16x4=__attribute__((ext_vector_type(4)))short;
using f32x16=__attribute__((ext_vector_type(16)))float;
using u32x4=__attribute__((ext_vector_type(4)))unsigned;
constexpr int D=64;
constexpr int NW=8,QBLK=32,QB=QBLK*NW,KVBLK=64;
constexpr int ATTN_UNIT_ROWS=QB;
__device__ __forceinline__ int crow(int r,int hi){return (r&3)+8*(r>>2)+4*hi;}
#define SBAR() __builtin_amdgcn_sched_barrier(0)
__device__ __forceinline__ void cmask(f32x16&p0,f32x16&p1,int jb,int qrel,int hi){
  const float NEG=-INFINITY; int kb=64*jb+4*hi;
  #pragma unroll
  for(int r=0;r<16;++r){int kv=kb+(r&3)+8*(r>>2); if(kv>qrel)p0[r]=NEG; if(kv+32>qrel)p1[r]=NEG;}
}

constexpr int NSLOT=3, SLOTB=8192;
constexpr int LDS_K=0, LDS_V=NSLOT*SLOTB, LDS_WS=2*NSLOT*SLOTB, LDS_OST=LDS_WS+NW*64*4, LDS_BYTES=LDS_OST+NW*4096;
constexpr float C2=0.125f*1.4426950408889634f;
__device__ __forceinline__ void glds16(const void*gsrc,unsigned lds_dst){unsigned keep;
  asm volatile("s_mov_b32 %0, m0\n\ts_mov_b32 m0, %2\n\ts_nop 0\n\tglobal_load_lds_dwordx4 %1, off\n\ts_mov_b32 m0, %0":"=&s"(keep):"v"(gsrc),"s"(lds_dst):"memory");}
__device__ __forceinline__ float max3f(float a,float b,float c){float r;asm("v_max3_f32 %0, %1, %2, %3":"=v"(r):"v"(a),"v"(b),"v"(c));return r;}
__device__ __forceinline__ float max2f(float a,float b){float r;asm("v_max_f32_e32 %0, %1, %2":"=v"(r):"v"(a),"v"(b));return r;}
__device__ __forceinline__ float fadd_s(float a,float b){float r;asm("v_add_f32_e32 %0, %1, %2":"=v"(r):"v"(a),"v"(b));return r;}
__device__ __forceinline__ float fsub_s(float a,float b){float r;asm("v_sub_f32_e32 %0, %1, %2":"=v"(r):"v"(a),"v"(b));return r;}
typedef float f32x2_t __attribute__((ext_vector_type(2))); typedef __bf16 bf16x2_t __attribute__((ext_vector_type(2)));
__device__ __forceinline__ unsigned cvtpk_s(float lo,float hi){f32x2_t v={lo,hi};bf16x2_t b=__builtin_convertvector(v,bf16x2_t);return __builtin_bit_cast(unsigned,b);}
#define WAIT_BAR(N) asm volatile("s_waitcnt vmcnt(" #N ") lgkmcnt(0)\n\ts_barrier":::"memory")

__device__ __forceinline__ void qkt(f32x16&p0,f32x16&p1,const char*Kslot,const bf16x8*qr,const f32x16&negm,int r32,int hi){
  const char*kb=Kslot+hi*1024+r32*16;
  #pragma unroll
  for(int d0=0;d0<4;++d0){
    const bf16x8 b0=*reinterpret_cast<const bf16x8*>(kb+d0*2048);
    const bf16x8 b1=*reinterpret_cast<const bf16x8*>(kb+d0*2048+512);
    if(d0==0){p0=__builtin_amdgcn_mfma_f32_32x32x16_bf16(b0,qr[0],negm,0,0,0);p1=__builtin_amdgcn_mfma_f32_32x32x16_bf16(b1,qr[0],negm,0,0,0);}
    else{p0=__builtin_amdgcn_mfma_f32_32x32x16_bf16(b0,qr[d0],p0,0,0,0);p1=__builtin_amdgcn_mfma_f32_32x32x16_bf16(b1,qr[d0],p1,0,0,0);}}
}
typedef __attribute__((address_space(3))) const char* lds_cptr;
typedef short v4i16_t __attribute__((ext_vector_type(4)));
__device__ __forceinline__ void kload8(bf16x8*kf,lds_cptr kp){
  kf[0]=*(const __attribute__((address_space(3))) bf16x8*)(kp);      kf[1]=*(const __attribute__((address_space(3))) bf16x8*)(kp+512);
  kf[2]=*(const __attribute__((address_space(3))) bf16x8*)(kp+2048); kf[3]=*(const __attribute__((address_space(3))) bf16x8*)(kp+2560);
  kf[4]=*(const __attribute__((address_space(3))) bf16x8*)(kp+4096); kf[5]=*(const __attribute__((address_space(3))) bf16x8*)(kp+4608);
  kf[6]=*(const __attribute__((address_space(3))) bf16x8*)(kp+6144); kf[7]=*(const __attribute__((address_space(3))) bf16x8*)(kp+6656);
}
__device__ __forceinline__ void kload2(bf16x8*kf,lds_cptr kp,int j){ kf[2*j]=*(const __attribute__((address_space(3))) bf16x8*)(kp+j*2048); kf[2*j+1]=*(const __attribute__((address_space(3))) bf16x8*)(kp+j*2048+512); }
__device__ __forceinline__ s16x4 vtr(lds_cptr p){ return __builtin_bit_cast(s16x4,__builtin_amdgcn_ds_read_tr16_b64_v4i16((__attribute__((address_space(3))) v4i16_t*)p)); }
__device__ __forceinline__ float rowmax(const f32x16&p0,const f32x16&p1){
  float a=max3f(p0[0],p0[1],p1[0]),b=max3f(p0[2],p0[3],p1[1]);a=max3f(a,p1[2],p1[3]);
  #pragma unroll
  for(int r=4;r<16;r+=4){a=max3f(a,p0[r],p0[r+1]);b=max3f(b,p0[r+2],p0[r+3]);a=max3f(a,p1[r],p1[r+1]);b=max3f(b,p1[r+2],p1[r+3]);}
  const float m=max2f(a,b);
  auto rr=__builtin_amdgcn_permlane32_swap(__float_as_uint(m),__float_as_uint(m),false,false);
  return max2f(__uint_as_float(rr[0]),__uint_as_float(rr[1]));
}
__device__ __forceinline__ void pv(f32x16*o,int vb,bf16x8 pa0,bf16x8 pa1,bf16x8 pa2,bf16x8 pa3){
  #pragma unroll
  for(int d0=0;d0<2;++d0){s16x4 lo[4],hi[4];
    #pragma unroll
    for(int ks=0;ks<4;++ks){
      asm volatile("ds_read_b64_tr_b16 %0,%1 offset:%c2":"=&v"(lo[ks]):"v"(vb),"i"(d0*4096+ks*1024):"memory");
      asm volatile("ds_read_b64_tr_b16 %0,%1 offset:%c2":"=&v"(hi[ks]):"v"(vb),"i"(d0*4096+ks*1024+512):"memory");}
    asm volatile("s_waitcnt lgkmcnt(0)":::"memory");SBAR();
    #define PK(k) (bf16x8){lo[k][0],lo[k][1],lo[k][2],lo[k][3],hi[k][0],hi[k][1],hi[k][2],hi[k][3]}
    o[d0]=__builtin_amdgcn_mfma_f32_32x32x16_bf16(pa0,PK(0),o[d0],0,0,0);
    o[d0]=__builtin_amdgcn_mfma_f32_32x32x16_bf16(pa1,PK(1),o[d0],0,0,0);
    o[d0]=__builtin_amdgcn_mfma_f32_32x32x16_bf16(pa2,PK(2),o[d0],0,0,0);
    o[d0]=__builtin_amdgcn_mfma_f32_32x32x16_bf16(pa3,PK(3),o[d0],0,0,0);
    #undef PK
  }
}

#ifndef ATTN_STORE16
#define ATTN_STORE16(p,v) __builtin_nontemporal_store((v),(u32x4*)(p))
#endif
template<int THRL,int QP,int KP,int VP,int OP,bool FIXMAX> __device__ __forceinline__ void attn_unit(int q0,int NT,const bf16*Qb,const bf16*__restrict__ Kh,const bf16*__restrict__ Vh,bf16*Ob,char*shm,float mshift){
  int tid_=threadIdx.x; asm volatile("":"+v"(tid_));
  const int tid=tid_,lane=tid&63,r32=lane&31,hi=lane>>5; const int wid=__builtin_amdgcn_readfirstlane(tid>>6);
  const bf16*Qw=Qb+(long)(q0+wid*QBLK)*QP;
  const unsigned lds0=(unsigned)(uintptr_t)shm;
  float*wsf=(float*)(shm+LDS_WS)+wid*64;
  const bf16*ksrc=Kh+(long)lane*KP+wid*8;
  const bf16*vsrc=Vh+(long)(16*(wid&3)+(lane>>2))*VP+(wid>>2)*32+(lane&3)*8;
  const unsigned kdst=lds0+LDS_K+wid*1024, vdst=lds0+LDS_V+wid*1024;
  #define DMA_K(t,slot) glds16(ksrc+(long)(t)*KVBLK*KP,(unsigned)__builtin_amdgcn_readfirstlane(kdst+(slot)))
  #define DMA_V(t,slot) glds16(vsrc+(long)(t)*KVBLK*VP,(unsigned)__builtin_amdgcn_readfirstlane(vdst+(slot)))
  const int vb0=(int)(lds0+LDS_V)+((lane>>4)&1)*32+(lane&3)*8+(4*hi+((lane&15)>>2))*64;
  const char*Kbase=shm+LDS_K; bf16x8 kf[8];
  const lds_cptr shm3=(lds_cptr)shm; const lds_cptr kp0=shm3+LDS_K+hi*1024+r32*16; const lds_cptr vp0=shm3+LDS_V+((lane>>4)&1)*32+(lane&3)*8+(4*hi+((lane&15)>>2))*64;
  DMA_K(0,0);DMA_V(0,0);DMA_K(1,SLOTB);
  bf16x8 qr[4];
  #pragma unroll
  for(int d0=0;d0<4;++d0)qr[d0]=*reinterpret_cast<const bf16x8*>(&Qw[(long)r32*QP+d0*16+hi*8]);
  float mhat=0.f,l_reg=0.f;f32x16 o[2];o[0]=f32x16{};o[1]=f32x16{};f32x16 negm=f32x16{};asm volatile("":"+v"(negm));
  #define CMASK(P0,P1,t) do{}while(0)
  bool resc=false;
  #define START(P0,P1) do{ const float rm=FIXMAX?mshift:rowmax(P0,P1); resc=false; \
    { const float dl=rm; mhat=fadd_s(mhat,dl); \
      _Pragma("unroll") for(int r=0;r<16;++r){P0[r]=fsub_s(P0[r],dl);P1[r]=fsub_s(P1[r],dl);} \
      _Pragma("unroll") for(int r=0;r<16;++r)negm[r]=-mhat; asm volatile("":"+v"(negm)); } \
    _Pragma("unroll") for(int r=0;r<16;++r)P0[r]=__builtin_amdgcn_exp2f(P0[r]); }while(0)
  #define RESC() do{ if(resc){ asm volatile("s_waitcnt lgkmcnt(0)":::"memory"); \
      _Pragma("unroll") for(int d_=0;d_<2;++d_) _Pragma("unroll") for(int r=0;r<16;++r)o[d_][r]*=wsf[crow(r,hi)]; } }while(0)
  f32x16 pA0,pA1,pB0,pB1;
  int sl_prev=0,sl_cur=0,sl_next=SLOTB;
  #define ROT() do{sl_prev=sl_cur;sl_cur=sl_next;sl_next=(sl_next==(NSLOT-1)*SLOTB)?0:sl_next+SLOTB;}while(0)
  DMA_K(2,2*SLOTB);
  WAIT_BAR(3);
  qkt(pA0,pA1,Kbase,qr,negm,r32,hi);asm volatile("s_nop 15\n\ts_nop 7":"+v"(pA0),"+v"(pA1));CMASK(pA0,pA1,0);
  START(pA0,pA1);
  _Pragma("unroll") for(int r=0;r<16;++r)pA1[r]=__builtin_amdgcn_exp2f(pA1[r]);
  WAIT_BAR(0);
  DMA_K(3,0);DMA_V(1,SLOTB);
  ROT();
  kload8(kf,kp0+sl_cur);
  WAIT_BAR(2);
  s16x4 vlo[8],vhi[8]; u32x4 pw0,pw1,pw2,pw3;
  #define PKW(P,B) cvtpk_s(P[B],P[B+1])
  #define PAF(k) __builtin_bit_cast(bf16x8,pw##k)
  #define VFR(i) (bf16x8){vlo[i][0],vlo[i][1],vlo[i][2],vlo[i][3],vhi[i][0],vhi[i][1],vhi[i][2],vhi[i][3]}
  #define PIN(x) asm volatile("":"+v"(x))
  #define MX3(a,b,c) __builtin_fmaxf(__builtin_fmaxf((a),(b)),(c))
  #define GAPA(MF,A0,A1,A2,A3,W0,W1,PW) do{ MF; sacc+=A0; sacc+=A1; sacc+=A2; sacc+=A3; PIN(sacc); W0; W1; PIN(PW); SBAR(); }while(0)
  #define EX(v) __builtin_amdgcn_exp2f(v)
  #define GAPB(MF,X,B) do{ MF; X[B]=EX(X[B]); X[B+1]=EX(X[B+1]); X[B+2]=EX(X[B+2]); X[B+3]=EX(X[B+3]); PIN(X); SBAR(); }while(0)
  #define VRD(i) do{ vlo[i]=vtr(vp_+(((i)>>2)*4096+((i)&3)*1024)); vhi[i]=vtr(vp_+(((i)>>2)*4096+((i)&3)*1024+512)); }while(0)
  #define KRD(G,j) do{ if(G){ kload2(kf,kp0+sl_next,j); SBAR(); } }while(0)
  #define STEP(C0,C1,P0,P1,t,GK,GV,GL) do{ SBAR(); \
    const lds_cptr vp_=vp0+sl_prev; \
    VRD(0); SBAR(); float sacc=(P0[0]+P0[1]); \
    GAPA(C0=__builtin_amdgcn_mfma_f32_32x32x16_bf16(kf[0],qr[0],negm,0,0,0), P0[2],P0[3],P0[4],P0[5],     pw0[0]=PKW(P0,0), pw0[1]=PKW(P0,2), pw0); \
    VRD(4); SBAR(); GAPA(C1=__builtin_amdgcn_mfma_f32_32x32x16_bf16(kf[1],qr[0],negm,0,0,0), P0[6],P0[7],P0[8],P0[9],     pw0[2]=PKW(P0,4), pw0[3]=PKW(P0,6), pw0); \
    VRD(1); SBAR(); GAPA(C0=__builtin_amdgcn_mfma_f32_32x32x16_bf16(kf[2],qr[1],C0,0,0,0),   P0[10],P0[11],P0[12],P0[13], pw1[0]=PKW(P0,8), pw1[1]=PKW(P0,10), pw1); \
    VRD(5); SBAR(); GAPA(C1=__builtin_amdgcn_mfma_f32_32x32x16_bf16(kf[3],qr[1],C1,0,0,0),   P0[14],P0[15],P1[0],P1[1],   pw1[2]=PKW(P0,12),pw1[3]=PKW(P0,14), pw1); \
    VRD(2); SBAR(); GAPA(C0=__builtin_amdgcn_mfma_f32_32x32x16_bf16(kf[4],qr[2],C0,0,0,0),   P1[2],P1[3],P1[4],P1[5],     pw2[0]=PKW(P1,0), pw2[1]=PKW(P1,2), pw2); \
    VRD(6); SBAR(); GAPA(C1=__builtin_amdgcn_mfma_f32_32x32x16_bf16(kf[5],qr[2],C1,0,0,0),   P1[6],P1[7],P1[8],P1[9],     pw2[2]=PKW(P1,4), pw2[3]=PKW(P1,6), pw2); \
    VRD(3); SBAR(); GAPA(C0=__builtin_amdgcn_mfma_f32_32x32x16_bf16(kf[6],qr[3],C0,0,0,0),   P1[10],P1[11],P1[12],P1[13], pw3[0]=PKW(P1,8), pw3[1]=PKW(P1,10), pw3); \
    VRD(7); SBAR(); GAPA(C1=__builtin_amdgcn_mfma_f32_32x32x16_bf16(kf[7],qr[3],C1,0,0,0),   P1[14],P1[15],0.f,0.f,       pw3[2]=PKW(P1,12),pw3[3]=PKW(P1,14), pw3); \
    l_reg+=sacc; \
    if(GK){DMA_K((t)+3,sl_cur);} if(GV){DMA_V((t)+1,sl_next);} \
    CMASK(C0,C1,t); \
    if(!FIXMAX){ float a=MX3(C0[0],C0[1],C1[0]),b=MX3(C0[2],C0[3],C1[1]); a=MX3(a,C1[2],C1[3]); \
      _Pragma("unroll") for(int r=4;r<16;r+=4){a=MX3(a,C0[r],C0[r+1]);b=MX3(b,C0[r+2],C0[r+3]);a=MX3(a,C1[r],C1[r+1]);b=MX3(b,C1[r+2],C1[r+3]);} \
      float rm=__builtin_fmaxf(a,b); { auto rr=__builtin_amdgcn_permlane32_swap(__float_as_uint(rm),__float_as_uint(rm),false,false); rm=__builtin_fmaxf(__uint_as_float(rr[0]),__uint_as_float(rr[1])); } \
      resc=false; \
      if(__builtin_expect(__any(rm>(float)THRL),0)){ const float dl=__builtin_fmaxf(rm,0.f); mhat+=dl; \
        _Pragma("unroll") for(int r=0;r<16;++r){C0[r]-=dl;C1[r]-=dl;} \
        _Pragma("unroll") for(int r=0;r<16;++r)negm[r]=-mhat; asm volatile("":"+v"(negm)); \
        const float f=__builtin_amdgcn_exp2f(-dl); l_reg*=f; if(hi==0)wsf[r32]=f; resc=true; } } \
    SBAR(); \
    GAPB(o[0]=__builtin_amdgcn_mfma_f32_32x32x16_bf16(PAF(0),VFR(0),o[0],0,0,0), C0,0); \
    GAPB(o[1]=__builtin_amdgcn_mfma_f32_32x32x16_bf16(PAF(0),VFR(4),o[1],0,0,0), C0,4); \
    KRD(GL,0); GAPB(o[0]=__builtin_amdgcn_mfma_f32_32x32x16_bf16(PAF(1),VFR(1),o[0],0,0,0), C0,8); \
    KRD(GL,1); GAPB(o[1]=__builtin_amdgcn_mfma_f32_32x32x16_bf16(PAF(1),VFR(5),o[1],0,0,0), C0,12); \
    KRD(GL,2); GAPB(o[0]=__builtin_amdgcn_mfma_f32_32x32x16_bf16(PAF(2),VFR(2),o[0],0,0,0), C1,0); \
    KRD(GL,3); GAPB(o[1]=__builtin_amdgcn_mfma_f32_32x32x16_bf16(PAF(2),VFR(6),o[1],0,0,0), C1,4); \
    GAPB(o[0]=__builtin_amdgcn_mfma_f32_32x32x16_bf16(PAF(3),VFR(3),o[0],0,0,0), C1,8); \
    GAPB(o[1]=__builtin_amdgcn_mfma_f32_32x32x16_bf16(PAF(3),VFR(7),o[1],0,0,0), C1,12); \
    }while(0)
  int t=1;
  #undef CMASK
  #define CMASK(P0,P1,t) do{}while(0)
  for(;t+5<NT;t+=2){
    STEP(pB0,pB1,pA0,pA1,t,true,true,true);     WAIT_BAR(2); RESC(); ROT();
    STEP(pA0,pA1,pB0,pB1,t+1,true,true,true);   WAIT_BAR(2); RESC(); ROT();
  }
  #undef CMASK
  #define CMASK(P0,P1,t) do{}while(0)
  #define ENDW(tt) do{ if((tt)+3<NT){WAIT_BAR(2);} else if((tt)+2<NT){WAIT_BAR(1);} else {WAIT_BAR(0);} }while(0)
  for(;t+1<NT;t+=2){
    STEP(pB0,pB1,pA0,pA1,t,(t+3<NT),(t+1<NT),(t+1<NT));       ENDW(t);   RESC(); ROT();
    STEP(pA0,pA1,pB0,pB1,t+1,(t+4<NT),(t+2<NT),(t+2<NT));     ENDW(t+1); RESC(); ROT();
  }
  STEP(pB0,pB1,pA0,pA1,NT-1,false,false,false); RESC();
  { float sacc=pB0[0]+pB0[1]; _Pragma("unroll") for(int r=2;r<16;++r)sacc+=pB0[r]; _Pragma("unroll") for(int r=0;r<16;++r)sacc+=pB1[r]; l_reg+=sacc;
    pw0=(u32x4){PKW(pB0,0),PKW(pB0,2),PKW(pB0,4),PKW(pB0,6)};pw1=(u32x4){PKW(pB0,8),PKW(pB0,10),PKW(pB0,12),PKW(pB0,14)};pw2=(u32x4){PKW(pB1,0),PKW(pB1,2),PKW(pB1,4),PKW(pB1,6)};pw3=(u32x4){PKW(pB1,8),PKW(pB1,10),PKW(pB1,12),PKW(pB1,14)};
    SBAR(); pv(o,vb0+sl_cur,PAF(0),PAF(1),PAF(2),PAF(3)); }
  #undef PKW
  #undef PAF
  #undef VFR
  #undef PIN
  #undef MX3
  #undef GAPA
  #undef GAPB
  #undef EX
  #undef VRD
  #undef KRD
  #undef STEP
  #undef ENDW
  {auto rr=__builtin_amdgcn_permlane32_swap(__float_as_uint(l_reg),__float_as_uint(l_reg),false,false);l_reg=__uint_as_float(rr[0])+__uint_as_float(rr[1]);}
  if(hi==0)wsf[32+r32]=l_reg;asm volatile("s_waitcnt lgkmcnt(0)":::"memory");
  float rli[16];
  #pragma unroll
  for(int r=0;r<16;++r)rli[r]=__builtin_amdgcn_rcpf(wsf[32+crow(r,hi)]);
  bf16*Ow=Ob+(long)(q0+wid*QBLK)*OP;
  { bf16*stg=(bf16*)(shm+LDS_OST)+wid*2048;
    #pragma unroll
    for(int r=0;r<16;++r){const int orow=crow(r,hi);
      #pragma unroll
      for(int d0=0;d0<2;++d0)stg[orow*64+d0*32+r32]=__float2bfloat16(o[d0][r]*rli[r]);}
    asm volatile("s_waitcnt lgkmcnt(0)":::"memory");
    #pragma unroll
    for(int i=0;i<4;++i){const int row=i*8+(lane>>3),ch=lane&7; const u32x4 v=*(const u32x4*)(stg+row*64+ch*8); ATTN_STORE16(Ow+(long)row*OP+ch*8,v);} }
  asm volatile("s_waitcnt lgkmcnt(0)\n\ts_barrier":::"memory");
  #undef DMA_K
  #undef DMA_V
  #undef CMASK
  #undef START
  #undef RESC
  #undef ROT
}
constexpr int ATTN_LDS_BYTES=LDS_BYTES;
#undef SBAR
#undef WAIT_BAR
}

#define GAS __attribute__((address_space(1)))
#define LAS __attribute__((address_space(3)))
#define CAS __attribute__((address_space(4)))
typedef const GAS float* cfp;
typedef unsigned short bf16;
typedef unsigned v4u __attribute__((ext_vector_type(4)));
typedef unsigned v2u __attribute__((ext_vector_type(2)));
typedef float f32x4 __attribute__((ext_vector_type(4)));
typedef float f32x2 __attribute__((ext_vector_type(2)));
typedef float f32x16 __attribute__((ext_vector_type(16)));
typedef short bf16x8 __attribute__((ext_vector_type(8)));
typedef short s16x4 __attribute__((ext_vector_type(4)));
typedef GAS unsigned gu32;
#define RLX_AGENT __ATOMIC_RELAXED, __HIP_MEMORY_SCOPE_AGENT
#define NTST(p_, v_) __builtin_nontemporal_store((v_), (p_))
#define LDS_WAIT() asm volatile("s_waitcnt lgkmcnt(0)" ::: "memory")
#define VM_WAIT() asm volatile("s_waitcnt vmcnt(0)" ::: "memory")
#define LDS_BARRIER() do { asm volatile("s_waitcnt lgkmcnt(0)" ::: "memory"); __builtin_amdgcn_s_barrier(); asm volatile("" ::: "memory"); } while (0)

constexpr int NWAVES = 8, NTHR = 512;
constexpr int BATCH = 2, SEQ = 16384, T = BATCH * SEQ, D = 2048, DIN = 5152, DINP = 5376;
constexpr int GW = 512, HD = 64, NH = 8, NKV = 2, DIN_FULL = 5120;
constexpr int C_AQKV = 0, C_AZ = 1536, C_ABETA = 2048, C_AALPHA = 2064, C_B = 2080, C_CQ = 3616, C_CKV = 4128, C_DQ = 4384, C_DKV = 4896;
constexpr int NE = 32, DE = 512, MOE_ROWS = 2 * T + NE * 256;
constexpr int FL = SEQ;
constexpr float EPS = 1e-6f;
constexpr float LOG2E = 1.4426950408889634f;
constexpr float C2 = 0.125f * LOG2E;

enum { I_X = 0, I_NORM_MIX, I_W_IN, I_GDN_CONV, I_GDN_ALOG, I_GDN_DTB, I_GDN_NORM, I_HY_CONV, I_HY_W1, I_HY_B1, I_HY_F1, I_HY_W2, I_HY_B2, I_HY_F2, I_HY_W3,
       I_HY_DELTAS, I_HY_BIAS, I_HY_NORM, I_SWA_SINK, I_SWA_NORM, I_GA_QN, I_GA_KN, I_GA_NORM, I_W_OUT, I_NORM_FFN, I_MOE_WG, I_MOE_BG, I_MOE_WE, I_MOE_BE,
       I_MOE_GATE, I_MOE_UP, I_MOE_DOWN, I_NORM_FINAL, N_INPUTS };

constexpr size_t MiB = 1u << 20;
constexpr size_t WS_CTL = 0, CTL_ZERO_BYTES = 1 * MiB;
constexpr size_t WS_INFO = 1 * MiB;
constexpr size_t WS_H2T = 2 * MiB;
constexpr size_t WS_WRT = 6 * MiB;
constexpr size_t WS_WIN = 8 * MiB;
constexpr size_t WIN_BYTES = (size_t)DINP * D * 2;
constexpr size_t WS_WOUT = 50 * MiB;
constexpr size_t WOUT_BYTES = (size_t)D * D * 2;
constexpr size_t WS_XN = 66 * MiB;
constexpr size_t WS_P = 194 * MiB;
constexpr size_t WS_MOE_H = WS_P + 288 * MiB;
constexpr size_t WS_Y = 554 * MiB;
constexpr size_t WS_T = 682 * MiB;
constexpr size_t WS_GUT = WS_Y, WS_DT = WS_T;
constexpr size_t WS_ELIST = WS_T + 64 * MiB;
constexpr size_t WS_HT = WS_XN, WS_OF = WS_XN + 64 * MiB, WS_OB = WS_XN + 96 * MiB;
constexpr size_t WS_UT = WS_Y, WS_YT = WS_T, WS_FSCR = WS_T + 64 * MiB;
constexpr size_t WS_QP = WS_T + 384 * MiB, WS_KP = WS_Y + 96 * MiB, WS_VTC = WS_Y + 104 * MiB, WS_VP = WS_Y + 112 * MiB, WS_OGD = WS_T + 192 * MiB, WS_OGC = WS_T + 224 * MiB;
constexpr size_t WS_END = WS_T + 416 * MiB;
constexpr int CW_BAR = 4096;
constexpr int CW_CNT = 32768;

constexpr int RING_BYTES = 131072;
constexpr int FFT_LDS_BYTES = 139264;
constexpr int MISC_OFF = FFT_LDS_BYTES;
constexpr int TILE_E_OFF = MISC_OFF + 1024;
constexpr int LDS_BYTES = 147456;

typedef __bf16 hwbf16x2 __attribute__((ext_vector_type(2)));
__device__ __forceinline__ unsigned pk2(float lo, float hi) { const f32x2 v = {lo, hi}; return __builtin_bit_cast(unsigned, __builtin_convertvector(v, hwbf16x2)); }
__device__ __forceinline__ unsigned f2bf(float f) { return pk2(f, 0.f) & 0xffffu; }
__device__ __forceinline__ float bf2f(bf16 h) { return __builtin_bit_cast(float, (unsigned)h << 16); }
__device__ __forceinline__ float bflo(unsigned w) { return __builtin_bit_cast(float, w << 16); }
__device__ __forceinline__ float bfhi(unsigned w) { return __builtin_bit_cast(float, w & 0xffff0000u); }
__device__ __forceinline__ float wave_sum(float v) {
#pragma unroll
    for (int o = 1; o < 64; o <<= 1) v += __shfl_xor(v, o);
    return v;
}
__device__ __forceinline__ int crow(int r, int hi) { return (r & 3) + 8 * (r >> 2) + 4 * hi; }
__device__ __forceinline__ float siluf(float a) { return a / (1.0f + __expf(-a)); }

#define XB_TMO      128
#define XB_XCNT(j)  (256  + 64 * (j))
#define XB_XSUB(j)  (1280 + 64 * (j))
#define XB_XGEN(j)  (2304 + 64 * (j))
#define XB_TOP      3328
#define XB_TOPGEN   3392
#define XCD_BAR_WORDS 3456
#define XB_SPIN_CAP (1u << 18)

__device__ __forceinline__ unsigned xb_ld(unsigned* p)              { return __hip_atomic_load(p, __ATOMIC_RELAXED, __HIP_MEMORY_SCOPE_AGENT); }
__device__ __forceinline__ unsigned xb_add(unsigned* p, unsigned v) { return __hip_atomic_fetch_add(p, v, __ATOMIC_RELAXED, __HIP_MEMORY_SCOPE_AGENT); }
__device__ __forceinline__ unsigned xb_xcc_id() { return (unsigned)__builtin_amdgcn_s_getreg((3 << 11) | 20) & 0xFu; }
#define XB_SPIN(cond, bar) do { unsigned _sp = 0; while (cond) { __builtin_amdgcn_s_sleep(1); \
    if ((++_sp & 255u) == 0u) { if (xb_ld(&(bar)[XB_TMO])) break; if (_sp > XB_SPIN_CAP) { atomicAdd(&(bar)[XB_TMO], 1u); break; } } } } while (0)

struct XcdBarrier {
    unsigned* bar; unsigned x;
    volatile LAS unsigned* st;
};

__device__ __forceinline__ XcdBarrier xcd_barrier_post(unsigned* bar, volatile LAS unsigned* st) {
    XcdBarrier b; b.bar = bar; b.x = xb_xcc_id(); b.st = st;
    if (threadIdx.x == 0) (void)xb_add(&bar[XB_XCNT(b.x)], 1u);
    return b;
}
__device__ __forceinline__ void xcd_barrier_complete(unsigned* bar, unsigned x, unsigned& nloc, unsigned& nx) {
    const unsigned G = gridDim.x * gridDim.y * gridDim.z;
    unsigned sum, cnt, mine, sp = 0u;
    for (;;) {
        sum = 0u; cnt = 0u; mine = 0u;
#pragma unroll
        for (unsigned j = 0; j < 16; ++j) { const unsigned c = xb_ld(&bar[XB_XCNT(j)]); sum += c; cnt += (c > 0u) ? 1u : 0u; mine = (j == x) ? c : mine; }
        if (sum == G) break;
        __builtin_amdgcn_s_sleep(1);
        if ((++sp & 255u) == 0u) { if (xb_ld(&bar[XB_TMO])) break; if (sp > XB_SPIN_CAP) { atomicAdd(&bar[XB_TMO], 1u); break; } }
    }
    nloc = mine > 0u ? mine : 1u; nx = cnt > 0u ? cnt : 1u;
}

__device__ __forceinline__ void xcd_barrier(const XcdBarrier& b) {
    asm volatile("s_waitcnt vmcnt(0)" ::: "memory");
    __syncthreads();
    if (threadIdx.x == 0) {
        unsigned* bar = b.bar;
        __builtin_amdgcn_s_waitcnt(0);
        unsigned nloc = b.st[0], nx = b.st[1];
        if (nloc == 0u) { xcd_barrier_complete(bar, b.x, nloc, nx); b.st[0] = nloc; b.st[1] = nx; }
        const unsigned old = xb_add(&bar[XB_XSUB(b.x)], 1u);
        const unsigned gen = old / nloc;
        if (old + 1u == (gen + 1u) * nloc) {
            __builtin_amdgcn_fence(__ATOMIC_RELEASE, "agent");
            asm volatile("s_waitcnt vmcnt(0)" ::: "memory");
            const unsigned og = xb_add(&bar[XB_TOP], 1u);
            const unsigned tg = og / nx;
            if (og + 1u == (tg + 1u) * nx) xb_add(&bar[XB_TOPGEN], 1u);
            else XB_SPIN(xb_ld(&bar[XB_TOPGEN]) == tg, bar);
            __builtin_amdgcn_fence(__ATOMIC_ACQUIRE, "agent");
            xb_add(&bar[XB_XGEN(b.x)], 1u);
            asm volatile("s_waitcnt vmcnt(0)" ::: "memory");
        } else {
            XB_SPIN(xb_ld(&bar[XB_XGEN(b.x)]) == gen, bar);
            __builtin_amdgcn_fence(__ATOMIC_ACQUIRE, "agent");
            asm volatile("s_waitcnt vmcnt(0)" ::: "memory");
        }
    }
    __syncthreads();
}


#define INP(i) ((const float*)F.in[i])
struct Frame {
    LAS unsigned char* lds;
    volatile LAS unsigned* MISC;
    gu32* ctl;
    int tid, lane, wave, G, bid;
    const CAS cfp* in;
    float* out; unsigned char* ws;
};


__device__ __forceinline__ void transpose_tile(const float* W, int ldw, int k0, int n0, bf16* WT, int ldt, int dst_row0, LAS float* scr, int lane) {
#pragma unroll 8
    for (int i = 0; i < 32; ++i) { const int kk = 2 * i + (lane >> 5); scr[kk * 33 + (lane & 31)] = W[(size_t)(k0 + kk) * ldw + n0 + (lane & 31)]; }
    LDS_WAIT(); asm volatile("" ::: "memory");
    const int c = lane & 7;
#pragma unroll
    for (int j = 0; j < 4; ++j) { const int n = (lane >> 3) + 8 * j; const LAS float* s = scr + (8 * c) * 33 + n;
        v4u o; o.x = pk2(s[0 * 33], s[1 * 33]); o.y = pk2(s[2 * 33], s[3 * 33]); o.z = pk2(s[4 * 33], s[5 * 33]); o.w = pk2(s[6 * 33], s[7 * 33]);
        *(v4u*)(WT + (size_t)(dst_row0 + n) * ldt + k0 + 8 * c) = o; }
    LDS_WAIT(); asm volatile("" ::: "memory");
}

__device__ __forceinline__ void transpose_tile64(const float* W, int ldw, int k0, int n0, bf16* WT, int ldt, int dst_row0, LAS float* scr, int lane) {
    f32x4 v[16];
#pragma unroll
    for (int j = 0; j < 16; ++j) v[j] = *(const f32x4*)(W + (size_t)(k0 + 4 * j + (lane >> 4)) * ldw + n0 + 4 * (lane & 15));
#pragma unroll
    for (int j = 0; j < 16; ++j) { LAS float* d = scr + (4 * j + (lane >> 4)) * 65 + 4 * (lane & 15); d[0] = v[j].x; d[1] = v[j].y; d[2] = v[j].z; d[3] = v[j].w; }
    LDS_WAIT(); asm volatile("" ::: "memory");
    const int c = lane & 7;
#pragma unroll
    for (int j = 0; j < 8; ++j) { const int n = (lane >> 3) + 8 * j; const LAS float* s = scr + (8 * c) * 65 + n;
        v4u o; o.x = pk2(s[0 * 65], s[1 * 65]); o.y = pk2(s[2 * 65], s[3 * 65]); o.z = pk2(s[4 * 65], s[5 * 65]); o.w = pk2(s[6 * 65], s[7 * 65]);
        *(v4u*)(WT + (size_t)(dst_row0 + n) * ldt + k0 + 8 * c) = o; }
    LDS_WAIT(); asm volatile("" ::: "memory");
}

__device__ __forceinline__ void norm_row_bf16(const float* xrow, const float* g, bf16* orow, int lane) {
    f32x4 v[8]; float s = 0.f;
#pragma unroll
    for (int j = 0; j < 8; ++j) { v[j] = ((const f32x4*)xrow)[lane + 64 * j]; s += (v[j].x * v[j].x + v[j].y * v[j].y) + (v[j].z * v[j].z + v[j].w * v[j].w); }
    const float rstd = 1.0f / sqrtf(wave_sum(s) * (1.0f / D) + EPS);
#pragma unroll
    for (int j = 0; j < 8; ++j) { const f32x4 gv = ((const f32x4*)g)[lane + 64 * j]; const f32x4 o = v[j] * rstd * gv;
        v2u w; w.x = pk2(o.x, o.y); w.y = pk2(o.z, o.w); NTST((v2u*)orow + lane + 64 * j, w); }
}

__device__ __forceinline__ void ph_prologue(Frame& F) {
    LAS float* scr = (LAS float*)(F.lds + F.wave * 16640);
    const int gw = F.bid * NWAVES + F.wave, NGW = F.G * NWAVES;
    constexpr int IT_IN = (D / 64) * (DIN / 32), IT_OUT = (D / 64) * (D / 64);
    for (int it = gw; it < 2 * (IT_IN + IT_OUT); it += NGW) {
        const int l = it / (IT_IN + IT_OUT); int r = it % (IT_IN + IT_OUT);
        if (r < IT_IN) { const int nblk = DIN / 32, kb = r / nblk, nb = r % nblk;
            transpose_tile(INP(I_W_IN) + (size_t)l * D * DIN, DIN, kb * 64, nb * 32, (bf16*)(F.ws + WS_WIN + l * WIN_BYTES), D, nb * 32, scr, F.lane); }
        else { r -= IT_IN; const int nblk = D / 64, kb = r / nblk, nb = r % nblk;
            transpose_tile64(INP(I_W_OUT) + (size_t)l * D * D, D, kb * 64, nb * 64, (bf16*)(F.ws + WS_WOUT + l * WOUT_BYTES), D, nb * 64, scr, F.lane); }
    }
    { const int gt = F.bid * NTHR + F.tid, NGT = F.G * NTHR; constexpr int PADV = (DINP - DIN) * D * 2 / 16;
      for (int i = gt; i < 2 * PADV; i += NGT) { const int l = i / PADV, r = i % PADV; ((v4u*)(F.ws + WS_WIN + l * WIN_BYTES + (size_t)DIN * D * 2))[r] = (v4u){0u, 0u, 0u, 0u}; }
      float* wg = (float*)(F.ws + WS_WRT);
      for (int i = gt; i < 2 * D * 64; i += NGT) { const int l = i / (D * 64), r_ = i % (D * 64), k = r_ >> 6, j = r_ & 63; const float gk = INP(I_NORM_FFN)[l * D + k];
          wg[i] = (j < 32) ? gk * INP(I_MOE_WE)[((size_t)l * D + k) * 32 + j] : (j < 36) ? gk * INP(I_MOE_WG)[((size_t)l * D + k) * 4 + (j - 32)] : 0.f; } }
    for (int m = gw; m < T; m += NGW) norm_row_bf16(INP(I_X) + (size_t)m * D, INP(I_NORM_MIX), (bf16*)(F.ws + WS_XN) + (size_t)m * D, F.lane);
}

__device__ __forceinline__ void ph_in_rem(Frame& F, int l) {
    const int gw = F.bid * NWAVES + F.wave, NGW = F.G * NWAVES, lane = F.lane, fr = lane & 15, fq = lane >> 4;
    const bf16* xn = (const bf16*)(F.ws + WS_XN); const bf16* wt = (const bf16*)(F.ws + WS_WIN + l * WIN_BYTES) + (size_t)DIN_FULL * D;
    bf16* proj = (bf16*)(F.ws + WS_P);
    for (int u = gw; u < T / 16; u += NGW) {
        const bf16* ap = xn + (size_t)(u * 16 + fr) * D + 8 * fq; const bf16* bp0 = wt + (size_t)fr * D + 8 * fq; const bf16* bp1 = bp0 + (size_t)16 * D;
        f32x4 acc0 = (f32x4){0.f, 0.f, 0.f, 0.f}, acc1 = (f32x4){0.f, 0.f, 0.f, 0.f};
#pragma unroll 8
        for (int ks = 0; ks < D / 32; ++ks) { const bf16x8 a = *(const bf16x8*)(ap + 32 * ks), b0 = *(const bf16x8*)(bp0 + 32 * ks), b1 = *(const bf16x8*)(bp1 + 32 * ks);
            acc0 = __builtin_amdgcn_mfma_f32_16x16x32_bf16(b0, a, acc0, 0, 0, 0); acc1 = __builtin_amdgcn_mfma_f32_16x16x32_bf16(b1, a, acc1, 0, 0, 0); }
        bf16* o = proj + (size_t)(u * 16 + fr) * DINP + DIN_FULL + 4 * fq;
        *(v2u*)o = (v2u){pk2(acc0.x, acc0.y), pk2(acc0.z, acc0.w)}; *(v2u*)(o + 16) = (v2u){pk2(acc1.x, acc1.y), pk2(acc1.z, acc1.w)};
    }
}
constexpr int GREC_BYTES = 49152, GREC_W = 16384, GREC_A = 24576, GREC_Q = 32768, GREC_K = 40960;
constexpr size_t WS_GREC = WS_T;
constexpr size_t WS_GCD = 7 * MiB;
__device__ __forceinline__ void ph_gdn_prep(Frame& F, int l) {
    LAS float* Ks = (LAS float*)F.lds;
    LAS float* Qs = (LAS float*)(F.lds + 16640);
    LAS float* Vs = (LAS float*)(F.lds + 33280);
    LAS float* KK = (LAS float*)(F.lds + 49664);
    LAS float* QK = (LAS float*)(F.lds + 66304);
    LAS float* AT = (LAS float*)(F.lds + 82944);
    LAS float* gfv = (LAS float*)(F.lds + 100352);
    const bf16* proj = (const bf16*)(F.ws + WS_P);
    const float* cw = INP(I_GDN_CONV) + (size_t)l * 3 * 1536;
    for (int unit = F.bid; unit < 2 * 8 * 256; unit += F.G) {
        int tid_ = F.tid; asm volatile("" : "+v"(tid_));
        const int tid = tid_, lane = tid & 63, wave = __builtin_amdgcn_readfirstlane(tid >> 6);
        const int n = unit & 255, h = (unit >> 8) & 7, b = unit >> 11;
        { const int j = tid >> 3, p = tid & 7, t = n * 64 + j; const size_t m = (size_t)b * SEQ + t;
          const bf16* pr = proj + m * DINP + C_AQKV + h * 64 + p * 8;
          float sq = 0.f, sk = 0.f; float qv[8], kv[8], vv[8];
#pragma unroll
          for (int part = 0; part < 3; ++part) {
              const v4u xc = *(const v4u*)(pr + part * 512);
              v4u xm = (v4u){0u, 0u, 0u, 0u}, xp = (v4u){0u, 0u, 0u, 0u};
              if (t > 0) xm = *(const v4u*)(pr + part * 512 - DINP);
              if (t < SEQ - 1) xp = *(const v4u*)(pr + part * 512 + DINP);
              const int ch = part * 512 + h * 64 + p * 8;
              const f32x4 w0a = *(const f32x4*)(cw + ch), w0b = *(const f32x4*)(cw + ch + 4), w1a = *(const f32x4*)(cw + 1536 + ch), w1b = *(const f32x4*)(cw + 1536 + ch + 4),
                          w2a = *(const f32x4*)(cw + 3072 + ch), w2b = *(const f32x4*)(cw + 3072 + ch + 4);
              const float c0[8] = {bflo(xm.x), bfhi(xm.x), bflo(xm.y), bfhi(xm.y), bflo(xm.z), bfhi(xm.z), bflo(xm.w), bfhi(xm.w)};
              const float c1[8] = {bflo(xc.x), bfhi(xc.x), bflo(xc.y), bfhi(xc.y), bflo(xc.z), bfhi(xc.z), bflo(xc.w), bfhi(xc.w)};
              const float c2[8] = {bflo(xp.x), bfhi(xp.x), bflo(xp.y), bfhi(xp.y), bflo(xp.z), bfhi(xp.z), bflo(xp.w), bfhi(xp.w)};
              const float ww0[8] = {w0a.x, w0a.y, w0a.z, w0a.w, w0b.x, w0b.y, w0b.z, w0b.w}, ww1[8] = {w1a.x, w1a.y, w1a.z, w1a.w, w1b.x, w1b.y, w1b.z, w1b.w}, ww2[8] = {w2a.x, w2a.y, w2a.z, w2a.w, w2b.x, w2b.y, w2b.z, w2b.w};
#pragma unroll
              for (int i = 0; i < 8; ++i) { float a = ww0[i] * c0[i] + ww1[i] * c1[i] + ww2[i] * c2[i]; a = a * __builtin_amdgcn_rcpf(1.0f + __expf(-a));
                  if (part == 0) { qv[i] = a; sq += a * a; } else if (part == 1) { kv[i] = a; sk += a * a; } else vv[i] = a; }
          }
          sq += __shfl_xor(sq, 1); sq += __shfl_xor(sq, 2); sq += __shfl_xor(sq, 4);
          sk += __shfl_xor(sk, 1); sk += __shfl_xor(sk, 2); sk += __shfl_xor(sk, 4);
          const float rq = 0.125f / sqrtf(sq + EPS), rk = 1.0f / sqrtf(sk + EPS);
#pragma unroll
          for (int i = 0; i < 8; ++i) { Qs[j * 65 + p * 8 + i] = qv[i] * rq; Ks[j * 65 + p * 8 + i] = kv[i] * rk; Vs[j * 64 + p * 8 + i] = vv[i]; }
          if (tid < 64) { const size_t mm = (size_t)b * SEQ + n * 64 + tid; const bf16* pb_ = proj + mm * DINP;
              const float xbf = bf2f(pb_[C_ABETA + h]), xbb = bf2f(pb_[C_ABETA + 8 + h]);
              const float xaf = bf2f(pb_[C_AALPHA + h]) + INP(I_GDN_DTB)[l * 16 + h], xab = bf2f(pb_[C_AALPHA + 8 + h]) + INP(I_GDN_DTB)[l * 16 + 8 + h];
              const float spf = (xaf > 20.f) ? xaf : __logf(1.0f + __expf(xaf)), spb = (xab > 20.f) ? xab : __logf(1.0f + __expf(xab));
              const float g_f = -__expf(INP(I_GDN_ALOG)[l * 16 + h]) * spf, g_b = -__expf(INP(I_GDN_ALOG)[l * 16 + 8 + h]) * spb;
              gfv[256 + tid] = 1.0f / (1.0f + __expf(-xbf)); gfv[320 + tid] = 1.0f / (1.0f + __expf(-xbb));
              float sf = g_f; float sb = __shfl(g_b, 63 - lane);
#pragma unroll
              for (int o = 1; o < 64; o <<= 1) { const float uf = __shfl_up(sf, o), ub = __shfl_up(sb, o); if (lane >= o) { sf += uf; sb += ub; } }
              gfv[128 + tid] = sf; gfv[192 + 63 - tid] = sb; }
        }
        LDS_BARRIER();
        { const int mat = wave >> 2, mt = wave & 3, r16 = lane & 15, q4 = lane >> 4; const LAS float* Am = mat ? Qs : Ks; LAS float* Om = mat ? QK : KK;
          f32x4 acc[4];
#pragma unroll
          for (int nt = 0; nt < 4; ++nt) acc[nt] = (f32x4){0.f, 0.f, 0.f, 0.f};
#pragma unroll 4
          for (int ks = 0; ks < 16; ++ks) { const float a = Am[(16 * mt + r16) * 65 + 4 * ks + q4];
#pragma unroll
              for (int nt = 0; nt < 4; ++nt) acc[nt] = __builtin_amdgcn_mfma_f32_16x16x4f32(a, Ks[(16 * nt + r16) * 65 + 4 * ks + q4], acc[nt], 0, 0, 0); }
#pragma unroll
          for (int nt = 0; nt < 4; ++nt)
#pragma unroll
              for (int rg = 0; rg < 4; ++rg) Om[(16 * mt + 4 * q4 + rg) * 65 + 16 * nt + r16] = acc[nt][rg];
        }
        LDS_BARRIER();
#pragma unroll
        for (int q = 0; q < 8; ++q) { const int e = tid + NTHR * q, i = e >> 6, j = e & 63; float v = 0.f;
            if (j > i) v = gfv[256 + j] * KK[j * 65 + i] * __expf(gfv[128 + j] - gfv[128 + i]);
            else if (j < i) v = gfv[320 + j] * KK[j * 65 + i] * __expf(gfv[192 + j] - gfv[192 + i]);
            AT[i * 68 + j] = v; }
        LDS_BARRIER();
        unsigned char* recf = F.ws + WS_GREC + ((size_t)((b * 8 + h) * 2 + 0) * 256 + n) * GREC_BYTES;
        unsigned char* recb = F.ws + WS_GREC + ((size_t)((b * 8 + h) * 2 + 1) * 256 + n) * GREC_BYTES;
        if (wave < 4) {
            const int dirw = wave >> 1, isW = wave & 1; const LAS float* gc = gfv + 128 + dirw * 64; const LAS float* be = gfv + 256 + dirw * 64;
            const LAS float* ATl = AT; asm volatile("" : "+v"(ATl), "+v"(gc), "+v"(be));
#define NFMA(acc_, a_, x_) asm("v_fma_f32 %0, -%1, %2, %0" : "+v"(acc_) : "v"(a_), "v"(x_))
#define NPKFMA(acc2_, a2_, xp_, EL) do { if ((EL) == 0) asm("v_pk_fma_f32 %0, %1, %2, %0 op_sel_hi:[1,0,1] neg_lo:[1,0,0] neg_hi:[1,0,0]" : "+v"(acc2_) : "v"(a2_), "v"(xp_)); \
                                         else asm("v_pk_fma_f32 %0, %1, %2, %0 op_sel:[0,1,0] op_sel_hi:[1,1,1] neg_lo:[1,0,0] neg_hi:[1,0,0]" : "+v"(acc2_) : "v"(a2_), "v"(xp_)); } while (0)
            f32x2 R2[32];
#pragma unroll
            for (int j = 0; j < 64; ++j) R2[j >> 1][j & 1] = isW ? (be[j] * Ks[j * 65 + lane] * __expf(gc[j])) : (be[j] * Vs[j * 64 + lane]);
            f32x4 cb[2][8];
#define SV_ROW(t) (BW ? ((t) < 62 ? 63 - ((t) >> 1) : 32 - ((t) - 62)) : ((t) < 62 ? ((t) >> 1) : 31 + ((t) - 62)))
#define SV_K0(t)  (BW ? (((t) < 62 && ((t) & 1)) ? 8 : 0) : ((((SV_ROW(t)) + 1) >> 2) + (((t) < 62 && ((t) & 1)) ? 8 : 0)))
#define SV_K1(t)  (BW ? (((t) < 62 && !((t) & 1)) ? 7 : ((SV_ROW(t) - 1) >> 2)) : (((t) < 62 && !((t) & 1)) ? ((((SV_ROW(t)) + 1) >> 2) + 7) : 15))
#define SV_LOAD(t) do { _Pragma("unroll") for (int k = SV_K0(t); k <= SV_K1(t); ++k) cb[(t) & 1][k - SV_K0(t)] = *(const LAS f32x4*)(ATl + SV_ROW(t) * 68 + 4 * k); } while (0)
#define SV_PAIR(j0, alo, ahi) do { if (!BW) { if ((j0) > i) { const f32x2 a2 = (f32x2){alo, ahi}; NPKFMA(R2[(j0) >> 1], a2, xp, i & 1); } else if ((j0) + 1 > i) NFMA(R2[(j0) >> 1][1], ahi, xi); } \
                                   else { if ((j0) + 1 < i) { const f32x2 a2 = (f32x2){alo, ahi}; NPKFMA(R2[(j0) >> 1], a2, xp, i & 1); } else if ((j0) < i) NFMA(R2[(j0) >> 1][0], alo, xi); } } while (0)
#define SV_RUN() do { SV_LOAD(0); \
                _Pragma("clang loop unroll(full)") for (int t = 0; t < 94; ++t) { \
                    if (t + 1 < 94) SV_LOAD(t + 1); \
                    __builtin_amdgcn_sched_barrier(0); \
                    const int i = SV_ROW(t); const float xi = R2[i >> 1][i & 1]; const f32x2 xp = R2[i >> 1]; \
                    _Pragma("unroll") for (int k = SV_K0(t); k <= SV_K1(t); ++k) { const f32x4 v = cb[t & 1][k - SV_K0(t)]; SV_PAIR(4 * k, v.x, v.y); SV_PAIR(4 * k + 2, v.z, v.w); } \
                    __builtin_amdgcn_sched_barrier(0); } } while (0)
            if (dirw == 0) { constexpr bool BW = false; SV_RUN(); } else { constexpr bool BW = true; SV_RUN(); }
#undef SV_ROW
#undef SV_K0
#undef SV_K1
#undef SV_LOAD
#undef SV_PAIR
#undef SV_RUN
            float R[64];
#pragma unroll
            for (int j = 0; j < 64; ++j) R[j] = R2[j >> 1][j & 1];
            unsigned char* rec = dirw ? recb : recf;
            if (!isW) { LAS unsigned char* st = F.lds + (dirw ? 102400 : 49664);
#pragma unroll
                for (int j = 0; j < 16; ++j) *(LAS f32x4*)(st + lane * 256 + ((j ^ (lane & 15)) << 4)) = (f32x4){R[4 * j], R[4 * j + 1], R[4 * j + 2], R[4 * j + 3]};
#pragma unroll
                for (int i = 0; i < 16; ++i) { const int row = (lane >> 4) + 4 * i, ch = lane & 15;
                    NTST((f32x4*)(rec + (size_t)row * 256 + ch * 16), *(const LAS f32x4*)(st + row * 256 + ((ch ^ (row & 15)) << 4))); } }
            else { LAS unsigned char* st = F.lds + (dirw ? 128000 : 118784);
#pragma unroll
                for (int j = 0; j < 64; ++j) *(LAS bf16*)(st + j * 144 + lane * 2) = (bf16)f2bf(-R[j]);
#pragma unroll
                for (int i = 0; i < 8; ++i) { const int row = (lane >> 3) + 8 * i, ch = lane & 7;
                    NTST((v4u*)(rec + GREC_W + (size_t)row * 128 + ch * 16), *(const LAS v4u*)(st + row * 144 + ch * 16)); } }
        } else {
            const int tl = tid - 256;
#pragma unroll
            for (int q = 0; q < 2; ++q) { const int e = tl + 256 * q, i = e >> 3, j0 = (e & 7) * 8;
                const float gfi = gfv[128 + i], gbi = gfv[192 + i], egf = __expf(gfi), egb = __expf(gbi), gfl = gfv[128 + 63], gbl = gfv[192 + 0];
                float af[8], ab[8], qf_[8], qb_[8], kf_[8], kb_[8];
#pragma unroll
                for (int c = 0; c < 8; ++c) { const int j = j0 + c; const float qk = QK[i * 65 + j];
                    af[c] = (j <= i) ? qk * __expf(gfi - gfv[128 + j]) : 0.f; ab[c] = (j >= i) ? qk * __expf(gbi - gfv[192 + j]) : 0.f;
                    const float qq = Qs[i * 65 + j]; qf_[c] = qq * egf; qb_[c] = qq * egb;
                    const float kk = Ks[j * 65 + i]; kf_[c] = kk * __expf(gfl - gfv[128 + j]); kb_[c] = kk * __expf(gbl - gfv[192 + j]); }
                const size_t off = (size_t)i * 128 + j0 * 2;
                NTST((v4u*)(recf + GREC_A + off), ((v4u){pk2(af[0], af[1]), pk2(af[2], af[3]), pk2(af[4], af[5]), pk2(af[6], af[7])}));
                NTST((v4u*)(recb + GREC_A + off), ((v4u){pk2(ab[0], ab[1]), pk2(ab[2], ab[3]), pk2(ab[4], ab[5]), pk2(ab[6], ab[7])}));
                NTST((v4u*)(recf + GREC_Q + off), ((v4u){pk2(qf_[0], qf_[1]), pk2(qf_[2], qf_[3]), pk2(qf_[4], qf_[5]), pk2(qf_[6], qf_[7])}));
                NTST((v4u*)(recb + GREC_Q + off), ((v4u){pk2(qb_[0], qb_[1]), pk2(qb_[2], qb_[3]), pk2(qb_[4], qb_[5]), pk2(qb_[6], qb_[7])}));
                NTST((v4u*)(recf + GREC_K + off), ((v4u){pk2(kf_[0], kf_[1]), pk2(kf_[2], kf_[3]), pk2(kf_[4], kf_[5]), pk2(kf_[6], kf_[7])}));
                NTST((v4u*)(recb + GREC_K + off), ((v4u){pk2(kb_[0], kb_[1]), pk2(kb_[2], kb_[3]), pk2(kb_[4], kb_[5]), pk2(kb_[6], kb_[7])})); }
            if (tl == 0) { float* cd = (float*)(F.ws + WS_GCD); cd[((b * 8 + h) * 2 + 0) * 256 + n] = __expf(gfv[128 + 63]); cd[((b * 8 + h) * 2 + 1) * 256 + n] = __expf(gfv[192 + 0]); }
        }
        LDS_BARRIER();
    }
}

typedef float f32x4m __attribute__((ext_vector_type(4)));
constexpr int N_SCAN_WG = 64;
__device__ __forceinline__ void ph_gdn_scan(Frame& F) {
    if (F.bid >= N_SCAN_WG) return;
    constexpr int LB_U = 0, LB_W = 17408, LB_A = 17408 + 9216, LB_Q = 17408 + 2 * 9216, LB_K = 17408 + 3 * 9216, LBUF = 17408 + 4 * 9216;
    constexpr int L_ST = 2 * LBUF, L_VT = 2 * LBUF + 9216;
    const int chain = F.bid >> 1, vh = F.bid & 1, dir = chain & 1, h = (chain >> 1) & 7, b = chain >> 4;
    const int tid = F.tid, lane = F.lane, wave = F.wave, r = lane & 15, q = lane >> 4, mt = wave >> 1, nt = 2 * vh + (wave & 1);
    const unsigned char* recs = F.ws + WS_GREC + (size_t)chain * 256 * GREC_BYTES;
    const float* cdv = (const float*)(F.ws + WS_GCD) + chain * 256;
    bf16* od = (bf16*)(F.ws + (dir ? WS_OB : WS_OF));
    LAS unsigned char* lds = F.lds;
    v4u pre[3][5];
    const unsigned goff0 = (unsigned)((512 * vh + tid) * 16), goff1 = (unsigned)((1024 + tid) * 16);
    const int loff0 = LB_U + (32 * vh + (tid >> 4)) * 272 + (tid & 15) * 16, loff1 = LB_W + (tid >> 3) * 144 + (tid & 7) * 16;
#define GS_LOAD(s_, n_) do { const unsigned char* rp_ = recs + (size_t)(n_) * GREC_BYTES; asm volatile("global_load_dwordx4 %0, %1, off" : "=v"(pre[s_][0]) : "v"(rp_ + goff0) : "memory"); \
        _Pragma("unroll") for (int i_ = 1; i_ < 5; ++i_) asm volatile("global_load_dwordx4 %0, %1, off" : "=v"(pre[s_][i_]) : "v"(rp_ + goff1 + (size_t)(i_ - 1) * 8192) : "memory"); } while (0)
#define GS_WAIT(s_, N_) GS_WAIT2(s_, N_)
#define GS_WAIT2(s_, N_) asm volatile("s_waitcnt vmcnt(" #N_ ")" : "+v"(pre[s_][0]), "+v"(pre[s_][1]), "+v"(pre[s_][2]), "+v"(pre[s_][3]), "+v"(pre[s_][4]) :: "memory")
#define GS_STORE(s_, bufo_) do { *(LAS v4u*)(lds + (bufo_) + loff0) = pre[s_][0]; _Pragma("unroll") for (int i_ = 1; i_ < 5; ++i_) *(LAS v4u*)(lds + (bufo_) + loff1 + (i_ - 1) * 9216) = pre[s_][i_]; } while (0)
    for (int i = tid; i < 9216 / 4; i += NTHR) ((LAS unsigned*)(lds + L_ST))[i] = 0u;
    LAS float* lcd = (LAS float*)(lds + L_VT + 9216);
    if (tid < 256) lcd[tid] = cdv[tid];
    f32x4m Sacc = {0.f, 0.f, 0.f, 0.f};
    const int n_first = dir ? 255 : 0, n_step = dir ? -1 : 1;
    GS_LOAD(0, n_first); GS_WAIT(0, 0); GS_STORE(0, 0);
    GS_LOAD(1, n_first + n_step); GS_LOAD(2, n_first + 2 * n_step);
    __syncthreads();
#define GS_STEP(SL_NEXT, SL_FREE, WAITN) do { \
        const int n = n_first + it * n_step, bo = (it & 1) * LBUF, bn = ((it + 1) & 1) * LBUF; \
        if (it + 3 < 256) GS_LOAD(SL_FREE, n + 3 * n_step); \
        const float cd = lcd[n]; \
        bf16x8 aw[2], aq[2], bs[2]; \
        _Pragma("unroll") for (int ks = 0; ks < 2; ++ks) { aw[ks] = *(const LAS bf16x8*)(lds + bo + LB_W + (16 * mt + r) * 144 + ks * 64 + q * 16); aq[ks] = *(const LAS bf16x8*)(lds + bo + LB_Q + (16 * mt + r) * 144 + ks * 64 + q * 16); \
            bs[ks] = *(const LAS bf16x8*)(lds + L_ST + (16 * nt + r) * 144 + ks * 64 + q * 16); } \
        f32x4m vn = *(const LAS f32x4m*)(lds + bo + LB_U + (16 * nt + r) * 272 + (16 * mt + 4 * q) * 4), oa = (f32x4m){0.f, 0.f, 0.f, 0.f}; \
        _Pragma("unroll") for (int ks = 0; ks < 2; ++ks) { vn = __builtin_amdgcn_mfma_f32_16x16x32_bf16(aw[ks], bs[ks], vn, 0, 0, 0); oa = __builtin_amdgcn_mfma_f32_16x16x32_bf16(aq[ks], bs[ks], oa, 0, 0, 0); } \
        *(LAS v2u*)(lds + L_VT + (16 * nt + r) * 144 + (16 * mt + 4 * q) * 2) = (v2u){pk2(vn.x, vn.y), pk2(vn.z, vn.w)}; \
        LDS_BARRIER(); \
        bf16x8 aa[2], ak[2], bv[2]; \
        _Pragma("unroll") for (int ks = 0; ks < 2; ++ks) { aa[ks] = *(const LAS bf16x8*)(lds + bo + LB_A + (16 * mt + r) * 144 + ks * 64 + q * 16); ak[ks] = *(const LAS bf16x8*)(lds + bo + LB_K + (16 * mt + r) * 144 + ks * 64 + q * 16); \
            bv[ks] = *(const LAS bf16x8*)(lds + L_VT + (16 * nt + r) * 144 + ks * 64 + q * 16); } \
        Sacc = Sacc * cd; \
        _Pragma("unroll") for (int ks = 0; ks < 2; ++ks) { oa = __builtin_amdgcn_mfma_f32_16x16x32_bf16(aa[ks], bv[ks], oa, 0, 0, 0); Sacc = __builtin_amdgcn_mfma_f32_16x16x32_bf16(ak[ks], bv[ks], Sacc, 0, 0, 0); } \
          \
        if (it + 1 < 256) { GS_WAIT(SL_NEXT, WAITN); GS_STORE(SL_NEXT, bn); } \
        *(LAS v2u*)(lds + L_ST + (16 * nt + r) * 144 + (16 * mt + 4 * q) * 2) = (v2u){pk2(Sacc.x, Sacc.y), pk2(Sacc.z, Sacc.w)}; \
        { bf16* op = od + ((size_t)b * SEQ + n * 64 + 16 * mt + 4 * q) * 512 + h * 64 + 16 * nt + r; \
          op[0] = (bf16)f2bf(oa.x); op[512] = (bf16)f2bf(oa.y); op[1024] = (bf16)f2bf(oa.z); op[1536] = (bf16)f2bf(oa.w); } \
        LDS_BARRIER(); ++it; } while (0)
    int it = 0;
    GS_STEP(1, 0, 10); GS_STEP(2, 1, 14);
    for (; it < 251; ) { GS_STEP(0, 2, 18); GS_STEP(1, 0, 18); GS_STEP(2, 1, 18); }
    GS_STEP(0, 2, 18); GS_STEP(1, 0, 18);
    GS_STEP(2, 1, 0); GS_STEP(0, 2, 0); GS_STEP(1, 0, 0);
#undef GS_STEP
#undef GS_LOAD
#undef GS_STORE
#undef GS_WAIT
#undef GS_WAIT2
}

__device__ __forceinline__ void ph_gdn_fin(Frame& F, int l) {
    const int gw = F.bid * NWAVES + F.wave, NGW = F.G * NWAVES, lane = F.lane;
    const bf16* of = (const bf16*)(F.ws + WS_OF); const bf16* ob = (const bf16*)(F.ws + WS_OB);
    const bf16* proj = (const bf16*)(F.ws + WS_P); bf16* y = (bf16*)(F.ws + WS_Y);
    const float* gnp = INP(I_GDN_NORM) + l * 64 + (lane & 7) * 8;
    const f32x4 g0 = *(const f32x4*)gnp, g1 = *(const f32x4*)(gnp + 4);
    const float gn[8] = {g0.x, g0.y, g0.z, g0.w, g1.x, g1.y, g1.z, g1.w};
    for (int m = gw; m < T; m += NGW) {
        const v4u a = *(const v4u*)(of + (size_t)m * 512 + lane * 8), c = *(const v4u*)(ob + (size_t)m * 512 + lane * 8), zz = *(const v4u*)(proj + (size_t)m * DINP + C_AZ + lane * 8);
        const float o[8] = {bflo(a.x) + bflo(c.x), bfhi(a.x) + bfhi(c.x), bflo(a.y) + bflo(c.y), bfhi(a.y) + bfhi(c.y), bflo(a.z) + bflo(c.z), bfhi(a.z) + bfhi(c.z), bflo(a.w) + bflo(c.w), bfhi(a.w) + bfhi(c.w)};
        const float z[8] = {bflo(zz.x), bfhi(zz.x), bflo(zz.y), bfhi(zz.y), bflo(zz.z), bfhi(zz.z), bflo(zz.w), bfhi(zz.w)};
        float ss = 0.f;
#pragma unroll
        for (int i = 0; i < 8; ++i) ss += o[i] * o[i];
        ss += __shfl_xor(ss, 1); ss += __shfl_xor(ss, 2); ss += __shfl_xor(ss, 4);
        const float r_ = 1.0f / sqrtf(ss * (1.0f / 64.0f) + EPS);
        float v[8];
#pragma unroll
        for (int i = 0; i < 8; ++i) v[i] = o[i] * r_ * gn[i] * (z[i] * __builtin_amdgcn_rcpf(1.0f + __expf(-z[i])));
        NTST((v4u*)(y + (size_t)m * D + lane * 8), ((v4u){pk2(v[0], v[1]), pk2(v[2], v[3]), pk2(v[4], v[5]), pk2(v[6], v[7])}));
    }
}

__device__ __forceinline__ void ph_hy_mlp(Frame& F, int l) {
    LAS float* zf = (LAS float*)F.lds;
    LAS float* h1 = (LAS float*)(F.lds + 16384);
    const float* w1 = INP(I_HY_W1) + (size_t)l * 33 * 64; const float* b1 = INP(I_HY_B1) + l * 64; const float* f1 = INP(I_HY_F1) + l * 64;
    const float* w2 = INP(I_HY_W2) + (size_t)l * 64 * 64; const float* b2 = INP(I_HY_B2) + l * 64; const float* f2 = INP(I_HY_F2) + l * 64;
    bf16* h2b = (bf16*)(F.ws + WS_H2T + (size_t)l * 2 * MiB);
    const int tid = F.tid, tl = tid & 63, jg = tid >> 6;
    for (int it = F.bid; it < FL / 64; it += F.G) {
        const int t0 = it * 64;
        for (int e = tid; e < 64 * 33; e += NTHR) { const int p = e / 33, f = e % 33, t = t0 + p; float val;
            if (f == 0) val = (float)t / (float)(FL - 1);
            else { const int i = (f - 1) & 15; const float fi = 1e-4f + (float)i * ((15.0f - 1e-4f) / 15.0f); const float w = 6.283185307179586f * (float)t / (float)FL; const float a = w * fi;
                   val = (f <= 16) ? cosf(a) : -sinf(a); }
            zf[p * 33 + f] = val; }
        __syncthreads();
#pragma unroll
        for (int jj = 0; jj < 8; ++jj) { const int j = jg * 8 + jj; float acc = b1[j];
            for (int i = 0; i < 33; ++i) acc += zf[tl * 33 + i] * w1[i * 64 + j];
            h1[tl * 65 + j] = sinf(f1[j] * acc); }
        __syncthreads();
#pragma unroll
        for (int jj = 0; jj < 8; ++jj) { const int j = jg * 8 + jj; float acc = b2[j];
            for (int i = 0; i < 64; ++i) acc += h1[tl * 65 + i] * w2[i * 64 + j];
            h2b[(size_t)(t0 + tl) * 64 + j] = (bf16)f2bf(sinf(f2[j] * acc)); }
        __syncthreads();
    }
}

__device__ __forceinline__ void ph_hy_expand(Frame& F, int l) {
    const bf16* h2b = (const bf16*)(F.ws + WS_H2T + (size_t)l * 2 * MiB); bf16* hT = (bf16*)(F.ws + WS_HT);
    const float* w3 = INP(I_HY_W3) + (size_t)l * 64 * 2048; const float* dl = INP(I_HY_DELTAS) + (size_t)l * 2048;
    const int gw = F.bid * NWAVES + F.wave, NGW = F.G * NWAVES, lane = F.lane, r32 = lane & 31, hi = lane >> 5;
    for (int task = gw; task < 64 * 32; task += NGW) {
        const int jt = task >> 5, tg = task & 31, j0 = jt * 32;
        bf16x8 af[4];
#pragma unroll
        for (int s = 0; s < 4; ++s) { float w[8];
#pragma unroll
            for (int i = 0; i < 8; ++i) w[i] = w3[(size_t)(16 * s + 8 * hi + i) * 2048 + j0 + r32];
            af[s] = __builtin_bit_cast(bf16x8, (v4u){pk2(w[0], w[1]), pk2(w[2], w[3]), pk2(w[4], w[5]), pk2(w[6], w[7])}); }
        float ad[16];
#pragma unroll
        for (int rg = 0; rg < 16; ++rg) ad[rg] = fabsf(dl[j0 + crow(rg, hi)]);
        for (int tt = 0; tt < 16; ++tt) {
            const int t0 = (tg * 16 + tt) * 32, t = t0 + r32;
            f32x16 acc = {0};
#pragma unroll
            for (int s = 0; s < 4; ++s) { const bf16x8 bfr = *(const bf16x8*)(h2b + (size_t)t * 64 + 16 * s + 8 * hi); acc = __builtin_amdgcn_mfma_f32_32x32x16_bf16(af[s], bfr, acc, 0, 0, 0); }
            const float tn = (float)t / (float)(FL - 1);
#pragma unroll
            for (int rg = 0; rg < 16; ++rg) hT[(size_t)(j0 + crow(rg, hi)) * FL + t] = (bf16)f2bf(acc[rg] * __expf(-tn * ad[rg]));
        }
    }
}

__device__ __forceinline__ void ph_hy_tin(Frame& F, int l) {
    LAS float* tile = (LAS float*)F.lds;
    const bf16* proj = (const bf16*)(F.ws + WS_P); bf16* uT = (bf16*)(F.ws + WS_UT);
    const float* cw = INP(I_HY_CONV) + (size_t)l * 3 * 1536;
    const int tid = F.tid;
    for (int it = F.bid; it < 2 * 256 * 24; it += F.G) {
        const int b = it / (256 * 24), r = it % (256 * 24), tt = r / 24, ct = r % 24, t0 = tt * 64, c0 = ct * 64;
        for (int e = tid; e < 66 * 8; e += NTHR) { const int row = e >> 3, ck = e & 7, t = t0 - 1 + row;
            v4u w = (v4u){0u, 0u, 0u, 0u};
            if (t >= 0 && t < SEQ) w = *(const v4u*)(proj + ((size_t)b * SEQ + t) * DINP + C_B + c0 + ck * 8);
            LAS float* d = tile + row * 65 + ck * 8;
            d[0] = bflo(w.x); d[1] = bfhi(w.x); d[2] = bflo(w.y); d[3] = bfhi(w.y); d[4] = bflo(w.z); d[5] = bfhi(w.z); d[6] = bflo(w.w); d[7] = bfhi(w.w); }
        __syncthreads();
        { const int chl = tid >> 3, tq = tid & 7, ch = c0 + chl; const float w0 = cw[ch], w1 = cw[1536 + ch], w2 = cw[3072 + ch];
          float v[8];
#pragma unroll
          for (int i = 0; i < 8; ++i) { const int tl = tq * 8 + i; v[i] = w0 * tile[tl * 65 + chl] + w1 * tile[(tl + 1) * 65 + chl] + w2 * tile[(tl + 2) * 65 + chl]; }
          v4u o; o.x = pk2(v[0], v[1]); o.y = pk2(v[2], v[3]); o.z = pk2(v[4], v[5]); o.w = pk2(v[6], v[7]);
          NTST((v4u*)(uT + ((size_t)b * 1536 + ch) * SEQ + t0 + tq * 8), o); }
        __syncthreads();
    }
}

#define FA(i) ((i) + (((i) >> 6) << 2))
__device__ __forceinline__ f32x2 cmul(f32x2 a, f32x2 b) { return (f32x2){a.x * b.x - a.y * b.y, a.x * b.y + a.y * b.x}; }
template <int K> __device__ __forceinline__ f32x2 cmul16(f32x2 a, bool conj) {
    constexpr float c16[8] = {1.000000000f, 0.923879533f, 0.707106781f, 0.382683432f, 0.000000000f, -0.382683432f, -0.707106781f, -0.923879533f}, s16[8] = {0.000000000f, 0.382683432f, 0.707106781f, 0.923879533f, 1.000000000f, 0.923879533f, 0.707106781f, 0.382683432f};
    const float c = c16[K], sn = conj ? s16[K] : -s16[K];
    if (K == 0) return a;
    if (K == 4) return conj ? (f32x2){-a.y, a.x} : (f32x2){a.y, -a.x};
    return (f32x2){a.x * c - a.y * sn, a.x * sn + a.y * c};
}
__device__ __forceinline__ f32x2 cmul_pk1(f32x2 a, f32x2 b) {
    f32x2 t, d;
    asm("v_pk_mul_f32 %0, %2, %3 op_sel_hi:[0,1]\n\ts_nop 0\n\tv_pk_fma_f32 %1, %2, %3, %0 op_sel:[1,1,0] op_sel_hi:[1,0,1] neg_lo:[0,1,0]" : "=&v"(t), "=&v"(d) : "v"(a), "v"(b));
    return d;
}
__device__ __forceinline__ void cmul_pk2(f32x2 a1, f32x2 b1, f32x2 a2, f32x2 b2, f32x2& d1, f32x2& d2) {
    f32x2 t1, t2;
    asm("v_pk_mul_f32 %0, %4, %5 op_sel_hi:[0,1]\n\tv_pk_mul_f32 %1, %6, %7 op_sel_hi:[0,1]\n\t"
        "v_pk_fma_f32 %2, %4, %5, %0 op_sel:[1,1,0] op_sel_hi:[1,0,1] neg_lo:[0,1,0]\n\tv_pk_fma_f32 %3, %6, %7, %1 op_sel:[1,1,0] op_sel_hi:[1,0,1] neg_lo:[0,1,0]"
        : "=&v"(t1), "=&v"(t2), "=&v"(d1), "=&v"(d2) : "v"(a1), "v"(b1), "v"(a2), "v"(b2));
}
template <int SP, bool INV> __device__ __forceinline__ void fft_r16_pass(LAS f32x2* Z, int tid) {
    constexpr int STR = (SP >= 64) ? (SP + SP / 16) : SP;
#pragma unroll
    for (int g = 0; g < 2; ++g) {
        const int grp = tid + NTHR * g, p = grp & (SP - 1), i0 = (grp / SP) * (16 * SP) + p;
        LAS f32x2* zb = Z + FA(i0);
        f32x2 e[16];
#pragma unroll
        for (int k = 0; k < 16; ++k) e[k] = zb[k * STR];
        const float fr = (float)p * (1.0f / (16.0f * (float)SP));
        const f32x2 w1 = (f32x2){__builtin_amdgcn_cosf(fr), INV ? __builtin_amdgcn_sinf(fr) : -__builtin_amdgcn_sinf(fr)};
        const f32x2 W16 = (f32x2){0.923879533f, INV ? 0.382683432f : -0.382683432f};
        f32x2 t1[8], t2[4], t3[2], t4;
        t1[0] = w1; t1[1] = cmul_pk1(w1, W16);
        cmul_pk2(t1[1], W16, t1[1], t1[1], t1[2], t2[1]);
        cmul_pk2(t1[2], W16, w1, w1, t1[3], t2[0]);
        cmul_pk2(t1[3], W16, t1[2], t1[2], t1[4], t2[2]);
        cmul_pk2(t1[4], W16, t1[3], t1[3], t1[5], t2[3]);
        cmul_pk2(t1[5], W16, t2[0], t2[0], t1[6], t3[0]);
        cmul_pk2(t1[6], W16, t2[1], t2[1], t1[7], t3[1]);
        t4 = cmul_pk1(t3[0], t3[0]);
#define R16_BF2(a1_, b1_, T1, a2_, b2_, T2) do { if (!INV) { const f32x2 s1_ = e[a1_] + e[b1_], d1_ = e[a1_] - e[b1_], s2_ = e[a2_] + e[b2_], d2_ = e[a2_] - e[b2_]; e[a1_] = s1_; e[a2_] = s2_; cmul_pk2(d1_, T1, d2_, T2, e[b1_], e[b2_]); } \
                                               else { f32x2 u1_, u2_; cmul_pk2(e[b1_], T1, e[b2_], T2, u1_, u2_); e[b1_] = e[a1_] - u1_; e[a1_] = e[a1_] + u1_; e[b2_] = e[a2_] - u2_; e[a2_] = e[a2_] + u2_; } } while (0)
#define R16_ST1() do { R16_BF2(0, 8, t1[0], 1, 9, t1[1]); R16_BF2(2, 10, t1[2], 3, 11, t1[3]); R16_BF2(4, 12, t1[4], 5, 13, t1[5]); R16_BF2(6, 14, t1[6], 7, 15, t1[7]); } while (0)
#define R16_ST2() do { R16_BF2(0, 4, t2[0], 8, 12, t2[0]); R16_BF2(1, 5, t2[1], 9, 13, t2[1]); R16_BF2(2, 6, t2[2], 10, 14, t2[2]); R16_BF2(3, 7, t2[3], 11, 15, t2[3]); } while (0)
#define R16_ST3() do { R16_BF2(0, 2, t3[0], 4, 6, t3[0]); R16_BF2(8, 10, t3[0], 12, 14, t3[0]); R16_BF2(1, 3, t3[1], 5, 7, t3[1]); R16_BF2(9, 11, t3[1], 13, 15, t3[1]); } while (0)
#define R16_ST4() do { R16_BF2(0, 1, t4, 2, 3, t4); R16_BF2(4, 5, t4, 6, 7, t4); R16_BF2(8, 9, t4, 10, 11, t4); R16_BF2(12, 13, t4, 14, 15, t4); } while (0)
        if (!INV) { R16_ST1(); R16_ST2(); R16_ST3(); R16_ST4(); } else { R16_ST4(); R16_ST3(); R16_ST2(); R16_ST1(); }
#undef R16_BF2
#undef R16_ST1
#undef R16_ST2
#undef R16_ST3
#undef R16_ST4
#pragma unroll
        for (int k = 0; k < 16; ++k) zb[k * STR] = e[k];
    }
    __syncthreads();
}
template <bool INV> __device__ __forceinline__ void fft_r4_pass(LAS f32x2* Z, int tid) {
#pragma unroll 4
    for (int g = 0; g < 8; ++g) {
        const int i0 = (tid + NTHR * g) * 4;
        LAS f32x4* zp = (LAS f32x4*)(Z + FA(i0));
        const f32x4 u = zp[0], v = zp[1];
        const f32x2 e0 = (f32x2){u.x, u.y}, e1 = (f32x2){u.z, u.w}, e2 = (f32x2){v.x, v.y}, e3 = (f32x2){v.z, v.w};
        f32x2 r0, r1, r2, r3;
        if (!INV) { const f32x2 a0 = e0 + e2, a2 = e0 - e2, a1 = e1 + e3, d = e1 - e3; const f32x2 a3 = (f32x2){d.y, -d.x};
                    r0 = a0 + a1; r1 = a0 - a1; r2 = a2 + a3; r3 = a2 - a3; }
        else { const f32x2 s0 = e0 + e1, s1 = e0 - e1, s2 = e2 + e3, s3 = e2 - e3; const f32x2 c = (f32x2){-s3.y, s3.x};
               r0 = s0 + s2; r2 = s0 - s2; r1 = s1 + c; r3 = s1 - c; }
        zp[0] = (f32x4){r0.x, r0.y, r1.x, r1.y}; zp[1] = (f32x4){r2.x, r2.y, r3.x, r3.y};
    }
    __syncthreads();
}
__device__ __forceinline__ void fft_fwd(LAS f32x2* Z, int tid) { fft_r16_pass<1024, false>(Z, tid); fft_r16_pass<64, false>(Z, tid); fft_r16_pass<4, false>(Z, tid); fft_r4_pass<false>(Z, tid); }
__device__ __forceinline__ void fft_inv(LAS f32x2* Z, int tid) { fft_r4_pass<true>(Z, tid); fft_r16_pass<4, true>(Z, tid); fft_r16_pass<64, true>(Z, tid); fft_r16_pass<1024, true>(Z, tid); }
__device__ __forceinline__ void ld8bf(const bf16* p, float (&v)[8]) { const v4u w = *(const v4u*)p; v[0] = bflo(w.x); v[1] = bfhi(w.x); v[2] = bflo(w.y); v[3] = bfhi(w.y); v[4] = bflo(w.z); v[5] = bfhi(w.z); v[6] = bflo(w.w); v[7] = bfhi(w.w); }
__device__ __forceinline__ void ph_hy_fft(Frame& F, int l) {
    LAS f32x2* Z = (LAS f32x2*)F.lds;
    volatile LAS float* red = (volatile LAS float*)(F.lds + MISC_OFF + 64);
    const bf16* hT = (const bf16*)(F.ws + WS_HT);
    const bf16* uT = (const bf16*)(F.ws + WS_UT); float* yT = (float*)(F.ws + WS_YT);
    f32x2* scr = (f32x2*)(F.ws + WS_FSCR) + (size_t)F.bid * (4 * FL);
    f32x2* KE = scr; f32x2* KO = scr + FL; f32x2* R1 = scr + 2 * FL; f32x2* Y0 = scr + 3 * FL;
    const int tid = F.tid;
#define FQ_LOOP _Pragma("unroll 2") for (int q = 0; q < 4; ++q)
#define FQ_IDX const int ck = tid + NTHR * q, n0 = 8 * ck; LAS f32x4* z4 = (LAS f32x4*)(Z + FA(n0))
    for (int c = F.bid; c < 512; c += F.G) {
        for (int o = 0; o < 2; ++o) {
            const bf16* hf = hT + (size_t)((o * 2 + 0) * 512 + c) * FL; const bf16* hb = hT + (size_t)((o * 2 + 1) * 512 + c) * FL;
            const float bias = INP(I_HY_BIAS)[(l * 2 + o) * 512 + c];
            const bf16* v0 = uT + ((size_t)0 * 1536 + 1024 + c) * SEQ; const bf16* v1 = uT + ((size_t)1 * 1536 + 1024 + c) * SEQ;
#define FQ_LOADZ(zz) f32x4 zz[4]; if (o == 0) { float p0_[8], p1_[8]; ld8bf(v0 + n0, p0_); ld8bf(v1 + n0, p1_); _Pragma("unroll") for (int jj = 0; jj < 4; ++jj) zz[jj] = (f32x4){p0_[2 * jj], p1_[2 * jj], p0_[2 * jj + 1], p1_[2 * jj + 1]}; } \
                     else { const f32x4* y4_ = (const f32x4*)(Y0 + n0); _Pragma("unroll") for (int jj = 0; jj < 4; ++jj) zz[jj] = y4_[jj]; }
            float sc = 0.f;
#pragma nounroll
            for (int k = 0; k < 6; ++k) {
                if (k == 0) {
                    float part = 0.f;
                    FQ_LOOP { FQ_IDX; float a[8], bch[8], br[8]; ld8bf(hf + n0, a); ld8bf(hb + (FL - 8 - n0), bch);
                        br[0] = (ck >= 1) ? bf2f(hb[FL - n0]) : 0.f;
#pragma unroll
                        for (int j = 1; j < 8; ++j) br[j] = bch[8 - j];
#pragma unroll
                        for (int j = 0; j < 8; ++j) part += fabsf(a[j]) + fabsf(br[j]);
#pragma unroll
                        for (int jj = 0; jj < 4; ++jj) z4[jj] = (f32x4){a[2 * jj] + br[2 * jj], 0.f, a[2 * jj + 1] + br[2 * jj + 1], 0.f}; }
                    part = wave_sum(part);
                    if (F.lane == 0) red[F.wave] = part;
                    __syncthreads();
                    float nrm = 0.f;
#pragma unroll
                    for (int w = 0; w < NWAVES; ++w) nrm += red[w];
                    sc = 1.0f / (2.0f * (float)FL * (nrm + EPS));
                } else if (k == 1) {
                    FQ_LOOP { FQ_IDX; f32x4* k4 = (f32x4*)(KE + n0); float a[8], bch[8], br[8]; ld8bf(hf + n0, a); ld8bf(hb + (FL - 8 - n0), bch);
                        br[0] = (ck >= 1) ? bf2f(hb[FL - n0]) : 0.f;
#pragma unroll
                        for (int j = 1; j < 8; ++j) br[j] = bch[8 - j];
#pragma unroll
                        for (int jj = 0; jj < 4; ++jj) { k4[jj] = z4[jj];
                            const float d0 = a[2 * jj] - br[2 * jj], d1 = a[2 * jj + 1] - br[2 * jj + 1]; const float f0 = (float)(n0 + 2 * jj) * (0.5f / (float)FL), f1 = (float)(n0 + 2 * jj + 1) * (0.5f / (float)FL);
                            z4[jj] = (f32x4){d0 * __builtin_amdgcn_cosf(f0), -d0 * __builtin_amdgcn_sinf(f0), d1 * __builtin_amdgcn_cosf(f1), -d1 * __builtin_amdgcn_sinf(f1)}; } }
                } else if (k == 2) {
                    FQ_LOOP { FQ_IDX; f32x4* k4 = (f32x4*)(KO + n0); FQ_LOADZ(zv);
#pragma unroll
                        for (int jj = 0; jj < 4; ++jj) { k4[jj] = z4[jj]; z4[jj] = zv[jj]; } }
                } else if (k == 3 || k == 5) {
                    const f32x2* KX = (k == 3) ? KE : KO;
                    FQ_LOOP { FQ_IDX; const f32x4* k4 = (const f32x4*)(KX + n0);
#pragma unroll
                        for (int jj = 0; jj < 4; ++jj) { const f32x4 a = z4[jj], kk = k4[jj]; z4[jj] = (f32x4){a.x * kk.x - a.y * kk.y, a.x * kk.y + a.y * kk.x, a.z * kk.z - a.w * kk.w, a.z * kk.w + a.w * kk.z}; } }
                } else {
                    FQ_LOOP { FQ_IDX; f32x4* r4 = (f32x4*)(R1 + n0); FQ_LOADZ(zv);
#pragma unroll
                        for (int jj = 0; jj < 4; ++jj) { r4[jj] = z4[jj]; const float f0 = (float)(n0 + 2 * jj) * (0.5f / (float)FL), f1 = (float)(n0 + 2 * jj + 1) * (0.5f / (float)FL);
                            const float c0 = __builtin_amdgcn_cosf(f0), s0 = -__builtin_amdgcn_sinf(f0), c1 = __builtin_amdgcn_cosf(f1), s1 = -__builtin_amdgcn_sinf(f1); const f32x4 z = zv[jj];
                            z4[jj] = (f32x4){z.x * c0 - z.y * s0, z.x * s0 + z.y * c0, z.z * c1 - z.w * s1, z.z * s1 + z.w * c1}; } }
                }
                __syncthreads();
                if (k == 3 || k == 5) fft_inv(Z, tid); else fft_fwd(Z, tid);
            }
            const bf16* x0 = uT + ((size_t)0 * 1536 + o * 512 + c) * SEQ; const bf16* x1 = uT + ((size_t)1 * 1536 + o * 512 + c) * SEQ;
            FQ_LOOP { FQ_IDX; FQ_LOADZ(zv); float g0[8], g1[8]; ld8bf(x0 + n0, g0); ld8bf(x1 + n0, g1); const f32x4* r4 = (const f32x4*)(R1 + n0);
                f32x4 ov[4];
#pragma unroll
                for (int jj = 0; jj < 4; ++jj) { const float f0 = (float)(n0 + 2 * jj) * (0.5f / (float)FL), f1 = (float)(n0 + 2 * jj + 1) * (0.5f / (float)FL);
                    const float c0 = __builtin_amdgcn_cosf(f0), s0 = __builtin_amdgcn_sinf(f0), c1 = __builtin_amdgcn_cosf(f1), s1 = __builtin_amdgcn_sinf(f1);
                    const f32x4 r2 = z4[jj], r1 = r4[jj], z = zv[jj];
                    const float ax = (r1.x + (r2.x * c0 - r2.y * s0)) * sc, ay = (r1.y + (r2.x * s0 + r2.y * c0)) * sc, bx = (r1.z + (r2.z * c1 - r2.w * s1)) * sc, by = (r1.w + (r2.z * s1 + r2.w * c1)) * sc;
                    ov[jj] = (f32x4){g0[2 * jj] * (ax + z.x * bias), g1[2 * jj] * (ay + z.y * bias), g0[2 * jj + 1] * (bx + z.z * bias), g1[2 * jj + 1] * (by + z.w * bias)}; }
                if (o == 0) { f32x4* y4 = (f32x4*)(Y0 + n0);
#pragma unroll
                    for (int jj = 0; jj < 4; ++jj) y4[jj] = ov[jj]; }
                else { f32x4* ya = (f32x4*)(yT + ((size_t)0 * 512 + c) * SEQ + n0); f32x4* yb = (f32x4*)(yT + ((size_t)1 * 512 + c) * SEQ + n0);
                    NTST(ya, ((f32x4){ov[0].x, ov[0].z, ov[1].x, ov[1].z})); NTST(ya + 1, ((f32x4){ov[2].x, ov[2].z, ov[3].x, ov[3].z}));
                    NTST(yb, ((f32x4){ov[0].y, ov[0].w, ov[1].y, ov[1].w})); NTST(yb + 1, ((f32x4){ov[2].y, ov[2].w, ov[3].y, ov[3].w})); } }
            __syncthreads();
        }
    }
#undef FQ_LOOP
#undef FQ_IDX
#undef FQ_LOADZ
}

__device__ __forceinline__ void ph_hy_fin(Frame& F, int l) {
    LAS float* tile = (LAS float*)F.lds;
    const float* yT = (const float*)(F.ws + WS_YT); bf16* y = (bf16*)(F.ws + WS_Y);
    const float* hn = INP(I_HY_NORM) + l * 512;
    const int tid = F.tid, lane = F.lane;
    for (int it = F.bid; it < 2 * 512; it += F.G) {
        const int b = it >> 9, t0 = (it & 511) * 32;
        for (int e = tid; e < 512 * 8; e += NTHR) { const int ch = e >> 3, q = e & 7; const f32x4 v = *(const f32x4*)(yT + ((size_t)b * 512 + ch) * SEQ + t0 + q * 4);
            LAS float* d = tile + ch * 33 + q * 4; d[0] = v.x; d[1] = v.y; d[2] = v.z; d[3] = v.w; }
        __syncthreads();
#pragma unroll
        for (int k = 0; k < 4; ++k) { const int tl = F.wave * 4 + k; float v[8]; float ss = 0.f;
#pragma unroll
            for (int i = 0; i < 8; ++i) { v[i] = tile[(lane + 64 * i) * 33 + tl]; ss += v[i] * v[i]; }
            const float r = 1.0f / sqrtf(wave_sum(ss) * (1.0f / 512.0f) + EPS);
            bf16* yr = y + ((size_t)b * SEQ + t0 + tl) * D + 512;
#pragma unroll
            for (int i = 0; i < 8; ++i) yr[lane + 64 * i] = (bf16)f2bf(v[i] * r * hn[lane + 64 * i]); }
        __syncthreads();
    }
}

__device__ __forceinline__ void ph_at_prep(Frame& F, int l) {
    const int gw = F.bid * NWAVES + F.wave, NGW = F.G * NWAVES, lane = F.lane;
    const bf16* proj = (const bf16*)(F.ws + WS_P);
    bf16* Qp = (bf16*)(F.ws + WS_QP); bf16* Kp = (bf16*)(F.ws + WS_KP); bf16* VtC = (bf16*)(F.ws + WS_VTC); bf16* Vp = (bf16*)(F.ws + WS_VP);
    const int j = lane & 7, half = j >> 2, second = (j >> 1) & 1;
    float invf[8], qg[8], kg[8];
#pragma unroll
    for (int e = 0; e < 8; ++e) { invf[e] = exp2f(-(float)(8 * (j & 1) + e) * (1.0f / 16.0f) * 13.287712379549449f) * 0.15915494309189535f;
        qg[e] = INP(I_GA_QN)[l * 64 + 8 * j + e]; kg[e] = INP(I_GA_KN)[l * 64 + 8 * j + e]; }
#define AP_ROW(w_, gain_, scale_, dst_, pos_) do { const float x_[8] = {bflo(w_.x), bfhi(w_.x), bflo(w_.y), bfhi(w_.y), bflo(w_.z), bfhi(w_.z), bflo(w_.w), bfhi(w_.w)}; \
        float ss_ = 0.f; _Pragma("unroll") for (int e = 0; e < 8; ++e) ss_ += x_[e] * x_[e]; \
        ss_ += __shfl_xor(ss_, 1); ss_ += __shfl_xor(ss_, 2); ss_ += __shfl_xor(ss_, 4); \
        const float r_ = 1.0f / sqrtf(ss_ * (1.0f / 64.0f) + EPS); float o_[8]; \
        _Pragma("unroll") for (int e = 0; e < 8; ++e) { const float xn_ = x_[e] * r_ * gain_[e], other_ = __shfl_xor(xn_, 2), rev_ = (pos_) * invf[e]; \
            const float sn_ = __builtin_amdgcn_sinf(rev_), cs_ = __builtin_amdgcn_cosf(rev_); o_[e] = (second ? (xn_ * cs_ + other_ * sn_) : (xn_ * cs_ - other_ * sn_)) * (scale_); } \
        *(v4u*)(dst_) = (v4u){pk2(o_[0], o_[1]), pk2(o_[2], o_[3]), pk2(o_[4], o_[5]), pk2(o_[6], o_[7])}; } while (0)
    for (int m = gw; m < T; m += NGW) {
        const int t = m % SEQ; const float pos = (float)(half ? (t & 63) : (t >> 6));
        const v4u w = *(const v4u*)(proj + (size_t)m * DINP + C_DQ + lane * 8);
        AP_ROW(w, qg, C2, Qp + (size_t)m * 512 + lane * 8, pos);
    }
    for (int m4 = gw * 4; m4 < T; m4 += NGW * 4) {
        const int m = m4 + (lane >> 4), hh = (lane >> 3) & 1, t = m % SEQ; const float pos = (float)(half ? (t & 63) : (t >> 6));
        const bf16* pr = proj + (size_t)m * DINP + C_DKV + hh * 64 + j * 8;
        const v4u w = *(const v4u*)pr, vv = *(const v4u*)(pr + 128);
        AP_ROW(w, kg, 1.0f, Kp + (size_t)m * 128 + hh * 64 + j * 8, pos);
        *(v4u*)(Vp + (size_t)m * 128 + hh * 64 + j * 8) = vv;
    }
#undef AP_ROW
    for (int u = gw; u < 2 * 2 * 256; u += NGW) {
        const int b = u >> 9, kh = (u >> 8) & 1, t = (u & 255) * 64 + lane;
        const v4u* src = (const v4u*)(proj + ((size_t)b * SEQ + t) * DINP + C_CKV + 128 + kh * 64);
        bf16* dst = VtC + (size_t)(b * 2 + kh) * 64 * SEQ + t;
#pragma unroll
        for (int i = 0; i < 8; ++i) { const v4u w = src[i]; const unsigned ww[4] = {w.x, w.y, w.z, w.w};
#pragma unroll
            for (int k = 0; k < 4; ++k) { dst[(size_t)(8 * i + 2 * k) * SEQ] = (bf16)(ww[k] & 0xffffu); dst[(size_t)(8 * i + 2 * k + 1) * SEQ] = (bf16)(ww[k] >> 16); } }
    }
}
template <bool SWA>
__device__ __forceinline__ void attn_wave(const bf16* Q, int qpitch, const bf16* K, int kpitch, const bf16* Vt, bf16* O, int q0, int lane, float slope2, float sink2, float qscale) {
    const int r32 = lane & 31, hi = lane >> 5;
    bf16x8 qf[4];
#pragma unroll
    for (int s = 0; s < 4; ++s) qf[s] = *(const bf16x8*)(Q + (size_t)(q0 + r32) * qpitch + 16 * s + 8 * hi);
    f32x16 o0 = {0}, o1 = {0};
    float m_run = -1e30f, l_run = 0.f;
    int kt_lo, kt_hi;
    if (SWA) { kt_lo = (q0 - 128) / 32; if (kt_lo < 0) kt_lo = 0; kt_hi = (q0 + 31 + 128) / 32; if (kt_hi > SEQ / 32 - 1) kt_hi = SEQ / 32 - 1; }
    else { kt_lo = 0; kt_hi = SEQ / 32 - 1; }
    const int qpos = q0 + r32;
    for (int kt = kt_lo; kt <= kt_hi; ++kt) {
        const int k0 = kt * 32;
        f32x16 st = {0};
#pragma unroll
        for (int s = 0; s < 4; ++s) { const bf16x8 kf = *(const bf16x8*)(K + (size_t)(k0 + r32) * kpitch + 16 * s + 8 * hi);
            st = __builtin_amdgcn_mfma_f32_32x32x16_bf16(kf, qf[s], st, 0, 0, 0); }
        float mx = -1e30f;
#pragma unroll
        for (int r = 0; r < 16; ++r) {
            float v = st[r];
            if (SWA) { const int kv = k0 + crow(r, hi); int dist = qpos - kv; dist = dist < 0 ? -dist : dist; v = v * qscale - slope2 * (float)dist; if (dist > 128) v = -1e30f; }
            st[r] = v; mx = fmaxf(mx, v);
        }
        mx = fmaxf(mx, __shfl_xor(mx, 32));
        const float m_new = fmaxf(m_run, mx);
        const float alpha = exp2f(m_run - m_new);
        float rs = 0.f;
#pragma unroll
        for (int r = 0; r < 16; ++r) { const float p = (st[r] <= -1e29f) ? 0.f : exp2f(st[r] - m_new); st[r] = p; rs += p; }
        rs += __shfl_xor(rs, 32);
        l_run = l_run * alpha + rs; m_run = m_new;
#pragma unroll
        for (int r = 0; r < 16; ++r) { o0[r] *= alpha; o1[r] *= alpha; }
#pragma unroll
        for (int s = 0; s < 2; ++s) {
            v4u pw; pw.x = pk2(st[8 * s + 0], st[8 * s + 1]); pw.y = pk2(st[8 * s + 2], st[8 * s + 3]); pw.z = pk2(st[8 * s + 4], st[8 * s + 5]); pw.w = pk2(st[8 * s + 6], st[8 * s + 7]);
            const bf16x8 pf = __builtin_bit_cast(bf16x8, pw);
#pragma unroll
            for (int db = 0; db < 2; ++db) {
                const bf16* vp = Vt + (size_t)(db * 32 + r32) * SEQ + k0 + 16 * s + 4 * hi;
                const v2u a = *(const v2u*)vp, c = *(const v2u*)(vp + 8);
                const bf16x8 vf = __builtin_bit_cast(bf16x8, (v4u){a.x, a.y, c.x, c.y});
                if (db == 0) o0 = __builtin_amdgcn_mfma_f32_32x32x16_bf16(vf, pf, o0, 0, 0, 0);
                else o1 = __builtin_amdgcn_mfma_f32_32x32x16_bf16(vf, pf, o1, 0, 0, 0);
            }
        }
    }
    float den = l_run;
    if (SWA) den += exp2f(sink2 - m_run);
    const float inv = 1.0f / den;
    bf16* orow = O + (size_t)(q0 + r32) * 512;
#pragma unroll
    for (int g = 0; g < 4; ++g) {
        v2u w0, w1;
        w0.x = pk2(o0[4 * g] * inv, o0[4 * g + 1] * inv); w0.y = pk2(o0[4 * g + 2] * inv, o0[4 * g + 3] * inv);
        w1.x = pk2(o1[4 * g] * inv, o1[4 * g + 1] * inv); w1.y = pk2(o1[4 * g + 2] * inv, o1[4 * g + 3] * inv);
        *(v2u*)(orow + 8 * g + 4 * hi) = w0; *(v2u*)(orow + 32 + 8 * g + 4 * hi) = w1;
    }
}
__device__ __forceinline__ void ph_at_global(Frame& F, int l) {
    typedef attn_body::bf16 abf;
    const abf* Qp = (const abf*)(F.ws + WS_QP); const abf* Kp = (const abf*)(F.ws + WS_KP); const abf* Vp = (const abf*)(F.ws + WS_VP); abf* og = (abf*)(F.ws + WS_OGD);
    float gq = fabsf(INP(I_GA_QN)[l * 64 + F.lane]), gk = fabsf(INP(I_GA_KN)[l * 64 + F.lane]);
#pragma unroll
    for (int o = 1; o < 64; o <<= 1) { gq = fmaxf(gq, __shfl_xor(gq, o)); gk = fmaxf(gk, __shfl_xor(gk, o)); }
    const float mshift = 64.0f * C2 * gq * gk;
    for (int i = 0; ; ++i) {
        int b, hq, qb;
        if (F.G == 256) { if (i >= 4) break; const int x = F.bid & 7, ul = (F.bid >> 3) * 4 + i; b = x >> 2; hq = ((x >> 1) & 1) * 4 + (x & 1) * 2 + (ul >> 6); qb = ul & 63; }
        else { const int u = F.bid + i * F.G; if (u >= 1024) break; b = u >> 9; hq = (u >> 6) & 7; qb = u & 63; }
        const int kh = hq >> 2;
        attn_body::attn_unit<8, 512, 128, 128, 512, true>(qb * 256, SEQ / 64, Qp + (size_t)b * SEQ * 512 + hq * 64, Kp + (size_t)b * SEQ * 128 + kh * 64,
                                                     Vp + (size_t)b * SEQ * 128 + kh * 64, og + (size_t)b * SEQ * 512 + hq * 64, (char*)F.lds, mshift);
    }
}
__device__ __forceinline__ void ph_at_swa(Frame& F, int l) {
    const bf16* proj = (const bf16*)(F.ws + WS_P); const bf16* VtC = (const bf16*)(F.ws + WS_VTC); bf16* og = (bf16*)(F.ws + WS_OGC);
    for (int u = F.bid; u < 1024; u += F.G) {
        const int b = u >> 9, hq = (u >> 6) & 7, qt = u & 63, kh = hq >> 2;
        const float slope = exp2f(-(float)(hq + 1)); const float sink = INP(I_SWA_SINK)[l * 8 + hq];
        attn_wave<true>(proj + (size_t)b * SEQ * DINP + C_CQ + hq * 64, DINP, proj + (size_t)b * SEQ * DINP + C_CKV + kh * 64, DINP, VtC + (size_t)(b * 2 + kh) * 64 * SEQ,
                        og + (size_t)b * SEQ * 512 + hq * 64, qt * 256 + F.wave * 32, F.lane, slope * LOG2E, sink * LOG2E, C2);
    }
}
__device__ __forceinline__ void ph_at_fin(Frame& F, int l) {
    const int gw = F.bid * NWAVES + F.wave, NGW = F.G * NWAVES, lane = F.lane;
    bf16* y = (bf16*)(F.ws + WS_Y);
    const float* gnc = INP(I_SWA_NORM) + l * 512 + lane * 8; const float* gnd = INP(I_GA_NORM) + l * 512 + lane * 8;
    const f32x4 gc0 = *(const f32x4*)gnc, gc1 = *(const f32x4*)(gnc + 4), gd0 = *(const f32x4*)gnd, gd1 = *(const f32x4*)(gnd + 4);
    for (int m0 = gw * 2; m0 < T; m0 += NGW * 2) {
        v4u w[4];
#pragma unroll
        for (int k = 0; k < 4; ++k) w[k] = *(const v4u*)((const bf16*)(F.ws + ((k & 1) ? WS_OGD : WS_OGC)) + (size_t)(m0 + (k >> 1)) * 512 + lane * 8);
#pragma unroll
        for (int k = 0; k < 4; ++k) { const int grp = k & 1, m = m0 + (k >> 1);
            float v[8] = {bflo(w[k].x), bfhi(w[k].x), bflo(w[k].y), bfhi(w[k].y), bflo(w[k].z), bfhi(w[k].z), bflo(w[k].w), bfhi(w[k].w)};
            float ss = 0.f;
#pragma unroll
            for (int i = 0; i < 8; ++i) ss += v[i] * v[i];
            const float r = 1.0f / sqrtf(wave_sum(ss) * (1.0f / 512.0f) + EPS);
            const f32x4 g0 = grp ? gd0 : gc0, g1 = grp ? gd1 : gc1;
            v4u o; o.x = pk2(v[0] * r * g0.x, v[1] * r * g0.y); o.y = pk2(v[2] * r * g0.z, v[3] * r * g0.w); o.z = pk2(v[4] * r * g1.x, v[5] * r * g1.y); o.w = pk2(v[6] * r * g1.z, v[7] * r * g1.w);
            NTST((v4u*)(y + (size_t)m * D + 1024 + grp * 512 + lane * 8), o); }
    }
}

__device__ __forceinline__ void ph_moe_route(Frame& F, int l) {
    LAS float* scr = (LAS float*)(F.lds + F.wave * 16640);
    const int gw = F.bid * NWAVES + F.wave, NGW = F.G * NWAVES, lane = F.lane;
    constexpr int IT_G = (D / 64) * (DE / 64), IT_D = (DE / 64) * (D / 64);
    for (int it = gw; it < NE * (2 * IT_G + IT_D); it += NGW) {
        const int e = it / (2 * IT_G + IT_D); int r = it % (2 * IT_G + IT_D);
        if (r < 2 * IT_G) { const int up = r / IT_G; r %= IT_G; const int nblk = DE / 64, kb = r / nblk, nb = r % nblk, j0 = nb * 64;
            const float* W = (up ? INP(I_MOE_UP) : INP(I_MOE_GATE)) + ((size_t)l * NE + e) * D * DE;
            transpose_tile64(W, DE, kb * 64, j0, (bf16*)(F.ws + WS_GUT) + (size_t)e * 1024 * D, D, (j0 >> 7) * 256 + up * 128 + (j0 & 127), scr, lane); }
        else { r -= 2 * IT_G; const int nblk = D / 64, kb = r / nblk, nb = r % nblk;
            const float* W = INP(I_MOE_DOWN) + ((size_t)l * NE + e) * DE * D;
            transpose_tile64(W, D, kb * 64, nb * 64, (bf16*)(F.ws + WS_DT) + (size_t)e * D * DE, DE, nb * 64, scr, lane); }
    }
    const float* x = F.out; const float* g = INP(I_NORM_FFN) + (size_t)l * D;
    const float* wg = (const float*)(F.ws + WS_WRT) + (size_t)l * D * 64;
    bf16* xn = (bf16*)(F.ws + WS_XN); int* info = (int*)(F.ws + WS_INFO); int* elist = (int*)(F.ws + WS_ELIST);
    unsigned* cnt = (unsigned*)(F.ctl + CW_CNT + l * 64);
    LAS float* red = (LAS float*)F.lds;
    LAS float* part = (LAS float*)(F.lds + 36864);
    LAS float* fin = (LAS float*)(F.lds + 36864 + 1024);
    LAS float* rsd = (LAS float*)(F.lds + 36864 + 1024 + 4736);
    const int wave = F.wave, i32 = lane & 31, kk = lane >> 5;
    __syncthreads();
    for (int tile = F.bid; tile < T / 32; tile += F.G) {
        const int t0 = tile * 32;
        const float* xp = x + (size_t)(t0 + i32) * D + 256 * wave + 4 * kk;
        f32x4 x4[32]; float ss = 0.f;
#pragma unroll
        for (int m = 0; m < 32; ++m) x4[m] = *(const f32x4*)(xp + 8 * m);
        f32x16 acc0 = {0}, acc1 = {0};
        const float* wp = wg + (size_t)(256 * wave + 4 * kk) * 64 + i32;
        float bq[5][8];
        const float* wpm = wp;
#define RT_LOADB(slot_) do { _Pragma("unroll") for (int s = 0; s < 4; ++s) { bq[slot_][2 * s] = wpm[s * 64]; bq[slot_][2 * s + 1] = wpm[s * 64 + 32]; } wpm += 8 * 64; asm volatile("" : "+v"(wpm)); } while (0)
        RT_LOADB(0); RT_LOADB(1); RT_LOADB(2); RT_LOADB(3);
#pragma unroll
        for (int m = 0; m < 32; ++m) {
            if (m + 4 < 32) RT_LOADB((m + 4) % 5);
            __builtin_amdgcn_sched_barrier(0);
            ss += (x4[m].x * x4[m].x + x4[m].y * x4[m].y) + (x4[m].z * x4[m].z + x4[m].w * x4[m].w);
#pragma unroll
            for (int s = 0; s < 4; ++s) { acc0 = __builtin_amdgcn_mfma_f32_32x32x2f32(x4[m][s], bq[m % 5][2 * s], acc0, 0, 0, 0); acc1 = __builtin_amdgcn_mfma_f32_32x32x2f32(x4[m][s], bq[m % 5][2 * s + 1], acc1, 0, 0, 0); }
            __builtin_amdgcn_sched_barrier(0);
        }
#undef RT_LOADB
        ss += __shfl_xor(ss, 32);
        if (kk == 0) part[wave * 32 + i32] = ss;
#pragma unroll
        for (int rg = 0; rg < 16; ++rg) { const int row = crow(rg, kk); red[(wave * 32 + row) * 36 + i32] = acc0[rg]; if (i32 < 4) red[(wave * 32 + row) * 36 + 32 + i32] = acc1[rg]; }
        __syncthreads();
        for (int e_ = F.tid; e_ < 32 * 36; e_ += NTHR) { const int row = e_ / 36, col = e_ % 36; float a = 0.f;
#pragma unroll
            for (int w = 0; w < 8; ++w) a += red[(w * 32 + row) * 36 + col];
            fin[row * 37 + col] = a; }
        if (F.tid < 32) { float a = 0.f;
#pragma unroll
            for (int w = 0; w < 8; ++w) a += part[w * 32 + F.tid];
            rsd[F.tid] = 1.0f / sqrtf(a * (1.0f / D) + EPS); }
        __syncthreads();
        if (F.tid < 32) {
            const int m = t0 + F.tid; const float rstd = rsd[F.tid]; const LAS float* lg = fin + F.tid * 37;
            float gl[4];
#pragma unroll
            for (int q = 0; q < 4; ++q) gl[q] = lg[32 + q] * rstd + INP(I_MOE_BG)[l * 4 + q];
            int gi = 0; float gmax = gl[0];
#pragma unroll
            for (int q = 1; q < 4; ++q) if (gl[q] > gmax) { gmax = gl[q]; gi = q; }
            float gsum = 0.f;
#pragma unroll
            for (int q = 0; q < 4; ++q) gsum += expf(gl[q] - gmax);
            const float g_w = 1.0f / gsum;
            float el[8];
#pragma unroll
            for (int q = 0; q < 8; ++q) el[q] = lg[gi * 8 + q] * rstd + INP(I_MOE_BE)[l * 32 + gi * 8 + q];
            int i1 = 0; float v1 = el[0];
#pragma unroll
            for (int q = 1; q < 8; ++q) if (el[q] > v1) { v1 = el[q]; i1 = q; }
            int i2 = -1; float v2 = -3.0e38f;
#pragma unroll
            for (int q = 0; q < 8; ++q) if (q != i1 && el[q] > v2) { v2 = el[q]; i2 = q; }
            const float ex = expf(v2 - v1); const float w1 = g_w / (1.0f + ex), w2 = g_w * ex / (1.0f + ex);
            const int e1 = gi * 8 + i1, e2 = gi * 8 + i2;
            const unsigned s1 = __hip_atomic_fetch_add(cnt + e1, 1u, RLX_AGENT), s2 = __hip_atomic_fetch_add(cnt + e2, 1u, RLX_AGENT);
            int* rec = info + (size_t)m * 8; rec[0] = e1; rec[1] = e2; rec[2] = (int)s1; rec[3] = (int)s2; rec[4] = __builtin_bit_cast(int, w1); rec[5] = __builtin_bit_cast(int, w2);
            elist[(size_t)e1 * T + s1] = m; elist[(size_t)e2 * T + s2] = m;
        }
        { const float rstd = rsd[i32]; const float* gp = g + 256 * wave + 4 * kk; LAS unsigned char* stg = F.lds + 49152 + wave * 4608;
#pragma unroll
          for (int c = 0; c < 4; ++c) {
#pragma unroll
              for (int mm = 0; mm < 8; ++mm) { const int m = 8 * c + mm; const f32x4 gv = *(const f32x4*)(gp + 8 * m); const f32x4 o = x4[m] * rstd * gv;
                  *(LAS v2u*)(stg + i32 * 144 + mm * 16 + kk * 8) = (v2u){pk2(o.x, o.y), pk2(o.z, o.w)}; }
              LDS_WAIT();
#pragma unroll
              for (int q = 0; q < 4; ++q) { const int row = 8 * q + (lane >> 3), ch = lane & 7; const v4u v = *(const LAS v4u*)(stg + row * 144 + ch * 16);
                  *(v4u*)(xn + (size_t)(t0 + row) * D + 256 * wave + 64 * c + 8 * ch) = v; }
              LDS_WAIT(); } }
        __syncthreads();
    }
}
__device__ __forceinline__ int moe_bases(const unsigned* cnt, int lane, int& padded) {
    const int c = (lane < 32) ? (int)__hip_atomic_load(cnt + (lane & 31), RLX_AGENT) : 0;
    padded = (c + 255) & ~255;
    int incl = padded;
#pragma unroll
    for (int o = 1; o < 32; o <<= 1) { const int up = __shfl_up(incl, o); if (lane >= o) incl += up; }
    return incl - padded;
}
__device__ __forceinline__ int moe_tile_table(Frame& F, int l) {
    LAS int* tile_e = (LAS int*)(F.lds + TILE_E_OFF);
    const unsigned* cnt = (const unsigned*)(F.ctl + CW_CNT + l * 64);
    int padded; const int base = moe_bases(cnt, F.lane, padded);
    if (F.wave == 0 && F.lane < 32) { for (int ti = base >> 8; ti < ((base + padded) >> 8); ++ti) tile_e[ti] = F.lane;
        tile_e[320 + F.lane] = base >> 8; tile_e[352 + F.lane] = (int)__hip_atomic_load(cnt + F.lane, RLX_AGENT); }
    const int total = __builtin_amdgcn_readfirstlane(__shfl(base + padded, 31));
    __syncthreads();
    return total >> 8;
}
__device__ __forceinline__ void ph_combine(Frame& F, int l) {
    const int gw = F.bid * NWAVES + F.wave, NGW = F.G * NWAVES, lane = F.lane;
    const bf16* ob = (const bf16*)(F.ws + WS_P); const int* info = (const int*)(F.ws + WS_INFO);
    const bool last = (l == 1);
    const float* g = last ? INP(I_NORM_FINAL) : (INP(I_NORM_MIX) + D);
    bf16* xn = (bf16*)(F.ws + WS_XN);
    int padded_; const int base = moe_bases((const unsigned*)(F.ctl + CW_CNT + l * 64), lane, padded_);
    for (int m = gw; m < T; m += NGW) {
        const int* rec = info + (size_t)m * 8;
        const float w1 = __builtin_bit_cast(float, rec[4]), w2 = __builtin_bit_cast(float, rec[5]); const int p1 = __shfl(base, rec[0]) + rec[2], p2 = __shfl(base, rec[1]) + rec[3];
        float* xr = F.out + (size_t)m * D;
        f32x4 v[8]; float s = 0.f;
#pragma unroll
        for (int j = 0; j < 8; ++j) { v[j] = ((const f32x4*)xr)[lane + 64 * j];
            const v2u a = ((const v2u*)(ob + (size_t)p1 * D))[lane + 64 * j], c = ((const v2u*)(ob + (size_t)p2 * D))[lane + 64 * j];
            v[j].x += w1 * bflo(a.x) + w2 * bflo(c.x); v[j].y += w1 * bfhi(a.x) + w2 * bfhi(c.x); v[j].z += w1 * bflo(a.y) + w2 * bflo(c.y); v[j].w += w1 * bfhi(a.y) + w2 * bfhi(c.y);
            s += (v[j].x * v[j].x + v[j].y * v[j].y) + (v[j].z * v[j].z + v[j].w * v[j].w); }
        const float rstd = 1.0f / sqrtf(wave_sum(s) * (1.0f / D) + EPS);
#pragma unroll
        for (int j = 0; j < 8; ++j) { const f32x4 gv = ((const f32x4*)g)[lane + 64 * j];
            if (last) NTST((f32x4*)xr + lane + 64 * j, v[j] * rstd * gv);
            else { NTST((f32x4*)xr + lane + 64 * j, v[j]); const f32x4 o = v[j] * rstd * gv; v2u w; w.x = pk2(o.x, o.y); w.y = pk2(o.z, o.w); ((v2u*)(xn + (size_t)m * D))[lane + 64 * j] = w; } }
    }
}

constexpr int NPH = 11;
constexpr int N_PHASES = 1 + 2 * NPH;
struct Args { const float* in[N_INPUTS]; float* out; unsigned char* ws; int ph_lo, ph_hi, use_bar, pad; };

#define PH_BEGIN() do { \
        const CAS cfp* ip_ = (const CAS cfp*)__builtin_amdgcn_kernarg_segment_ptr(); asm volatile("" : "+s"(ip_)); F.in = ip_; \
        size_t zo_ = 0; asm volatile("" : "+s"(zo_));     \
        F.ws = args.ws + zo_; F.ctl = (gu32*)(args.ws + zo_); F.out = args.out + zo_; \
        int t_ = threadIdx.x; asm volatile("" : "+v"(t_)); F.tid = t_; F.lane = t_ & 63; F.wave = __builtin_amdgcn_readfirstlane(t_ >> 6); \
        int b_ = blockIdx.x; asm volatile("" : "+s"(b_)); F.bid = b_; int g_ = gridDim.x; asm volatile("" : "+s"(g_)); F.G = g_; \
    } while (0)
#ifndef PH_MASK
#define PH_MASK 0xFFFFFFFFu
#endif
#define IN(k) (lo <= (k) && (k) < hi)
#define INL(j) (IN(pb + (j)) && ((PH_MASK >> (1 + (j))) & 1u))
#define SEAM(k) do { if (IN(k) && IN((k) + 1)) { XcdBarrier b2_ = bar; asm volatile("" : "+s"(b2_.bar)); xcd_barrier(b2_); } } while (0)

__device__ __forceinline__ void run_layer(Frame& F, const Args& args, const XcdBarrier& bar, const int lo, const int hi, const int l) {
    const int pb = 1 + l * NPH;
    if (INL(0)) { PH_BEGIN();
        { pg8::Gemm g{(const bf16*)(F.ws + WS_XN), (const bf16*)(F.ws + WS_WIN + l * WIN_BYTES), T, DIN_FULL, D}; pg8::StaticOrder S; S.init(T, DIN_FULL, F.G, F.bid);
          pg8::EpiBf16L E{(bf16*)(F.ws + WS_P), DINP};
          pg8::gemm_phase<pg8::EpiBf16L, pg8::StaticOrder, true, true>(F.lds, g, S, E); }
        __syncthreads(); PH_BEGIN(); ph_in_rem(F, l);
    } SEAM(pb + 0);
    if (INL(1)) { PH_BEGIN(); ph_gdn_prep(F, l); } SEAM(pb + 1);
    if (INL(2)) {
        PH_BEGIN();
        const bool split = F.G > N_SCAN_WG;
        if (!split || F.bid < N_SCAN_WG) ph_gdn_scan(F);
        if (!split || F.bid >= N_SCAN_WG) {
            __syncthreads(); PH_BEGIN();
            if (split) { F.bid -= N_SCAN_WG; F.G -= N_SCAN_WG; }
            ph_hy_expand(F, l); ph_hy_tin(F, l); __syncthreads(); PH_BEGIN(); if (split) { F.bid -= N_SCAN_WG; F.G -= N_SCAN_WG; } ph_at_prep(F, l);
        }
    } SEAM(pb + 2);
    if (INL(3)) { PH_BEGIN(); ph_hy_fft(F, l); } SEAM(pb + 3);
    if (INL(4)) { PH_BEGIN(); ph_at_global(F, l); __syncthreads(); PH_BEGIN(); ph_at_swa(F, l); } SEAM(pb + 4);
    if (INL(5)) { PH_BEGIN(); ph_gdn_fin(F, l); ph_hy_fin(F, l); __syncthreads(); PH_BEGIN(); ph_at_fin(F, l); } SEAM(pb + 5);
    if (INL(6)) { PH_BEGIN();
        pg8::Gemm g{(const bf16*)(F.ws + WS_Y), (const bf16*)(F.ws + WS_WOUT + l * WOUT_BYTES), T, D, D}; pg8::StaticOrder S; S.init(T, D, F.G, F.bid);
        pg8::EpiResF32 E{(l == 0) ? INP(I_X) : (const float*)F.out, F.out, D};
        pg8::gemm_phase<pg8::EpiResF32, pg8::StaticOrder, true, true>(F.lds, g, S, E);
    } SEAM(pb + 6);
    if (INL(7)) { PH_BEGIN(); ph_moe_route(F, l); } SEAM(pb + 7);
    if (INL(8)) { PH_BEGIN();
        const int ntiles = moe_tile_table(F, l);
        pg8::Gemm g{(const bf16*)(F.ws + WS_XN), (const bf16*)(F.ws + WS_GUT), MOE_ROWS, 1024, D};
        const LAS int* tt = (const LAS int*)(F.lds + TILE_E_OFF);
        pg8::MoeGatherOrder<4, T, (unsigned)(D * 2)> S{tt, tt + 320, tt + 352, (const int*)(F.ws + WS_ELIST), ntiles, F.G, F.bid};
        pg8::EpiSwiGLU E{(bf16*)(F.ws + WS_MOE_H), DE};
        pg8::gemm_phase<pg8::EpiSwiGLU, pg8::MoeGatherOrder<4, T, (unsigned)(D * 2)>, true, true>(F.lds, g, S, E);
    } SEAM(pb + 8);
    if (INL(9)) { PH_BEGIN();
        const int ntiles = moe_tile_table(F, l);
        pg8::Gemm g{(const bf16*)(F.ws + WS_MOE_H), (const bf16*)(F.ws + WS_DT), MOE_ROWS, D, DE};
        pg8::MoeOrder<8> S{(const LAS int*)(F.lds + TILE_E_OFF), ntiles, F.G, F.bid};
        pg8::EpiBf16L E{(bf16*)(F.ws + WS_P), D};
        pg8::gemm_phase<pg8::EpiBf16L, pg8::MoeOrder<8>, false, true>(F.lds, g, S, E);
    } SEAM(pb + 9);
    if (INL(10)) { PH_BEGIN(); ph_combine(F, l); }
    if (l == 0) SEAM(pb + 10);
}

__global__ void __launch_bounds__(NTHR, 2) mk_fwd(Args args) {
    extern __shared__ __attribute__((aligned(16))) unsigned char lds[];
    Frame F;
    F.lds = (LAS unsigned char*)lds;
    F.MISC = (volatile LAS unsigned*)(F.lds + MISC_OFF);
    F.tid = threadIdx.x; F.lane = F.tid & 63; F.wave = __builtin_amdgcn_readfirstlane(F.tid >> 6);
    F.G = gridDim.x; F.bid = blockIdx.x;
    PH_BEGIN();
    for (int u = F.tid; u < (LDS_BYTES - MISC_OFF) / 4; u += NTHR) ((LAS unsigned*)(F.lds + MISC_OFF))[u] = 0u;
    __syncthreads();
    XcdBarrier bar; bar.bar = (unsigned*)(F.ctl + CW_BAR); bar.x = 0; bar.st = nullptr;
    if (args.use_bar) bar = xcd_barrier_post((unsigned*)(F.ctl + CW_BAR), F.MISC + 8);
    const int lo = args.ph_lo, hi = args.ph_hi;

    if (IN(0) && (PH_MASK & 1u)) { PH_BEGIN(); ph_prologue(F);
#pragma nounroll
        for (int l2 = 0; l2 < 2; ++l2) { asm volatile("" : "+s"(l2)); __syncthreads(); PH_BEGIN(); ph_hy_mlp(F, l2); } }
    SEAM(0);

#pragma nounroll
    for (int l = 0; l < 2; ++l) { asm volatile("" : "+s"(l)); run_layer(F, args, bar, lo, hi, l); }
}
#undef IN
#undef INL
#undef SEAM

#ifndef MK_ONE_LAUNCH
#define MK_ONE_LAUNCH 1
#endif
extern "C" void kernel_launch(void* const* d_in, const int* in_sizes, int n_in, void* d_out, int out_size, void* d_ws, size_t ws_size, hipStream_t stream) {
    static int grid = 0;
    if (grid == 0) {
        if (n_in != N_INPUTS || out_size != T * D || ws_size < WS_END) { fprintf(stderr, "kernel_launch: unexpected shapes (n_in %d out %d ws %zu)\n", n_in, out_size, ws_size); grid = -1; return; }
        if (hipFuncSetAttribute((const void*)mk_fwd, hipFuncAttributeMaxDynamicSharedMemorySize, LDS_BYTES) != hipSuccess) { fprintf(stderr, "kernel_launch: hipFuncSetAttribute failed\n"); grid = -1; return; }
        int dev = 0, cus = 0, per_cu = 0;
        hipGetDevice(&dev); hipDeviceGetAttribute(&cus, hipDeviceAttributeMultiprocessorCount, dev);
        hipOccupancyMaxActiveBlocksPerMultiprocessor(&per_cu, (const void*)mk_fwd, NTHR, LDS_BYTES);
        (void)hipGetLastError();
        grid = (cus >= 256) ? 256 : cus;
        if (per_cu < 1) fprintf(stderr, "kernel_launch: occupancy query reports %d\n", per_cu);
    }
    if (grid < 0) return;
    hipMemsetAsync((char*)d_ws + WS_CTL, 0, CTL_ZERO_BYTES, stream);
    Args a{};
    for (int i = 0; i < N_INPUTS; ++i) a.in[i] = (const float*)d_in[i];
    a.out = (float*)d_out; a.ws = (unsigned char*)d_ws; a.pad = 0;
#if MK_ONE_LAUNCH
    a.ph_lo = 0; a.ph_hi = N_PHASES; a.use_bar = 1;
    hipLaunchKernelGGL(mk_fwd, dim3(grid), dim3(NTHR), LDS_BYTES, stream, a);
#else
    for (int p = 0; p < N_PHASES; ++p) { a.ph_lo = p; a.ph_hi = p + 1; a.use_bar = 0; hipLaunchKernelGGL(mk_fwd, dim3(grid), dim3(NTHR), LDS_BYTES, stream, a); }
#endif
}
```

```cpp
#include <hip/hip_runtime.h>
#include <cstdio>
#include <cstdint>
#include <cmath>
namespace pg8 {
#define PG8_LAS __attribute__((address_space(3)))
typedef unsigned short bf16_t;
typedef short bf16x8 __attribute__((ext_vector_type(8)));
typedef float f32x4 __attribute__((ext_vector_type(4)));
typedef unsigned u32x4 __attribute__((ext_vector_type(4)));
constexpr int BM = 256, BK = 64, HALF = 128, HTB = HALF * BK * 2  , STAGE_BYTES = 8 * HTB, NXCD = 8, WGM = 8;

__host__ __device__ __forceinline__ int lds_byte(int r, int c) { const int st = (r >> 4) * 2 + (c >> 5), rr = r & 15, cc = c & 31, ob = rr * 64 + cc * 2; return st * 1024 + (ob ^ (((ob >> 9) & 1) << 5)); }
__host__ __device__ __forceinline__ void stage_rc(int b, int& R, int& C) { const int st = b / 1024, sb = b % 1024, swz = sb ^ (((sb >> 9) & 1) << 5); R = (st >> 1) * 16 + swz / 64; C = (st & 1) * 32 + (swz % 64) / 2; }
__host__ __device__ __forceinline__ int perm32(int rho) { const int n = rho >> 4, i = rho & 15; return 8 * (i >> 2) + 4 * n + (i & 3); }

struct Unit { int pm, pn, pb; };
struct Gemm { const bf16_t* A; const bf16_t* Bt; int M, N, K; };

struct StaticOrder {
    int nM, nN, nwg, G, c;
    __host__ __device__ void init(int M, int N, int G_, int c_) { nM = M / BM; nN = N / BM; nwg = nM * nN; G = G_; c = c_; }
    __host__ __device__ bool next(int i, Unit& u) const {
        const long L = (long)i * G + c; if (L >= nwg) return false;
        int wgid = (int)L; { const int q = nwg / NXCD, r = nwg % NXCD, xcd = wgid % NXCD, off = wgid / NXCD; wgid = (xcd < r ? xcd * (q + 1) : r * (q + 1) + (xcd - r) * q) + off; }
        const int nig = WGM * nN, gid = wgid / nig, fm = gid * WGM, gsz = (nM - fm) < WGM ? (nM - fm) : WGM;
        u.pm = fm + ((wgid % nig) % gsz); u.pn = (wgid % nig) / gsz; u.pb = u.pn; return true;
    }
    __device__ __forceinline__ void a_ready(const Unit&) const {}
    __device__ __forceinline__ void done(const Unit&) const {}
    static constexpr bool GATHER = false;
    __device__ __forceinline__ unsigned arow(const Unit&, int) const { return 0u; }
};

__device__ __forceinline__ unsigned cvt_pk_bf16(float lo, float hi) { unsigned r; asm volatile("v_cvt_pk_bf16_f32 %0, %1, %2" : "=v"(r) : "v"(lo), "v"(hi)); return r; }
typedef float f32x2 __attribute__((ext_vector_type(2)));
__device__ __forceinline__ f32x2 gelu_pk(f32x2 v) {
    const f32x2 av = __builtin_elementwise_abs(v), d = av * 0.2316418882f + 1.0f;
    f32x2 t; t.x = __builtin_amdgcn_rcpf(d.x); t.y = __builtin_amdgcn_rcpf(d.y);
    f32x2 q = t * 0.5307027145f + (-0.7265760135f); q = q * t + 0.7107068705f; q = q * t + (-0.142248368f); q = q * t + 0.127414796f; q = q * t;
    const f32x2 s = (v * v) * (-0.72134752044f);
    f32x2 e; e.x = __builtin_amdgcn_exp2f(s.x); e.y = __builtin_amdgcn_exp2f(s.y);
    const f32x2 m = v * (q * e), r = v - m;
    f32x2 o; o.x = v.x < 0.f ? m.x : r.x; o.y = v.y < 0.f ? m.y : r.y; return o;
}

template <int ACT  > struct EpiBf16 {
    static constexpr bool PERM = true, PERM64 = false, AFTER_DRAIN = false; static_assert(ACT == 0 || ACT == 1, "EpiBf16: ACT is 0 (none) or 1 (gelu_pk)");
    bf16_t* O; int ldc; const float* bias; int split_cols; size_t split_stride; float scale0;
    __device__ __forceinline__ void operator()(const f32x4 (&acc)[2][2][4][2], const Unit& u, int wr, int wc, int fr, int fq) const {
        const int row0 = u.pm * BM + wr * 64 + fr; int colt = u.pn * BM; bf16_t* base = O;
        float sc = 1.f; if (split_cols) { const int t = colt / split_cols; base += (size_t)t * split_stride; colt -= t * split_cols; if (t == 0) sc = scale0; }
        const int col0 = colt + wc * 32 + 8 * fq, bcol0 = u.pn * BM + wc * 32 + 8 * fq;
        f32x4 bv[2][2];
#pragma unroll
        for (int bj = 0; bj < 2; ++bj)
#pragma unroll
            for (int n = 0; n < 2; ++n) bv[bj][n] = bias ? *(const f32x4*)(bias + bcol0 + bj * HALF + 4 * n) : (f32x4){0.f, 0.f, 0.f, 0.f};
#pragma unroll
        for (int ai = 0; ai < 2; ++ai)
#pragma unroll
            for (int m = 0; m < 4; ++m) { bf16_t* rowp = base + (size_t)(row0 + ai * HALF + m * 16) * ldc + col0;
#pragma unroll
                for (int bj = 0; bj < 2; ++bj) { f32x4 v0 = acc[ai][bj][m][0] + bv[bj][0], v1 = acc[ai][bj][m][1] + bv[bj][1];
                    if (ACT == 1) { f32x2 a = gelu_pk((f32x2){v0[0], v0[1]}), b = gelu_pk((f32x2){v0[2], v0[3]}), c = gelu_pk((f32x2){v1[0], v1[1]}), d = gelu_pk((f32x2){v1[2], v1[3]});
                        v0 = (f32x4){a.x, a.y, b.x, b.y}; v1 = (f32x4){c.x, c.y, d.x, d.y}; }
                    v0 = v0 * sc; v1 = v1 * sc; u32x4 w; w.x = cvt_pk_bf16(v0[0], v0[1]); w.y = cvt_pk_bf16(v0[2], v0[3]); w.z = cvt_pk_bf16(v1[0], v1[1]); w.w = cvt_pk_bf16(v1[2], v1[3]);
                    *(u32x4*)(rowp + bj * HALF) = w; } }
    }
};

#ifndef EPI_NT
#define EPI_NT 1
#endif
#if EPI_NT
#define EPI_ST(v, p) __builtin_nontemporal_store((v), (p))
#else
#define EPI_ST(v, p) (*(p) = (v))
#endif
__device__ __forceinline__ unsigned dpp_ror8(unsigned x) { return (unsigned)__builtin_amdgcn_update_dpp(0, (int)x, 0x128, 0xf, 0xf, false); }
__device__ __forceinline__ unsigned bperm(int a, unsigned x) { return (unsigned)__builtin_amdgcn_ds_bpermute(a, (int)x); }
__device__ __forceinline__ f32x4 dpp_ror8_v4(f32x4 v) { const u32x4 u = __builtin_bit_cast(u32x4, v); u32x4 r; r.x = dpp_ror8(u.x); r.y = dpp_ror8(u.y); r.z = dpp_ror8(u.z); r.w = dpp_ror8(u.w); return __builtin_bit_cast(f32x4, r); }
__device__ __forceinline__ f32x4 bperm_v4(int a, f32x4 v) { const u32x4 u = __builtin_bit_cast(u32x4, v); u32x4 r; r.x = bperm(a, u.x); r.y = bperm(a, u.y); r.z = bperm(a, u.z); r.w = bperm(a, u.w); return __builtin_bit_cast(f32x4, r); }
struct EpiResF32 {
    static constexpr bool PERM = false, PERM64 = false, AFTER_DRAIN = false;
    const float* base; float* out; int ldc;
    __device__ __forceinline__ void operator()(const f32x4 (&acc)[2][2][4][2], const Unit& u, int wr, int wc, int fr, int fq) const {
        const int hi8 = fr >> 3, l = fq * 16 + fr, dr = l >> 3, dc = l & 7;
        const int srcA = (((dc & 3) * 16 + (dc >> 2) * 8 + dr) << 2), srcB = (((dc & 3) * 16 + ((dc >> 2) ^ 1) * 8 + dr) << 2);
        const size_t offa = (size_t)(u.pm * BM + wr * 64 + dr) * ldc + u.pn * BM + wc * 32 + dc * 4, offb = offa + (size_t)8 * ldc;
#pragma unroll
        for (int ai = 0; ai < 2; ++ai)
#pragma unroll
            for (int m = 0; m < 4; ++m)
#pragma unroll
                for (int bj = 0; bj < 2; ++bj) { const size_t ro = (size_t)(ai * HALF + m * 16) * ldc + bj * HALF;
                    const f32x4 ba = *(const f32x4*)(base + offa + ro), bb = *(const f32x4*)(base + offb + ro);
                    const f32x4 w0 = acc[ai][bj][m][0], t = dpp_ror8_v4(acc[ai][bj][m][1]);
                    const f32x4 sa = hi8 ? t : w0, sb = hi8 ? w0 : t;
                    EPI_ST(bperm_v4(srcA, sa) + ba, (f32x4*)(out + offa + ro)); EPI_ST(bperm_v4(srcB, sb) + bb, (f32x4*)(out + offb + ro)); }
    }
};
struct EpiBf16L {
    static constexpr bool PERM = true, PERM64 = true, AFTER_DRAIN = false;
    bf16_t* O; int ldc;
    __device__ __forceinline__ void operator()(const f32x4 (&acc)[2][2][4][2], const Unit& u, int wr, int wc, int fr, int fq) const {
        const int hi8 = fr >> 3, l = fq * 16 + fr, dr = l >> 3, dc = l & 7;
        const int srcA = (((dc & 3) * 16 + (dc >> 2) * 8 + dr) << 2), srcB = (((dc & 3) * 16 + ((dc >> 2) ^ 1) * 8 + dr) << 2);
        bf16_t* pa = O + (size_t)(u.pm * BM + wr * 64 + dr) * ldc + u.pn * BM + wc * 64 + dc * 8;
        bf16_t* pb = pa + (size_t)8 * ldc;
#pragma unroll
        for (int ai = 0; ai < 2; ++ai)
#pragma unroll
            for (int m = 0; m < 4; ++m) { const size_t ro = (size_t)(ai * HALF + m * 16) * ldc;
                u32x4 w0, w1, t;
                w0.x = cvt_pk_bf16(acc[ai][0][m][0][0], acc[ai][0][m][0][1]); w0.y = cvt_pk_bf16(acc[ai][0][m][0][2], acc[ai][0][m][0][3]); w0.z = cvt_pk_bf16(acc[ai][0][m][1][0], acc[ai][0][m][1][1]); w0.w = cvt_pk_bf16(acc[ai][0][m][1][2], acc[ai][0][m][1][3]);
                w1.x = cvt_pk_bf16(acc[ai][1][m][0][0], acc[ai][1][m][0][1]); w1.y = cvt_pk_bf16(acc[ai][1][m][0][2], acc[ai][1][m][0][3]); w1.z = cvt_pk_bf16(acc[ai][1][m][1][0], acc[ai][1][m][1][1]); w1.w = cvt_pk_bf16(acc[ai][1][m][1][2], acc[ai][1][m][1][3]);
                t.x = dpp_ror8(w1.x); t.y = dpp_ror8(w1.y); t.z = dpp_ror8(w1.z); t.w = dpp_ror8(w1.w);
                const u32x4 sa = hi8 ? t : w0, sb = hi8 ? w0 : t;
                u32x4 oa, ob;
                oa.x = bperm(srcA, sa.x); oa.y = bperm(srcA, sa.y); oa.z = bperm(srcA, sa.z); oa.w = bperm(srcA, sa.w);
                ob.x = bperm(srcB, sb.x); ob.y = bperm(srcB, sb.y); ob.z = bperm(srcB, sb.z); ob.w = bperm(srcB, sb.w);
                EPI_ST(oa, (u32x4*)(pa + ro)); EPI_ST(ob, (u32x4*)(pb + ro)); }
    }
};
struct EpiSwiGLU {
    static constexpr bool PERM = true, PERM64 = false, AFTER_DRAIN = false;
    bf16_t* H; int ldh;
    __device__ __forceinline__ void operator()(const f32x4 (&acc)[2][2][4][2], const Unit& u, int wr, int wc, int fr, int fq) const {
        const int l = fq * 16 + fr, dr = l >> 2, dc = l & 3, src = (dc * 16 + dr) << 2;
        const int row0 = u.pm * BM + wr * 64 + dr, col0 = u.pn * HALF + wc * 32 + 8 * dc;
#pragma unroll
        for (int ai = 0; ai < 2; ++ai)
#pragma unroll
            for (int m = 0; m < 4; ++m) { bf16_t* rowp = H + (size_t)(row0 + ai * HALF + m * 16) * ldh + col0;
                float r[8];
#pragma unroll
                for (int n = 0; n < 2; ++n)
#pragma unroll
                    for (int i = 0; i < 4; ++i) { const float g = acc[ai][0][m][n][i], up = acc[ai][1][m][n][i]; r[n * 4 + i] = g / (1.0f + __expf(-g)) * up; }
                u32x4 w; w.x = cvt_pk_bf16(r[0], r[1]); w.y = cvt_pk_bf16(r[2], r[3]); w.z = cvt_pk_bf16(r[4], r[5]); w.w = cvt_pk_bf16(r[6], r[7]);
                u32x4 o; o.x = bperm(src, w.x); o.y = bperm(src, w.y); o.z = bperm(src, w.z); o.w = bperm(src, w.w);
                EPI_ST(o, (u32x4*)rowp); }
    }
};
#ifndef MOE_XCD_ORDER
#define MOE_XCD_ORDER 1
#endif
template <int NPN> struct MoeOrder {
    const PG8_LAS int* tile_e; int ntiles, G, c;
    __device__ __forceinline__ bool next(int i, Unit& u) const {
        if (MOE_XCD_ORDER && (G & 7) == 0) {
            const int x = c & 7, j = c >> 3, w = G >> 3;
            const int tb = ntiles >> 3, ex = ntiles & 7, cntx = tb + (x < ex ? 1 : 0), start = x * tb + (x < ex ? x : ex);
            const int q = i * w + j, tl = q / NPN; if (tl >= cntx) return false;
            u.pm = start + tl; u.pn = q % NPN;
        } else { const int L = i * G + c; if (L >= ntiles * NPN) return false; u.pm = L / NPN; u.pn = L % NPN; }
        u.pb = __builtin_amdgcn_readfirstlane(tile_e[u.pm]) * NPN + u.pn; return true;
    }
    __device__ __forceinline__ void a_ready(const Unit&) const {}
    __device__ __forceinline__ void done(const Unit&) const {}
    static constexpr bool GATHER = false;
    __device__ __forceinline__ unsigned arow(const Unit&, int) const { return 0u; }
};
template <int NPN, int LT, unsigned ROWBYTES> struct MoeGatherOrder {
    const PG8_LAS int* tile_e; const PG8_LAS int* tile0; const PG8_LAS int* cnt; const int* list; int ntiles, G, c;
    __device__ __forceinline__ bool next(int i, Unit& u) const {
        if (MOE_XCD_ORDER && (G & 7) == 0) {
            const int x = c & 7, j = c >> 3, w = G >> 3;
            const int tb = ntiles >> 3, ex = ntiles & 7, cntx = tb + (x < ex ? 1 : 0), start = x * tb + (x < ex ? x : ex);
            const int q = i * w + j, tl = q / NPN; if (tl >= cntx) return false;
            u.pm = start + tl; u.pn = q % NPN;
        } else { const int L = i * G + c; if (L >= ntiles * NPN) return false; u.pm = L / NPN; u.pn = L % NPN; }
        u.pb = __builtin_amdgcn_readfirstlane(tile_e[u.pm]) * NPN + u.pn; return true;
    }
    __device__ __forceinline__ void a_ready(const Unit&) const {}
    __device__ __forceinline__ void done(const Unit&) const {}
    static constexpr bool GATHER = true;
    __device__ __forceinline__ unsigned arow(const Unit& u, int r) const {
        const int e = __builtin_amdgcn_readfirstlane(tile_e[u.pm]); const int rr = (u.pm - __builtin_amdgcn_readfirstlane(tile0[e])) * 256 + r;
        const int tok = (rr < __builtin_amdgcn_readfirstlane(cnt[e])) ? list[(size_t)e * LT + rr] : 0;
        return (unsigned)tok * ROWBYTES;
    }
};
template <class Epi, class Sched, bool ALIGN_EPI = false, bool SP2 = false, bool THIN = false>
__device__ __forceinline__ void gemm_phase(PG8_LAS unsigned char* lds, const Gemm g, const Sched& S, const Epi& E) {
    int tid_ = threadIdx.x; asm volatile("" : "+v"(tid_));
    const int tid = tid_, wid = __builtin_amdgcn_readfirstlane(tid >> 6), lane = tid & 63, wr = wid >> 2, wc = wid & 3, fr = lane & 15, fq = lane >> 4;
    const int K = g.K, nt = K / BK;
    unsigned voffA[2], voffB[2]; int rowA[2]; unsigned colA2[2];
#pragma unroll
    for (int i = 0; i < 2; ++i) { int R, C; stage_rc(tid * 16 + i * 8192, R, C); const int Rb = Epi::PERM64 ? (64 * (R >> 5) + perm32(R & 31)) : Epi::PERM ? ((R & ~31) + perm32(R & 31)) : R;
        voffA[i] = (unsigned)(R * K + C) * 2u; voffB[i] = (unsigned)(Rb * K + C) * 2u; rowA[i] = R; colA2[i] = (unsigned)C * 2u; }
    unsigned cOff[2][2], nOff[2][2];
#define PG8_AOFFS(dst, u_) do { _Pragma("unroll") for (int h_ = 0; h_ < 2; ++h_) _Pragma("unroll") for (int i_ = 0; i_ < 2; ++i_) dst[h_][i_] = S.arow(u_, h_ * HALF + rowA[i_]) + colA2[i_]; } while (0)
    const size_t kstep = (size_t)(BK * 2);
    const size_t hstep = (size_t)HALF * K * 2;
    const size_t hstepB = Epi::PERM64 ? (size_t)32 * K * 2 : hstep;
    const size_t tstep = 2 * hstep;
    const unsigned ldsw = (unsigned)wid * 1024u;
    const int aoff = lds_byte(wr * 64 + fr, fq * 8), boff = lds_byte(wc * 32 + fr, fq * 8);
#define PG8_SA(b, h) (((b) * 2 + (h)) * HTB)
#define PG8_SB(b, h) ((4 + (b) * 2 + (h)) * HTB)
#define PG8_STAGE(bufoff, gbase, voff) do { _Pragma("unroll") for (int _i = 0; _i < 2; ++_i) \
        __builtin_amdgcn_global_load_lds((const unsigned*)((const char*)(gbase) + (voff)[_i]), (PG8_LAS unsigned*)(lds + (bufoff) + ldsw + _i * 8192), 16, 0, 0); } while (0)
#define PG8_LDA(dst, b, h) do { _Pragma("unroll") for (int m = 0; m < 4; ++m) _Pragma("unroll") for (int k = 0; k < 2; ++k) dst[m][k] = *(const PG8_LAS bf16x8*)(lds + PG8_SA(b, h) + aoff + m * 2048 + k * 1024); } while (0)
#define PG8_LDB(dst, b, h) do { _Pragma("unroll") for (int n = 0; n < 2; ++n) _Pragma("unroll") for (int k = 0; k < 2; ++k) dst[n][k] = *(const PG8_LAS bf16x8*)(lds + PG8_SB(b, h) + boff + n * 2048 + k * 1024); } while (0)
#define PG8_MMA(ai, bj, At, Bt) do { __builtin_amdgcn_s_setprio(1); _Pragma("unroll") for (int m = 0; m < 4; ++m) _Pragma("unroll") for (int n = 0; n < 2; ++n) _Pragma("unroll") for (int k = 0; k < 2; ++k) \
        acc[ai][bj][m][n] = __builtin_amdgcn_mfma_f32_16x16x32_bf16(Bt[n][k], At[m][k], acc[ai][bj][m][n], 0, 0, 0); __builtin_amdgcn_s_setprio(0); } while (0)
#define PG8_MMA2(ai) do { if constexpr (THIN) { if (wc == 0) PG8_MMA(ai, 0, At, B0); } else { PG8_MMA(ai, 0, At, B0); PG8_MMA(ai, 1, At, B1); } } while (0)
#define PG8_VC(h) (GA ? cOff[h] : voffA)
#define PG8_VN(h) (GA ? vN[h] : voffA)
#define PG8_WAIT_V(n) asm volatile("s_waitcnt vmcnt(" #n ")" ::: "memory")
#define PG8_WAIT_L(n) asm volatile("s_waitcnt lgkmcnt(" #n ")" ::: "memory")
#define PG8_BAR __builtin_amdgcn_s_barrier()
#define PG8_SCHED __builtin_amdgcn_sched_barrier(0)
    Unit cur, nxt; int ui = 0;
    if (!S.next(0, cur)) return;
    f32x4 acc[2][2][4][2];
#pragma unroll
    for (int a = 0; a < 2; ++a)
#pragma unroll
        for (int b = 0; b < 2; ++b)
#pragma unroll
            for (int m = 0; m < 4; ++m)
#pragma unroll
                for (int n = 0; n < 2; ++n) acc[a][b][m][n] = (f32x4){0.f, 0.f, 0.f, 0.f};
    bf16x8 At[4][2], B0[2][2], B1[2][2];
    constexpr bool GA = Sched::GATHER;
    const size_t hstepA = GA ? (size_t)0 : hstep;
    const char* cA = (const char*)g.A + (GA ? (size_t)0 : (size_t)cur.pm * tstep); const char* cB = (const char*)g.Bt + (size_t)cur.pb * tstep;
    if constexpr (GA) PG8_AOFFS(cOff, cur);
    S.a_ready(cur);
    if constexpr (SP2) {
        PG8_STAGE(PG8_SB(0, 0), cB, voffB); PG8_STAGE(PG8_SB(0, 1), cB + hstepB, voffB); PG8_STAGE(PG8_SA(0, 0), cA, PG8_VC(0)); PG8_STAGE(PG8_SA(0, 1), cA + hstepA, PG8_VC(1));
        if (wr == 1) PG8_BAR;
        PG8_WAIT_V(2); PG8_BAR;
        PG8_STAGE(PG8_SB(1, 0), cB + kstep, voffB); PG8_STAGE(PG8_SA(1, 0), cA + kstep, PG8_VC(0)); PG8_STAGE(PG8_SB(1, 1), cB + hstepB + kstep, voffB);
        PG8_WAIT_V(6); PG8_BAR;
    } else {
        PG8_STAGE(PG8_SB(0, 0), cB, voffB); PG8_STAGE(PG8_SA(0, 0), cA, PG8_VC(0)); PG8_STAGE(PG8_SB(0, 1), cB + hstepB, voffB); PG8_STAGE(PG8_SA(0, 1), cA + hstepA, PG8_VC(1));
        if (wr == 1) PG8_BAR;
        PG8_WAIT_V(4); PG8_BAR;
        PG8_STAGE(PG8_SB(1, 0), cB + kstep, voffB); PG8_STAGE(PG8_SA(1, 0), cA + kstep, PG8_VC(0)); PG8_STAGE(PG8_SB(1, 1), cB + hstepB + kstep, voffB);
        PG8_WAIT_V(6); PG8_BAR;
    }
    for (;;) {
        const bool has_next = S.next(ui + 1, nxt);
        if constexpr (GA) { if (has_next) PG8_AOFFS(nOff, nxt); else { _Pragma("unroll") for (int h_ = 0; h_ < 2; ++h_) _Pragma("unroll") for (int i_ = 0; i_ < 2; ++i_) nOff[h_][i_] = cOff[h_][i_]; } }
        const char* nA = (has_next && !GA) ? (const char*)g.A + (size_t)nxt.pm * tstep : cA; const char* nB = has_next ? (const char*)g.Bt + (size_t)nxt.pb * tstep : cB;
        for (int t = 0; t < nt; t += 2) {
            const bool last = (t == nt - 2);
            const char* a1 = cA + (size_t)(t + 1) * kstep;
            const char* a2 = last ? nA : cA + (size_t)(t + 2) * kstep; const char* b2 = last ? nB : cB + (size_t)(t + 2) * kstep;
            const char* a3 = a2 + kstep; const char* b3 = b2 + kstep;
            unsigned vN[2][2];
            if constexpr (GA) { _Pragma("unroll") for (int h_ = 0; h_ < 2; ++h_) _Pragma("unroll") for (int i_ = 0; i_ < 2; ++i_) vN[h_][i_] = last ? nOff[h_][i_] : cOff[h_][i_]; }
            if (last && has_next) S.a_ready(nxt);
            if constexpr (SP2) {
            PG8_LDB(B0, 0, 0); PG8_LDB(B1, 0, 1); PG8_SCHED; PG8_LDA(At, 0, 0); PG8_STAGE(PG8_SA(1, 1), a1 + hstepA, PG8_VC(1));
            PG8_WAIT_V(8); PG8_WAIT_L(0); PG8_BAR; PG8_MMA2(0); PG8_BAR; PG8_SCHED;
            PG8_LDA(At, 0, 1); PG8_STAGE(PG8_SB(0, 0), b2, voffB); PG8_STAGE(PG8_SB(0, 1), b2 + hstepB, voffB); PG8_STAGE(PG8_SA(0, 0), a2, PG8_VN(0));
            PG8_WAIT_V(8); PG8_WAIT_L(0); PG8_BAR; PG8_MMA2(1); PG8_BAR; PG8_SCHED;
            PG8_LDB(B0, 1, 0); PG8_LDB(B1, 1, 1); PG8_SCHED; PG8_LDA(At, 1, 0); PG8_STAGE(PG8_SA(0, 1), a2 + hstepA, PG8_VN(1));
            PG8_WAIT_V(8); PG8_WAIT_L(0); PG8_BAR; PG8_MMA2(0); PG8_BAR; PG8_SCHED;
            PG8_LDA(At, 1, 1); PG8_STAGE(PG8_SB(1, 0), b3, voffB); PG8_STAGE(PG8_SB(1, 1), b3 + hstepB, voffB); PG8_STAGE(PG8_SA(1, 0), a3, PG8_VN(0));
            PG8_WAIT_V(8); PG8_WAIT_L(0); PG8_BAR; PG8_MMA2(1); PG8_BAR; PG8_SCHED;
            } else {
            PG8_LDB(B0, 0, 0); PG8_SCHED; PG8_LDA(At, 0, 0); PG8_STAGE(PG8_SA(1, 1), a1 + hstepA, PG8_VC(1));
            PG8_WAIT_L(8); PG8_BAR; PG8_WAIT_L(0); PG8_MMA(0, 0, At, B0); PG8_BAR; PG8_SCHED;
            PG8_LDB(B1, 0, 1); PG8_STAGE(PG8_SB(0, 0), b2, voffB);
            PG8_BAR; PG8_WAIT_L(0); PG8_MMA(0, 1, At, B1); PG8_BAR;
            PG8_LDA(At, 0, 1); PG8_STAGE(PG8_SA(0, 0), a2, PG8_VN(0));
            PG8_BAR; PG8_WAIT_L(0); PG8_MMA(1, 0, At, B0); PG8_BAR; PG8_SCHED;
            PG8_STAGE(PG8_SB(0, 1), b2 + hstepB, voffB);
            PG8_WAIT_V(6); PG8_BAR; PG8_MMA(1, 1, At, B1); PG8_BAR;
            PG8_LDB(B0, 1, 0); PG8_SCHED; PG8_LDA(At, 1, 0); PG8_STAGE(PG8_SA(0, 1), a2 + hstepA, PG8_VN(1));
            PG8_WAIT_L(8); PG8_BAR; PG8_WAIT_L(0); PG8_MMA(0, 0, At, B0); PG8_BAR; PG8_SCHED;
            PG8_LDB(B1, 1, 1); PG8_STAGE(PG8_SB(1, 0), b3, voffB);
            PG8_BAR; PG8_WAIT_L(0); PG8_MMA(0, 1, At, B1); PG8_BAR;
            PG8_LDA(At, 1, 1); PG8_STAGE(PG8_SA(1, 0), a3, PG8_VN(0));
            PG8_BAR; PG8_WAIT_L(0); PG8_MMA(1, 0, At, B0); PG8_BAR; PG8_SCHED;
            PG8_STAGE(PG8_SB(1, 1), b3 + hstepB, voffB);
            PG8_WAIT_V(6); PG8_BAR; PG8_MMA(1, 1, At, B1); PG8_BAR;
            }
        }
        if constexpr (ALIGN_EPI) { if (wr == 0) PG8_BAR; }
        if constexpr (!Epi::AFTER_DRAIN) { E(acc, cur, wr, wc, fr, fq); S.done(cur); }
        if (!has_next) break;
#pragma unroll
        for (int a = 0; a < 2; ++a)
#pragma unroll
            for (int b = 0; b < 2; ++b)
#pragma unroll
                for (int m = 0; m < 4; ++m)
#pragma unroll
                    for (int n = 0; n < 2; ++n) acc[a][b][m][n] = (f32x4){0.f, 0.f, 0.f, 0.f};
        cur = nxt; cA = nA; cB = nB; ++ui;
        if constexpr (GA) { _Pragma("unroll") for (int h_ = 0; h_ < 2; ++h_) _Pragma("unroll") for (int i_ = 0; i_ < 2; ++i_) cOff[h_][i_] = nOff[h_][i_]; }
        if constexpr (ALIGN_EPI) { if (wr == 1) PG8_BAR; }
    }
    PG8_WAIT_V(0);
    if constexpr (!ALIGN_EPI) { if (wr == 0) PG8_BAR; }
    PG8_BAR;
    if constexpr (Epi::AFTER_DRAIN) { E.fused(acc, cur, wr, wc, fr, fq, lds, wid, lane); S.done(cur); }
#undef PG8_SA
#undef PG8_SB
#undef PG8_STAGE
#undef PG8_LDA
#undef PG8_LDB
#undef PG8_MMA
#undef PG8_MMA2
#undef PG8_VC
#undef PG8_VN
#undef PG8_AOFFS
#undef PG8_WAIT_V
#undef PG8_WAIT_L
#undef PG8_BAR
#undef PG8_SCHED
}
}
#include <hip/hip_bf16.h>
namespace attn_body {
using bf16=__hip_bfloat16;
using bf16x8=__attribute__((ext_vector_type(8)))short;
using s16x4=__attribute__((ext_vector_type(4)))short;
using f32x16=__attribute__((ext_vector_type(16)))float;
using u32x4=__attribute__((ext_vector_type(4)))unsigned;
constexpr int D=64;
constexpr int NW=8,QBLK=32,QB=QBLK*NW,KVBLK=64;
constexpr int ATTN_UNIT_ROWS=QB;
__device__ __forceinline__ int crow(int r,int hi){return (r&3)+8*(r>>2)+4*hi;}
#define SBAR() __builtin_amdgcn_sched_barrier(0)
__device__ __forceinline__ void cmask(f32x16&p0,f32x16&p1,int jb,int qrel,int hi){
  const float NEG=-INFINITY; int kb=64*jb+4*hi;
  #pragma unroll
  for(int r=0;r<16;++r){int kv=kb+(r&3)+8*(r>>2); if(kv>qrel)p0[r]=NEG; if(kv+32>qrel)p1[r]=NEG;}
}

constexpr int NSLOT=3, SLOTB=8192;
constexpr int LDS_K=0, LDS_V=NSLOT*SLOTB, LDS_WS=2*NSLOT*SLOTB, LDS_OST=LDS_WS+NW*64*4, LDS_BYTES=LDS_OST+NW*4096;
constexpr float C2=0.125f*1.4426950408889634f;
__device__ __forceinline__ void glds16(const void*gsrc,unsigned lds_dst){unsigned keep;
  asm volatile("s_mov_b32 %0, m0\n\ts_mov_b32 m0, %2\n\ts_nop 0\n\tglobal_load_lds_dwordx4 %1, off\n\ts_mov_b32 m0, %0":"=&s"(keep):"v"(gsrc),"s"(lds_dst):"memory");}
__device__ __forceinline__ float max3f(float a,float b,float c){float r;asm("v_max3_f32 %0, %1, %2, %3":"=v"(r):"v"(a),"v"(b),"v"(c));return r;}
__device__ __forceinline__ float max2f(float a,float b){float r;asm("v_max_f32_e32 %0, %1, %2":"=v"(r):"v"(a),"v"(b));return r;}
__device__ __forceinline__ float fadd_s(float a,float b){float r;asm("v_add_f32_e32 %0, %1, %2":"=v"(r):"v"(a),"v"(b));return r;}
__device__ __forceinline__ float fsub_s(float a,float b){float r;asm("v_sub_f32_e32 %0, %1, %2":"=v"(r):"v"(a),"v"(b));return r;}
typedef float f32x2_t __attribute__((ext_vector_type(2))); typedef __bf16 bf16x2_t __attribute__((ext_vector_type(2)));
__device__ __forceinline__ unsigned cvtpk_s(float lo,float hi){f32x2_t v={lo,hi};bf16x2_t b=__builtin_convertvector(v,bf16x2_t);return __builtin_bit_cast(unsigned,b);}
#define WAIT_BAR(N) asm volatile("s_waitcnt vmcnt(" #N ") lgkmcnt(0)\n\ts_barrier":::"memory")

__device__ __forceinline__ void qkt(f32x16&p0,f32x16&p1,const char*Kslot,const bf16x8*qr,const f32x16&negm,int r32,int hi){
  const char*kb=Kslot+hi*1024+r32*16;
  #pragma unroll
  for(int d0=0;d0<4;++d0){
    const bf16x8 b0=*reinterpret_cast<const bf16x8*>(kb+d0*2048);
    const bf16x8 b1=*reinterpret_cast<const bf16x8*>(kb+d0*2048+512);
    if(d0==0){p0=__builtin_amdgcn_mfma_f32_32x32x16_bf16(b0,qr[0],negm,0,0,0);p1=__builtin_amdgcn_mfma_f32_32x32x16_bf16(b1,qr[0],negm,0,0,0);}
    else{p0=__builtin_amdgcn_mfma_f32_32x32x16_bf16(b0,qr[d0],p0,0,0,0);p1=__builtin_amdgcn_mfma_f32_32x32x16_bf16(b1,qr[d0],p1,0,0,0);}}
}
typedef __attribute__((address_space(3))) const char* lds_cptr;
typedef short v4i16_t __attribute__((ext_vector_type(4)));
__device__ __forceinline__ void kload8(bf16x8*kf,lds_cptr kp){
  kf[0]=*(const __attribute__((address_space(3))) bf16x8*)(kp);      kf[1]=*(const __attribute__((address_space(3))) bf16x8*)(kp+512);
  kf[2]=*(const __attribute__((address_space(3))) bf16x8*)(kp+2048); kf[3]=*(const __attribute__((address_space(3))) bf16x8*)(kp+2560);
  kf[4]=*(const __attribute__((address_space(3))) bf16x8*)(kp+4096); kf[5]=*(const __attribute__((address_space(3))) bf16x8*)(kp+4608);
  kf[6]=*(const __attribute__((address_space(3))) bf16x8*)(kp+6144); kf[7]=*(const __attribute__((address_space(3))) bf16x8*)(kp+6656);
}
__device__ __forceinline__ void kload2(bf16x8*kf,lds_cptr kp,int j){ kf[2*j]=*(const __attribute__((address_space(3))) bf16x8*)(kp+j*2048); kf[2*j+1]=*(const __attribute__((address_space(3))) bf16x8*)(kp+j*2048+512); }
__device__ __forceinline__ s16x4 vtr(lds_cptr p){ return __builtin_bit_cast(s16x4,__builtin_amdgcn_ds_read_tr16_b64_v4i16((__attribute__((address_space(3))) v4i16_t*)p)); }
__device__ __forceinline__ float rowmax(const f32x16&p0,const f32x16&p1){
  float a=max3f(p0[0],p0[1],p1[0]),b=max3f(p0[2],p0[3],p1[1]);a=max3f(a,p1[2],p1[3]);
  #pragma unroll
  for(int r=4;r<16;r+=4){a=max3f(a,p0[r],p0[r+1]);b=max3f(b,p0[r+2],p0[r+3]);a=max3f(a,p1[r],p1[r+1]);b=max3f(b,p1[r+2],p1[r+3]);}
  const float m=max2f(a,b);
  auto rr=__builtin_amdgcn_permlane32_swap(__float_as_uint(m),__float_as_uint(m),false,false);
  return max2f(__uint_as_float(rr[0]),__uint_as_float(rr[1]));
}
__device__ __forceinline__ void pv(f32x16*o,int vb,bf16x8 pa0,bf16x8 pa1,bf16x8 pa2,bf16x8 pa3){
  #pragma unroll
  for(int d0=0;d0<2;++d0){s16x4 lo[4],hi[4];
    #pragma unroll
    for(int ks=0;ks<4;++ks){
      asm volatile("ds_read_b64_tr_b16 %0,%1 offset:%c2":"=&v"(lo[ks]):"v"(vb),"i"(d0*4096+ks*1024):"memory");
      asm volatile("ds_read_b64_tr_b16 %0,%1 offset:%c2":"=&v"(hi[ks]):"v"(vb),"i"(d0*4096+ks*1024+512):"memory");}
    asm volatile("s_waitcnt lgkmcnt(0)":::"memory");SBAR();
    #define PK(k) (bf16x8){lo[k][0],lo[k][1],lo[k][2],lo[k][3],hi[k][0],hi[k][1],hi[k][2],hi[k][3]}
    o[d0]=__builtin_amdgcn_mfma_f32_32x32x16_bf16(pa0,PK(0),o[d0],0,0,0);
    o[d0]=__builtin_amdgcn_mfma_f32_32x32x16_bf16(pa1,PK(1),o[d0],0,0,0);
    o[d0]=__builtin_amdgcn_mfma_f32_32x32x16_bf16(pa2,PK(2),o[d0],0,0,0);
    o[d0]=__builtin_amdgcn_mfma_f32_32x32x16_bf16(pa3,PK(3),o[d0],0,0,0);
    #undef PK
  }
}

#ifndef ATTN_STORE16
#define ATTN_STORE16(p,v) __builtin_nontemporal_store((v),(u32x4*)(p))
#endif
template<int THRL,int QP,int KP,int VP,int OP,bool FIXMAX> __device__ __forceinline__ void attn_unit(int q0,int NT,const bf16*Qb,const bf16*__restrict__ Kh,const bf16*__restrict__ Vh,bf16*Ob,char*shm,float mshift){
  int tid_=threadIdx.x; asm volatile("":"+v"(tid_));
  const int tid=tid_,lane=tid&63,r32=lane&31,hi=lane>>5; const int wid=__builtin_amdgcn_readfirstlane(tid>>6);
  const bf16*Qw=Qb+(long)(q0+wid*QBLK)*QP;
  const unsigned lds0=(unsigned)(uintptr_t)shm;
  float*wsf=(float*)(shm+LDS_WS)+wid*64;
  const bf16*ksrc=Kh+(long)lane*KP+wid*8;
  const bf16*vsrc=Vh+(long)(16*(wid&3)+(lane>>2))*VP+(wid>>2)*32+(lane&3)*8;
  const unsigned kdst=lds0+LDS_K+wid*1024, vdst=lds0+LDS_V+wid*1024;
  #define DMA_K(t,slot) glds16(ksrc+(long)(t)*KVBLK*KP,(unsigned)__builtin_amdgcn_readfirstlane(kdst+(slot)))
  #define DMA_V(t,slot) glds16(vsrc+(long)(t)*KVBLK*VP,(unsigned)__builtin_amdgcn_readfirstlane(vdst+(slot)))
  const int vb0=(int)(lds0+LDS_V)+((lane>>4)&1)*32+(lane&3)*8+(4*hi+((lane&15)>>2))*64;
  const char*Kbase=shm+LDS_K; bf16x8 kf[8];
  const lds_cptr shm3=(lds_cptr)shm; const lds_cptr kp0=shm3+LDS_K+hi*1024+r32*16; const lds_cptr vp0=shm3+LDS_V+((lane>>4)&1)*32+(lane&3)*8+(4*hi+((lane&15)>>2))*64;
  DMA_K(0,0);DMA_V(0,0);DMA_K(1,SLOTB);
  bf16x8 qr[4];
  #pragma unroll
  for(int d0=0;d0<4;++d0)qr[d0]=*reinterpret_cast<const bf16x8*>(&Qw[(long)r32*QP+d0*16+hi*8]);
  float mhat=0.f,l_reg=0.f;f32x16 o[2];o[0]=f32x16{};o[1]=f32x16{};f32x16 negm=f32x16{};asm volatile("":"+v"(negm));
  #define CMASK(P0,P1,t) do{}while(0)
  bool resc=false;
  #define START(P0,P1) do{ const float rm=FIXMAX?mshift:rowmax(P0,P1); resc=false; \
    { const float dl=rm; mhat=fadd_s(mhat,dl); \
      _Pragma("unroll") for(int r=0;r<16;++r){P0[r]=fsub_s(P0[r],dl);P1[r]=fsub_s(P1[r],dl);} \
      _Pragma("unroll") for(int r=0;r<16;++r)negm[r]=-mhat; asm volatile("":"+v"(negm)); } \
    _Pragma("unroll") for(int r=0;r<16;++r)P0[r]=__builtin_amdgcn_exp2f(P0[r]); }while(0)
  #define RESC() do{ if(resc){ asm volatile("s_waitcnt lgkmcnt(0)":::"memory"); \
      _Pragma("unroll") for(int d_=0;d_<2;++d_) _Pragma("unroll") for(int r=0;r<16;++r)o[d_][r]*=wsf[crow(r,hi)]; } }while(0)
  f32x16 pA0,pA1,pB0,pB1;
  int sl_prev=0,sl_cur=0,sl_next=SLOTB;
  #define ROT() do{sl_prev=sl_cur;sl_cur=sl_next;sl_next=(sl_next==(NSLOT-1)*SLOTB)?0:sl_next+SLOTB;}while(0)
  DMA_K(2,2*SLOTB);
  WAIT_BAR(3);
  qkt(pA0,pA1,Kbase,qr,negm,r32,hi);asm volatile("s_nop 15\n\ts_nop 7":"+v"(pA0),"+v"(pA1));CMASK(pA0,pA1,0);
  START(pA0,pA1);
  _Pragma("unroll") for(int r=0;r<16;++r)pA1[r]=__builtin_amdgcn_exp2f(pA1[r]);
  WAIT_BAR(0);
  DMA_K(3,0);DMA_V(1,SLOTB);
  ROT();
  kload8(kf,kp0+sl_cur);
  WAIT_BAR(2);
  s16x4 vlo[8],vhi[8]; u32x4 pw0,pw1,pw2,pw3;
  #define PKW(P,B) cvtpk_s(P[B],P[B+1])
  #define PAF(k) __builtin_bit_cast(bf16x8,pw##k)
  #define VFR(i) (bf16x8){vlo[i][0],vlo[i][1],vlo[i][2],vlo[i][3],vhi[i][0],vhi[i][1],vhi[i][2],vhi[i][3]}
  #define PIN(x) asm volatile("":"+v"(x))
  #define MX3(a,b,c) __builtin_fmaxf(__builtin_fmaxf((a),(b)),(c))
  #define GAPA(MF,A0,A1,A2,A3,W0,W1,PW) do{ MF; sacc+=A0; sacc+=A1; sacc+=A2; sacc+=A3; PIN(sacc); W0; W1; PIN(PW); SBAR(); }while(0)
  #define EX(v) __builtin_amdgcn_exp2f(v)
  #define GAPB(MF,X,B) do{ MF; X[B]=EX(X[B]); X[B+1]=EX(X[B+1]); X[B+2]=EX(X[B+2]); X[B+3]=EX(X[B+3]); PIN(X); SBAR(); }while(0)
  #define VRD(i) do{ vlo[i]=vtr(vp_+(((i)>>2)*4096+((i)&3)*1024)); vhi[i]=vtr(vp_+(((i)>>2)*4096+((i)&3)*1024+512)); }while(0)
  #define KRD(G,j) do{ if(G){ kload2(kf,kp0+sl_next,j); SBAR(); } }while(0)
  #define STEP(C0,C1,P0,P1,t,GK,GV,GL) do{ SBAR(); \
    const lds_cptr vp_=vp0+sl_prev; \
    VRD(0); SBAR(); float sacc=(P0[0]+P0[1]); \
    GAPA(C0=__builtin_amdgcn_mfma_f32_32x32x16_bf16(kf[0],qr[0],negm,0,0,0), P0[2],P0[3],P0[4],P0[5],     pw0[0]=PKW(P0,0), pw0[1]=PKW(P0,2), pw0); \
    VRD(4); SBAR(); GAPA(C1=__builtin_amdgcn_mfma_f32_32x32x16_bf16(kf[1],qr[0],negm,0,0,0), P0[6],P0[7],P0[8],P0[9],     pw0[2]=PKW(P0,4), pw0[3]=PKW(P0,6), pw0); \
    VRD(1); SBAR(); GAPA(C0=__builtin_amdgcn_mfma_f32_32x32x16_bf16(kf[2],qr[1],C0,0,0,0),   P0[10],P0[11],P0[12],P0[13], pw1[0]=PKW(P0,8), pw1[1]=PKW(P0,10), pw1); \
    VRD(5); SBAR(); GAPA(C1=__builtin_amdgcn_mfma_f32_32x32x16_bf16(kf[3],qr[1],C1,0,0,0),   P0[14],P0[15],P1[0],P1[1],   pw1[2]=PKW(P0,12),pw1[3]=PKW(P0,14), pw1); \
    VRD(2); SBAR(); GAPA(C0=__builtin_amdgcn_mfma_f32_32x32x16_bf16(kf[4],qr[2],C0,0,0,0),   P1[2],P1[3],P1[4],P1[5],     pw2[0]=PKW(P1,0), pw2[1]=PKW(P1,2), pw2); \
    VRD(6); SBAR(); GAPA(C1=__builtin_amdgcn_mfma_f32_32x32x16_bf16(kf[5],qr[2],C1,0,0,0),   P1[6],P1[7],P1[8],P1[9],     pw2[2]=PKW(P1,4), pw2[3]=PKW(P1,6), pw2); \
    VRD(3); SBAR(); GAPA(C0=__builtin_amdgcn_mfma_f32_32x32x16_bf16(kf[6],qr[3],C0,0,0,0),   P1[10],P1[11],P1[12],P1[13], pw3[0]=PKW(P1,8), pw3[1]=PKW(P1,10), pw3); \
    VRD(7); SBAR(); GAPA(C1=__builtin_amdgcn_mfma_f32_32x32x16_bf16(kf[7],qr[3],C1,0,0,0),   P1[14],P1[15],0.f,0.f,       pw3[2]=PKW(P1,12),pw3[3]=PKW(P1,14), pw3); \
    l_reg+=sacc; \
    if(GK){DMA_K((t)+3,sl_cur);} if(GV){DMA_V((t)+1,sl_next);} \
    CMASK(C0,C1,t); \
    if(!FIXMAX){ float a=MX3(C0[0],C0[1],C1[0]),b=MX3(C0[2],C0[3],C1[1]); a=MX3(a,C1[2],C1[3]); \
      _Pragma("unroll") for(int r=4;r<16;r+=4){a=MX3(a,C0[r],C0[r+1]);b=MX3(b,C0[r+2],C0[r+3]);a=MX3(a,C1[r],C1[r+1]);b=MX3(b,C1[r+2],C1[r+3]);} \
      float rm=__builtin_fmaxf(a,b); { auto rr=__builtin_amdgcn_permlane32_swap(__float_as_uint(rm),__float_as_uint(rm),false,false); rm=__builtin_fmaxf(__uint_as_float(rr[0]),__uint_as_float(rr[1])); } \
      resc=false; \
      if(__builtin_expect(__any(rm>(float)THRL),0)){ const float dl=__builtin_fmaxf(rm,0.f); mhat+=dl; \
        _Pragma("unroll") for(int r=0;r<16;++r){C0[r]-=dl;C1[r]-=dl;} \
        _Pragma("unroll") for(int r=0;r<16;++r)negm[r]=-mhat; asm volatile("":"+v"(negm)); \
        const float f=__builtin_amdgcn_exp2f(-dl); l_reg*=f; if(hi==0)wsf[r32]=f; resc=true; } } \
    SBAR(); \
    GAPB(o[0]=__builtin_amdgcn_mfma_f32_32x32x16_bf16(PAF(0),VFR(0),o[0],0,0,0), C0,0); \
    GAPB(o[1]=__builtin_amdgcn_mfma_f32_32x32x16_bf16(PAF(0),VFR(4),o[1],0,0,0), C0,4); \
    KRD(GL,0); GAPB(o[0]=__builtin_amdgcn_mfma_f32_32x32x16_bf16(PAF(1),VFR(1),o[0],0,0,0), C0,8); \
    KRD(GL,1); GAPB(o[1]=__builtin_amdgcn_mfma_f32_32x32x16_bf16(PAF(1),VFR(5),o[1],0,0,0), C0,12); \
    KRD(GL,2); GAPB(o[0]=__builtin_amdgcn_mfma_f32_32x32x16_bf16(PAF(2),VFR(2),o[0],0,0,0), C1,0); \
    KRD(GL,3); GAPB(o[1]=__builtin_amdgcn_mfma_f32_32x32x16_bf16(PAF(2),VFR(6),o[1],0,0,0), C1,4); \
    GAPB(o[0]=__builtin_amdgcn_mfma_f32_32x32x16_bf16(PAF(3),VFR(3),o[0],0,0,0), C1,8); \
    GAPB(o[1]=__builtin_amdgcn_mfma_f32_32x32x16_bf16(PAF(3),VFR(7),o[1],0,0,0), C1,12); \
    }while(0)
  int t=1;
  #undef CMASK
  #define CMASK(P0,P1,t) do{}while(0)
  for(;t+5<NT;t+=2){
    STEP(pB0,pB1,pA0,pA1,t,true,true,true);     WAIT_BAR(2); RESC(); ROT();
    STEP(pA0,pA1,pB0,pB1,t+1,true,true,true);   WAIT_BAR(2); RESC(); ROT();
  }
  #undef CMASK
  #define CMASK(P0,P1,t) do{}while(0)
  #define ENDW(tt) do{ if((tt)+3<NT){WAIT_BAR(2);} else if((tt)+2<NT){WAIT_BAR(1);} else {WAIT_BAR(0);} }while(0)
  for(;t+1<NT;t+=2){
    STEP(pB0,pB1,pA0,pA1,t,(t+3<NT),(t+1<NT),(t+1<NT));       ENDW(t);   RESC(); ROT();
    STEP(pA0,pA1,pB0,pB1,t+1,(t+4<NT),(t+2<NT),(t+2<NT));     ENDW(t+1); RESC(); ROT();
  }
  STEP(pB0,pB1,pA0,pA1,NT-1,false,false,false); RESC();
  { float sacc=pB0[0]+pB0[1]; _Pragma("unroll") for(int r=2;r<16;++r)sacc+=pB0[r]; _Pragma("unroll") for(int r=0;r<16;++r)sacc+=pB1[r]; l_reg+=sacc;
    pw0=(u32x4){PKW(pB0,0),PKW(pB0,2),PKW(pB0,4),PKW(pB0,6)};pw1=(u32x4){PKW(pB0,8),PKW(pB0,10),PKW(pB0,12),PKW(pB0,14)};pw2=(u32x4){PKW(pB1,0),PKW(pB1,2),PKW(pB1,4),PKW(pB1,6)};pw3=(u32x4){PKW(pB1,8),PKW(pB1,10),PKW(pB1,12),PKW(pB1,14)};
    SBAR(); pv(o,vb0+sl_cur,PAF(0),PAF(1),PAF(2),PAF(3)); }
  #undef PKW
  #undef PAF
  #undef VFR
  #undef PIN
  #undef MX3
  #undef GAPA
  #undef GAPB
  #undef EX
  #undef VRD
  #undef KRD
  #undef STEP
  #undef ENDW
  {auto rr=__builtin_amdgcn_permlane32_swap(__float_as_uint(l_reg),__float_as_uint(l_reg),false,false);l_reg=__uint_as_float(rr[0])+__uint_as_float(rr[1]);}
  if(hi==0)wsf[32+r32]=l_reg;asm volatile("s_waitcnt lgkmcnt(0)":::"memory");
  float rli[16];
  #pragma unroll
  for(int r=0;r<16;++r)rli[r]=__builtin_amdgcn_rcpf(wsf[32+crow(r,hi)]);
  bf16*Ow=Ob+(long)(q0+wid*QBLK)*OP;
  { bf16*stg=(bf16*)(shm+LDS_OST)+wid*2048;
    #pragma unroll
    for(int r=0;r<16;++r){const int orow=crow(r,hi);
      #pragma unroll
      for(int d0=0;d0<2;++d0)stg[orow*64+d0*32+r32]=__float2bfloat16(o[d0][r]*rli[r]);}
    asm volatile("s_waitcnt lgkmcnt(0)":::"memory");
    #pragma unroll
    for(int i=0;i<4;++i){const int row=i*8+(lane>>3),ch=lane&7; const u32x4 v=*(const u32x4*)(stg+row*64+ch*8); ATTN_STORE16(Ow+(long)row*OP+ch*8,v);} }
  asm volatile("s_waitcnt lgkmcnt(0)\n\ts_barrier":::"memory");
  #undef DMA_K
  #undef DMA_V
  #undef CMASK
  #undef START
  #undef RESC
  #undef ROT
}
constexpr int ATTN_LDS_BYTES=LDS_BYTES;
#undef SBAR
#undef WAIT_BAR
}

#define GAS __attribute__((address_space(1)))
#define LAS __attribute__((address_space(3)))
#define CAS __attribute__((address_space(4)))
typedef const GAS float* cfp;
typedef unsigned short bf16;
typedef unsigned v4u __attribute__((ext_vector_type(4)));
typedef unsigned v2u __attribute__((ext_vector_type(2)));
typedef float f32x4 __attribute__((ext_vector_type(4)));
typedef float f32x2 __attribute__((ext_vector_type(2)));
typedef float f32x16 __attribute__((ext_vector_type(16)));
typedef short bf16x8 __attribute__((ext_vector_type(8)));
typedef short s16x4 __attribute__((ext_vector_type(4)));
typedef GAS unsigned gu32;
#define RLX_AGENT __ATOMIC_RELAXED, __HIP_MEMORY_SCOPE_AGENT
#define NTST(p_, v_) __builtin_nontemporal_store((v_), (p_))
#define LDS_WAIT() asm volatile("s_waitcnt lgkmcnt(0)" ::: "memory")
#define VM_WAIT() asm volatile("s_waitcnt vmcnt(0)" ::: "memory")
#define LDS_BARRIER() do { asm volatile("s_waitcnt lgkmcnt(0)" ::: "memory"); __builtin_amdgcn_s_barrier(); asm volatile("" ::: "memory"); } while (0)

constexpr int NWAVES = 8, NTHR = 512;
constexpr int BATCH = 2, SEQ = 16384, T = BATCH * SEQ, D = 2048, DIN = 5152, DINP = 5376;
constexpr int GW = 512, HD = 64, NH = 8, NKV = 2, DIN_FULL = 5120;
constexpr int C_AQKV = 0, C_AZ = 1536, C_ABETA = 2048, C_AALPHA = 2064, C_B = 2080, C_CQ = 3616, C_CKV = 4128, C_DQ = 4384, C_DKV = 4896;
constexpr int NE = 32, DE = 512, MOE_ROWS = 2 * T + NE * 256;
constexpr int FL = SEQ;
constexpr float EPS = 1e-6f;
constexpr float LOG2E = 1.4426950408889634f;
constexpr float C2 = 0.125f * LOG2E;

enum { I_X = 0, I_NORM_MIX, I_W_IN, I_GDN_CONV, I_GDN_ALOG, I_GDN_DTB, I_GDN_NORM, I_HY_CONV, I_HY_W1, I_HY_B1, I_HY_F1, I_HY_W2, I_HY_B2, I_HY_F2, I_HY_W3,
       I_HY_DELTAS, I_HY_BIAS, I_HY_NORM, I_SWA_SINK, I_SWA_NORM, I_GA_QN, I_GA_KN, I_GA_NORM, I_W_OUT, I_NORM_FFN, I_MOE_WG, I_MOE_BG, I_MOE_WE, I_MOE_BE,
       I_MOE_GATE, I_MOE_UP, I_MOE_DOWN, I_NORM_FINAL, N_INPUTS };

constexpr size_t MiB = 1u << 20;
constexpr size_t WS_CTL = 0, CTL_ZERO_BYTES = 160 * 1024;
constexpr size_t WS_INFO = 1 * MiB;
constexpr size_t WS_H2T = 2 * MiB;
constexpr size_t WS_WRT = 6 * MiB;
constexpr size_t WS_WIN = 8 * MiB;
constexpr size_t WIN_BYTES = (size_t)DINP * D * 2;
constexpr size_t WS_WOUT = 50 * MiB;
constexpr size_t WOUT_BYTES = (size_t)D * D * 2;
constexpr size_t WS_XN = 66 * MiB;
constexpr size_t WS_P = 194 * MiB;
constexpr size_t WS_MOE_H = WS_P + 288 * MiB;
constexpr size_t WS_Y = 554 * MiB;
constexpr size_t WS_T = 682 * MiB;
constexpr size_t WS_GUT = WS_Y, WS_DT = WS_T;
constexpr size_t WS_ELIST = WS_T + 64 * MiB;
constexpr size_t WS_HT = WS_XN, WS_OF = WS_XN + 64 * MiB, WS_OB = WS_XN + 96 * MiB;
constexpr size_t WS_UT = WS_Y, WS_YT = WS_T, WS_FSCR = WS_T + 64 * MiB;
constexpr size_t WS_QP = WS_T + 384 * MiB, WS_KP = WS_Y + 96 * MiB, WS_VTC = WS_Y + 104 * MiB, WS_VP = WS_Y + 112 * MiB, WS_OGD = WS_T + 192 * MiB, WS_OGC = WS_T + 416 * MiB;
constexpr size_t WS_END = WS_T + 448 * MiB;
constexpr int CW_BAR = 4096;
constexpr int CW_SUB = 36864;
constexpr int CW_CNT = 32768;

constexpr int RING_BYTES = 131072;
constexpr int FFT_LDS_BYTES = 139264;
constexpr int MISC_OFF = FFT_LDS_BYTES;
constexpr int TILE_E_OFF = MISC_OFF + 1024;
constexpr int LDS_BYTES = 147456;

typedef __bf16 hwbf16x2 __attribute__((ext_vector_type(2)));
__device__ __forceinline__ unsigned pk2(float lo, float hi) { const f32x2 v = {lo, hi}; return __builtin_bit_cast(unsigned, __builtin_convertvector(v, hwbf16x2)); }
__device__ __forceinline__ unsigned f2bf(float f) { return pk2(f, 0.f) & 0xffffu; }
__device__ __forceinline__ float bf2f(bf16 h) { return __builtin_bit_cast(float, (unsigned)h << 16); }
__device__ __forceinline__ float bflo(unsigned w) { return __builtin_bit_cast(float, w << 16); }
__device__ __forceinline__ float bfhi(unsigned w) { return __builtin_bit_cast(float, w & 0xffff0000u); }
__device__ __forceinline__ float wave_sum(float v) {
#pragma unroll
    for (int o = 1; o < 64; o <<= 1) v += __shfl_xor(v, o);
    return v;
}
__device__ __forceinline__ int crow(int r, int hi) { return (r & 3) + 8 * (r >> 2) + 4 * hi; }
__device__ __forceinline__ float siluf(float a) { return a / (1.0f + __expf(-a)); }

#define XB_TMO      128
#define XB_XCNT(j)  (256  + 64 * (j))
#define XB_XSUB(j)  (1280 + 64 * (j))
#define XB_XGEN(j)  (2304 + 64 * (j))
#define XB_TOP      3328
#define XB_TOPGEN   3392
#define XCD_BAR_WORDS 3456
#define XB_SPIN_CAP (1u << 18)

__device__ __forceinline__ unsigned xb_ld(unsigned* p)              { return __hip_atomic_load(p, __ATOMIC_RELAXED, __HIP_MEMORY_SCOPE_AGENT); }
__device__ __forceinline__ unsigned xb_add(unsigned* p, unsigned v) { return __hip_atomic_fetch_add(p, v, __ATOMIC_RELAXED, __HIP_MEMORY_SCOPE_AGENT); }
__device__ __forceinline__ unsigned xb_xcc_id() { return (unsigned)__builtin_amdgcn_s_getreg((3 << 11) | 20) & 0xFu; }
#define XB_SPIN(cond, bar) do { unsigned _sp = 0; while (cond) { __builtin_amdgcn_s_sleep(1); \
    if ((++_sp & 255u) == 0u) { if (xb_ld(&(bar)[XB_TMO])) break; if (_sp > XB_SPIN_CAP) { atomicAdd(&(bar)[XB_TMO], 1u); break; } } } } while (0)

struct XcdBarrier {
    unsigned* bar; unsigned x;
    volatile LAS unsigned* st;
};

__device__ __forceinline__ XcdBarrier xcd_barrier_post(unsigned* bar, volatile LAS unsigned* st) {
    XcdBarrier b; b.bar = bar; b.x = xb_xcc_id(); b.st = st;
    if (threadIdx.x == 0) (void)xb_add(&bar[XB_XCNT(b.x)], 1u);
    return b;
}
__device__ __forceinline__ void xcd_barrier_complete(unsigned* bar, unsigned x, unsigned& nloc, unsigned& nx) {
    const unsigned G = gridDim.x * gridDim.y * gridDim.z;
    unsigned sum, cnt, mine, sp = 0u;
    for (;;) {
        sum = 0u; cnt = 0u; mine = 0u;
#pragma unroll
        for (unsigned j = 0; j < 16; ++j) { const unsigned c = xb_ld(&bar[XB_XCNT(j)]); sum += c; cnt += (c > 0u) ? 1u : 0u; mine = (j == x) ? c : mine; }
        if (sum == G) break;
        __builtin_amdgcn_s_sleep(1);
        if ((++sp & 255u) == 0u) { if (xb_ld(&bar[XB_TMO])) break; if (sp > XB_SPIN_CAP) { atomicAdd(&bar[XB_TMO], 1u); break; } }
    }
    nloc = mine > 0u ? mine : 1u; nx = cnt > 0u ? cnt : 1u;
}

__device__ __forceinline__ void xcd_barrier(const XcdBarrier& b) {
    asm volatile("s_waitcnt vmcnt(0)" ::: "memory");
    __syncthreads();
    if (threadIdx.x == 0) {
        unsigned* bar = b.bar;
        __builtin_amdgcn_s_waitcnt(0);
        unsigned nloc = b.st[0], nx = b.st[1];
        if (nloc == 0u) { xcd_barrier_complete(bar, b.x, nloc, nx); b.st[0] = nloc; b.st[1] = nx; }
        const unsigned old = xb_add(&bar[XB_XSUB(b.x)], 1u);
        const unsigned gen = old / nloc;
        if (old + 1u == (gen + 1u) * nloc) {
            __builtin_amdgcn_fence(__ATOMIC_RELEASE, "agent");
            asm volatile("s_waitcnt vmcnt(0)" ::: "memory");
            const unsigned og = xb_add(&bar[XB_TOP], 1u);
            const unsigned tg = og / nx;
            if (og + 1u == (tg + 1u) * nx) xb_add(&bar[XB_TOPGEN], 1u);
            else XB_SPIN(xb_ld(&bar[XB_TOPGEN]) == tg, bar);
            __builtin_amdgcn_fence(__ATOMIC_ACQUIRE, "agent");
            xb_add(&bar[XB_XGEN(b.x)], 1u);
            asm volatile("s_waitcnt vmcnt(0)" ::: "memory");
        } else {
            XB_SPIN(xb_ld(&bar[XB_XGEN(b.x)]) == gen, bar);
            __builtin_amdgcn_fence(__ATOMIC_ACQUIRE, "agent");
            asm volatile("s_waitcnt vmcnt(0)" ::: "memory");
        }
    }
    __syncthreads();
}


#define INP(i) ((const float*)F.in[i])
struct Frame {
    LAS unsigned char* lds;
    volatile LAS unsigned* MISC;
    gu32* ctl;
    int tid, lane, wave, G, bid;
    const CAS cfp* in;
    float* out; unsigned char* ws;
};


__device__ __forceinline__ void transpose_tile(const float* W, int ldw, int k0, int n0, bf16* WT, int ldt, int dst_row0, LAS float* scr, int lane) {
#pragma unroll 8
    for (int i = 0; i < 32; ++i) { const int kk = 2 * i + (lane >> 5); scr[kk * 33 + (lane & 31)] = W[(size_t)(k0 + kk) * ldw + n0 + (lane & 31)]; }
    LDS_WAIT(); asm volatile("" ::: "memory");
    const int c = lane & 7;
#pragma unroll
    for (int j = 0; j < 4; ++j) { const int n = (lane >> 3) + 8 * j; const LAS float* s = scr + (8 * c) * 33 + n;
        v4u o; o.x = pk2(s[0 * 33], s[1 * 33]); o.y = pk2(s[2 * 33], s[3 * 33]); o.z = pk2(s[4 * 33], s[5 * 33]); o.w = pk2(s[6 * 33], s[7 * 33]);
        *(v4u*)(WT + (size_t)(dst_row0 + n) * ldt + k0 + 8 * c) = o; }
    LDS_WAIT(); asm volatile("" ::: "memory");
}

__device__ __forceinline__ void transpose_tile64(const float* W, int ldw, int k0, int n0, bf16* WT, int ldt, int dst_row0, LAS float* scr, int lane) {
    f32x4 v[16];
#pragma unroll
    for (int j = 0; j < 16; ++j) v[j] = *(const f32x4*)(W + (size_t)(k0 + 4 * j + (lane >> 4)) * ldw + n0 + 4 * (lane & 15));
#pragma unroll
    for (int j = 0; j < 16; ++j) { LAS float* d = scr + (4 * j + (lane >> 4)) * 65 + 4 * (lane & 15); d[0] = v[j].x; d[1] = v[j].y; d[2] = v[j].z; d[3] = v[j].w; }
    LDS_WAIT(); asm volatile("" ::: "memory");
    const int c = lane & 7;
#pragma unroll
    for (int j = 0; j < 8; ++j) { const int n = (lane >> 3) + 8 * j; const LAS float* s = scr + (8 * c) * 65 + n;
        v4u o; o.x = pk2(s[0 * 65], s[1 * 65]); o.y = pk2(s[2 * 65], s[3 * 65]); o.z = pk2(s[4 * 65], s[5 * 65]); o.w = pk2(s[6 * 65], s[7 * 65]);
        *(v4u*)(WT + (size_t)(dst_row0 + n) * ldt + k0 + 8 * c) = o; }
    LDS_WAIT(); asm volatile("" ::: "memory");
}

__device__ __forceinline__ void norm_row_bf16(const float* xrow, const float* g, bf16* orow, int lane) {
    f32x4 v[8]; float s = 0.f;
#pragma unroll
    for (int j = 0; j < 8; ++j) { v[j] = ((const f32x4*)xrow)[lane + 64 * j]; s += (v[j].x * v[j].x + v[j].y * v[j].y) + (v[j].z * v[j].z + v[j].w * v[j].w); }
    const float rstd = 1.0f / sqrtf(wave_sum(s) * (1.0f / D) + EPS);
#pragma unroll
    for (int j = 0; j < 8; ++j) { const f32x4 gv = ((const f32x4*)g)[lane + 64 * j]; const f32x4 o = v[j] * rstd * gv;
        v2u w; w.x = pk2(o.x, o.y); w.y = pk2(o.z, o.w); NTST((v2u*)orow + lane + 64 * j, w); }
}

__device__ __forceinline__ void ph_prologue(Frame& F) {
    LAS float* scr = (LAS float*)(F.lds + F.wave * 16640);
    const int gw = F.bid * NWAVES + F.wave, NGW = F.G * NWAVES;
    constexpr int IT_IN = (D / 64) * (DIN / 32), IT_OUT = (D / 64) * (D / 64);
    for (int it = gw; it < 2 * (IT_IN + IT_OUT); it += NGW) {
        const int l = it / (IT_IN + IT_OUT); int r = it % (IT_IN + IT_OUT);
        if (r < IT_IN) { const int nblk = DIN / 32, kb = r / nblk, nb = r % nblk;
            transpose_tile(INP(I_W_IN) + (size_t)l * D * DIN, DIN, kb * 64, nb * 32, (bf16*)(F.ws + WS_WIN + l * WIN_BYTES), D, nb * 32, scr, F.lane); }
        else { r -= IT_IN; const int nblk = D / 64, kb = r / nblk, nb = r % nblk;
            transpose_tile64(INP(I_W_OUT) + (size_t)l * D * D, D, kb * 64, nb * 64, (bf16*)(F.ws + WS_WOUT + l * WOUT_BYTES), D, nb * 64, scr, F.lane); }
    }
    { const int gt = F.bid * NTHR + F.tid, NGT = F.G * NTHR; constexpr int PADV = (DINP - DIN) * D * 2 / 16;
      for (int i = gt; i < 2 * PADV; i += NGT) { const int l = i / PADV, r = i % PADV; ((v4u*)(F.ws + WS_WIN + l * WIN_BYTES + (size_t)DIN * D * 2))[r] = (v4u){0u, 0u, 0u, 0u}; }
      float* wg = (float*)(F.ws + WS_WRT);
      for (int i = gt; i < 2 * D * 64; i += NGT) { const int l = i / (D * 64), r_ = i % (D * 64), k = r_ >> 6, j = r_ & 63; const float gk = INP(I_NORM_FFN)[l * D + k];
          wg[i] = (j < 32) ? gk * INP(I_MOE_WE)[((size_t)l * D + k) * 32 + j] : (j < 36) ? gk * INP(I_MOE_WG)[((size_t)l * D + k) * 4 + (j - 32)] : 0.f; } }
    for (int m = gw; m < T; m += NGW) norm_row_bf16(INP(I_X) + (size_t)m * D, INP(I_NORM_MIX), (bf16*)(F.ws + WS_XN) + (size_t)m * D, F.lane);
}

__device__ __forceinline__ void ph_in_rem(Frame& F, int l) {
    const int gw = F.bid * NWAVES + F.wave, NGW = F.G * NWAVES, lane = F.lane, fr = lane & 15, fq = lane >> 4;
    const bf16* xn = (const bf16*)(F.ws + WS_XN); const bf16* wt = (const bf16*)(F.ws + WS_WIN + l * WIN_BYTES) + (size_t)DIN_FULL * D;
    bf16* proj = (bf16*)(F.ws + WS_P);
    for (int u = gw; u < T / 16; u += NGW) {
        const bf16* ap = xn + (size_t)(u * 16 + fr) * D + 8 * fq; const bf16* bp0 = wt + (size_t)fr * D + 8 * fq; const bf16* bp1 = bp0 + (size_t)16 * D;
        f32x4 acc0 = (f32x4){0.f, 0.f, 0.f, 0.f}, acc1 = (f32x4){0.f, 0.f, 0.f, 0.f};
#pragma unroll 8
        for (int ks = 0; ks < D / 32; ++ks) { const bf16x8 a = *(const bf16x8*)(ap + 32 * ks), b0 = *(const bf16x8*)(bp0 + 32 * ks), b1 = *(const bf16x8*)(bp1 + 32 * ks);
            acc0 = __builtin_amdgcn_mfma_f32_16x16x32_bf16(b0, a, acc0, 0, 0, 0); acc1 = __builtin_amdgcn_mfma_f32_16x16x32_bf16(b1, a, acc1, 0, 0, 0); }
        bf16* o = proj + (size_t)(u * 16 + fr) * DINP + DIN_FULL + 4 * fq;
        *(v2u*)o = (v2u){pk2(acc0.x, acc0.y), pk2(acc0.z, acc0.w)}; *(v2u*)(o + 16) = (v2u){pk2(acc1.x, acc1.y), pk2(acc1.z, acc1.w)};
    }
}
constexpr int GREC_BYTES = 49152, GREC_W = 16384, GREC_A = 24576, GREC_Q = 32768, GREC_K = 40960;
constexpr size_t WS_GREC = WS_T;
constexpr size_t WS_GCD = 7 * MiB;
__device__ __forceinline__ void ph_gdn_prep(Frame& F, int l) {
    LAS float* Ks = (LAS float*)F.lds;
    LAS float* Qs = (LAS float*)(F.lds + 16640);
    LAS float* Vs = (LAS float*)(F.lds + 33280);
    LAS float* KK = (LAS float*)(F.lds + 49664);
    LAS float* QK = (LAS float*)(F.lds + 66304);
    LAS float* AT = (LAS float*)(F.lds + 82944);
    LAS float* gfv = (LAS float*)(F.lds + 100352);
    const bf16* proj = (const bf16*)(F.ws + WS_P);
    const float* cw = INP(I_GDN_CONV) + (size_t)l * 3 * 1536;
    for (int unit = F.bid; unit < 2 * 8 * 256; unit += F.G) {
        int tid_ = F.tid; asm volatile("" : "+v"(tid_));
        const int tid = tid_, lane = tid & 63, wave = __builtin_amdgcn_readfirstlane(tid >> 6);
        const int n = unit & 255, h = (unit >> 8) & 7, b = unit >> 11;
        { const int j = tid >> 3, p = tid & 7, t = n * 64 + j; const size_t m = (size_t)b * SEQ + t;
          const bf16* pr = proj + m * DINP + C_AQKV + h * 64 + p * 8;
          float sq = 0.f, sk = 0.f; float qv[8], kv[8], vv[8];
#pragma unroll
          for (int part = 0; part < 3; ++part) {
              const v4u xc = *(const v4u*)(pr + part * 512);
              v4u xm = (v4u){0u, 0u, 0u, 0u}, xp = (v4u){0u, 0u, 0u, 0u};
              if (t > 0) xm = *(const v4u*)(pr + part * 512 - DINP);
              if (t < SEQ - 1) xp = *(const v4u*)(pr + part * 512 + DINP);
              const int ch = part * 512 + h * 64 + p * 8;
              const f32x4 w0a = *(const f32x4*)(cw + ch), w0b = *(const f32x4*)(cw + ch + 4), w1a = *(const f32x4*)(cw + 1536 + ch), w1b = *(const f32x4*)(cw + 1536 + ch + 4),
                          w2a = *(const f32x4*)(cw + 3072 + ch), w2b = *(const f32x4*)(cw + 3072 + ch + 4);
              const float c0[8] = {bflo(xm.x), bfhi(xm.x), bflo(xm.y), bfhi(xm.y), bflo(xm.z), bfhi(xm.z), bflo(xm.w), bfhi(xm.w)};
              const float c1[8] = {bflo(xc.x), bfhi(xc.x), bflo(xc.y), bfhi(xc.y), bflo(xc.z), bfhi(xc.z), bflo(xc.w), bfhi(xc.w)};
              const float c2[8] = {bflo(xp.x), bfhi(xp.x), bflo(xp.y), bfhi(xp.y), bflo(xp.z), bfhi(xp.z), bflo(xp.w), bfhi(xp.w)};
              const float ww0[8] = {w0a.x, w0a.y, w0a.z, w0a.w, w0b.x, w0b.y, w0b.z, w0b.w}, ww1[8] = {w1a.x, w1a.y, w1a.z, w1a.w, w1b.x, w1b.y, w1b.z, w1b.w}, ww2[8] = {w2a.x, w2a.y, w2a.z, w2a.w, w2b.x, w2b.y, w2b.z, w2b.w};
#pragma unroll
              for (int i = 0; i < 8; ++i) { float a = ww0[i] * c0[i] + ww1[i] * c1[i] + ww2[i] * c2[i]; a = a * __builtin_amdgcn_rcpf(1.0f + __expf(-a));
                  if (part == 0) { qv[i] = a; sq += a * a; } else if (part == 1) { kv[i] = a; sk += a * a; } else vv[i] = a; }
          }
          sq += __shfl_xor(sq, 1); sq += __shfl_xor(sq, 2); sq += __shfl_xor(sq, 4);
          sk += __shfl_xor(sk, 1); sk += __shfl_xor(sk, 2); sk += __shfl_xor(sk, 4);
          const float rq = 0.125f / sqrtf(sq + EPS), rk = 1.0f / sqrtf(sk + EPS);
#pragma unroll
          for (int i = 0; i < 8; ++i) { Qs[j * 65 + p * 8 + i] = qv[i] * rq; Ks[j * 65 + p * 8 + i] = kv[i] * rk; Vs[j * 64 + p * 8 + i] = vv[i]; }
          if (tid < 64) { const size_t mm = (size_t)b * SEQ + n * 64 + tid; const bf16* pb_ = proj + mm * DINP;
              const float xbf = bf2f(pb_[C_ABETA + h]), xbb = bf2f(pb_[C_ABETA + 8 + h]);
              const float xaf = bf2f(pb_[C_AALPHA + h]) + INP(I_GDN_DTB)[l * 16 + h], xab = bf2f(pb_[C_AALPHA + 8 + h]) + INP(I_GDN_DTB)[l * 16 + 8 + h];
              const float spf = (xaf > 20.f) ? xaf : __logf(1.0f + __expf(xaf)), spb = (xab > 20.f) ? xab : __logf(1.0f + __expf(xab));
              const float g_f = -__expf(INP(I_GDN_ALOG)[l * 16 + h]) * spf, g_b = -__expf(INP(I_GDN_ALOG)[l * 16 + 8 + h]) * spb;
              gfv[256 + tid] = 1.0f / (1.0f + __expf(-xbf)); gfv[320 + tid] = 1.0f / (1.0f + __expf(-xbb));
              float sf = g_f; float sb = __shfl(g_b, 63 - lane);
#pragma unroll
              for (int o = 1; o < 64; o <<= 1) { const float uf = __shfl_up(sf, o), ub = __shfl_up(sb, o); if (lane >= o) { sf += uf; sb += ub; } }
              gfv[128 + tid] = sf; gfv[192 + 63 - tid] = sb; }
        }
        LDS_BARRIER();
        { const int mat = wave >> 2, mt = wave & 3, r16 = lane & 15, q4 = lane >> 4; const LAS float* Am = mat ? Qs : Ks; LAS float* Om = mat ? QK : KK;
          f32x4 acc[4];
#pragma unroll
          for (int nt = 0; nt < 4; ++nt) acc[nt] = (f32x4){0.f, 0.f, 0.f, 0.f};
#pragma unroll 4
          for (int ks = 0; ks < 16; ++ks) { const float a = Am[(16 * mt + r16) * 65 + 4 * ks + q4];
#pragma unroll
              for (int nt = 0; nt < 4; ++nt) acc[nt] = __builtin_amdgcn_mfma_f32_16x16x4f32(a, Ks[(16 * nt + r16) * 65 + 4 * ks + q4], acc[nt], 0, 0, 0); }
#pragma unroll
          for (int nt = 0; nt < 4; ++nt)
#pragma unroll
              for (int rg = 0; rg < 4; ++rg) Om[(16 * mt + 4 * q4 + rg) * 65 + 16 * nt + r16] = acc[nt][rg];
        }
        LDS_BARRIER();
#pragma unroll
        for (int q = 0; q < 8; ++q) { const int e = tid + NTHR * q, i = e >> 6, j = e & 63; float v = 0.f;
            if (j > i) v = gfv[256 + j] * KK[j * 65 + i] * __expf(gfv[128 + j] - gfv[128 + i]);
            else if (j < i) v = gfv[320 + j] * KK[j * 65 + i] * __expf(gfv[192 + j] - gfv[192 + i]);
            AT[i * 68 + j] = v; }
        LDS_BARRIER();
        unsigned char* recf = F.ws + WS_GREC + ((size_t)((b * 8 + h) * 2 + 0) * 256 + n) * GREC_BYTES;
        unsigned char* recb = F.ws + WS_GREC + ((size_t)((b * 8 + h) * 2 + 1) * 256 + n) * GREC_BYTES;
        if (wave < 4) {
            const int dirw = wave >> 1, isW = wave & 1; const LAS float* gc = gfv + 128 + dirw * 64; const LAS float* be = gfv + 256 + dirw * 64;
            const LAS float* ATl = AT; asm volatile("" : "+v"(ATl), "+v"(gc), "+v"(be));
#define NFMA(acc_, a_, x_) asm("v_fma_f32 %0, -%1, %2, %0" : "+v"(acc_) : "v"(a_), "v"(x_))
#define NPKFMA(acc2_, a2_, xp_, EL) do { if ((EL) == 0) asm("v_pk_fma_f32 %0, %1, %2, %0 op_sel_hi:[1,0,1] neg_lo:[1,0,0] neg_hi:[1,0,0]" : "+v"(acc2_) : "v"(a2_), "v"(xp_)); \
                                         else asm("v_pk_fma_f32 %0, %1, %2, %0 op_sel:[0,1,0] op_sel_hi:[1,1,1] neg_lo:[1,0,0] neg_hi:[1,0,0]" : "+v"(acc2_) : "v"(a2_), "v"(xp_)); } while (0)
            f32x2 R2[32];
#pragma unroll
            for (int j = 0; j < 64; ++j) R2[j >> 1][j & 1] = isW ? (be[j] * Ks[j * 65 + lane] * __expf(gc[j])) : (be[j] * Vs[j * 64 + lane]);
            f32x4 cb[2][8];
#define SV_ROW(t) (BW ? ((t) < 62 ? 63 - ((t) >> 1) : 32 - ((t) - 62)) : ((t) < 62 ? ((t) >> 1) : 31 + ((t) - 62)))
#define SV_K0(t)  (BW ? (((t) < 62 && ((t) & 1)) ? 8 : 0) : ((((SV_ROW(t)) + 1) >> 2) + (((t) < 62 && ((t) & 1)) ? 8 : 0)))
#define SV_K1(t)  (BW ? (((t) < 62 && !((t) & 1)) ? 7 : ((SV_ROW(t) - 1) >> 2)) : (((t) < 62 && !((t) & 1)) ? ((((SV_ROW(t)) + 1) >> 2) + 7) : 15))
#define SV_LOAD(t) do { _Pragma("unroll") for (int k = SV_K0(t); k <= SV_K1(t); ++k) cb[(t) & 1][k - SV_K0(t)] = *(const LAS f32x4*)(ATl + SV_ROW(t) * 68 + 4 * k); } while (0)
#define SV_PAIR(j0, alo, ahi) do { if (!BW) { if ((j0) > i) { const f32x2 a2 = (f32x2){alo, ahi}; NPKFMA(R2[(j0) >> 1], a2, xp, i & 1); } else if ((j0) + 1 > i) NFMA(R2[(j0) >> 1][1], ahi, xi); } \
                                   else { if ((j0) + 1 < i) { const f32x2 a2 = (f32x2){alo, ahi}; NPKFMA(R2[(j0) >> 1], a2, xp, i & 1); } else if ((j0) < i) NFMA(R2[(j0) >> 1][0], alo, xi); } } while (0)
#define SV_RUN() do { SV_LOAD(0); \
                _Pragma("clang loop unroll(full)") for (int t = 0; t < 94; ++t) { \
                    if (t + 1 < 94) SV_LOAD(t + 1); \
                    __builtin_amdgcn_sched_barrier(0); \
                    const int i = SV_ROW(t); const float xi = R2[i >> 1][i & 1]; const f32x2 xp = R2[i >> 1]; \
                    _Pragma("unroll") for (int k = SV_K0(t); k <= SV_K1(t); ++k) { const f32x4 v = cb[t & 1][k - SV_K0(t)]; SV_PAIR(4 * k, v.x, v.y); SV_PAIR(4 * k + 2, v.z, v.w); } \
                    __builtin_amdgcn_sched_barrier(0); } } while (0)
            if (dirw == 0) { constexpr bool BW = false; SV_RUN(); } else { constexpr bool BW = true; SV_RUN(); }
#undef SV_ROW
#undef SV_K0
#undef SV_K1
#undef SV_LOAD
#undef SV_PAIR
#undef SV_RUN
            float R[64];
#pragma unroll
            for (int j = 0; j < 64; ++j) R[j] = R2[j >> 1][j & 1];
            unsigned char* rec = dirw ? recb : recf;
            if (!isW) { LAS unsigned char* st = F.lds + (dirw ? 102400 : 49664);
#pragma unroll
                for (int j = 0; j < 16; ++j) *(LAS f32x4*)(st + lane * 256 + ((j ^ (lane & 15)) << 4)) = (f32x4){R[4 * j], R[4 * j + 1], R[4 * j + 2], R[4 * j + 3]};
#pragma unroll
                for (int i = 0; i < 16; ++i) { const int row = (lane >> 4) + 4 * i, ch = lane & 15;
                    NTST((f32x4*)(rec + (size_t)row * 256 + ch * 16), *(const LAS f32x4*)(st + row * 256 + ((ch ^ (row & 15)) << 4))); } }
            else { LAS unsigned char* st = F.lds + (dirw ? 128000 : 118784);
#pragma unroll
                for (int j = 0; j < 64; ++j) *(LAS bf16*)(st + j * 144 + lane * 2) = (bf16)f2bf(-R[j]);
#pragma unroll
                for (int i = 0; i < 8; ++i) { const int row = (lane >> 3) + 8 * i, ch = lane & 7;
                    NTST((v4u*)(rec + GREC_W + (size_t)row * 128 + ch * 16), *(const LAS v4u*)(st + row * 144 + ch * 16)); } }
        } else {
            const int tl = tid - 256;
#pragma unroll
            for (int q = 0; q < 2; ++q) { const int e = tl + 256 * q, i = e >> 3, j0 = (e & 7) * 8;
                const float gfi = gfv[128 + i], gbi = gfv[192 + i], egf = __expf(gfi), egb = __expf(gbi), gfl = gfv[128 + 63], gbl = gfv[192 + 0];
                float af[8], ab[8], qf_[8], qb_[8], kf_[8], kb_[8];
#pragma unroll
                for (int c = 0; c < 8; ++c) { const int j = j0 + c; const float qk = QK[i * 65 + j];
                    af[c] = (j <= i) ? qk * __expf(gfi - gfv[128 + j]) : 0.f; ab[c] = (j >= i) ? qk * __expf(gbi - gfv[192 + j]) : 0.f;
                    const float qq = Qs[i * 65 + j]; qf_[c] = qq * egf; qb_[c] = qq * egb;
                    const float kk = Ks[j * 65 + i]; kf_[c] = kk * __expf(gfl - gfv[128 + j]); kb_[c] = kk * __expf(gbl - gfv[192 + j]); }
                const size_t off = (size_t)i * 128 + j0 * 2;
                NTST((v4u*)(recf + GREC_A + off), ((v4u){pk2(af[0], af[1]), pk2(af[2], af[3]), pk2(af[4], af[5]), pk2(af[6], af[7])}));
                NTST((v4u*)(recb + GREC_A + off), ((v4u){pk2(ab[0], ab[1]), pk2(ab[2], ab[3]), pk2(ab[4], ab[5]), pk2(ab[6], ab[7])}));
                NTST((v4u*)(recf + GREC_Q + off), ((v4u){pk2(qf_[0], qf_[1]), pk2(qf_[2], qf_[3]), pk2(qf_[4], qf_[5]), pk2(qf_[6], qf_[7])}));
                NTST((v4u*)(recb + GREC_Q + off), ((v4u){pk2(qb_[0], qb_[1]), pk2(qb_[2], qb_[3]), pk2(qb_[4], qb_[5]), pk2(qb_[6], qb_[7])}));
                NTST((v4u*)(recf + GREC_K + off), ((v4u){pk2(kf_[0], kf_[1]), pk2(kf_[2], kf_[3]), pk2(kf_[4], kf_[5]), pk2(kf_[6], kf_[7])}));
                NTST((v4u*)(recb + GREC_K + off), ((v4u){pk2(kb_[0], kb_[1]), pk2(kb_[2], kb_[3]), pk2(kb_[4], kb_[5]), pk2(kb_[6], kb_[7])})); }
            if (tl == 0) { float* cd = (float*)(F.ws + WS_GCD); cd[((b * 8 + h) * 2 + 0) * 256 + n] = __expf(gfv[128 + 63]); cd[((b * 8 + h) * 2 + 1) * 256 + n] = __expf(gfv[192 + 0]); }
        }
        LDS_BARRIER();
    }
}

typedef float f32x4m __attribute__((ext_vector_type(4)));
constexpr int N_SCAN_WG = 64;
__device__ __forceinline__ void ph_gdn_scan(Frame& F) {
    if (F.bid >= N_SCAN_WG) return;
    constexpr int LB_U = 0, LB_W = 17408, LB_A = 17408 + 9216, LB_Q = 17408 + 2 * 9216, LB_K = 17408 + 3 * 9216, LBUF = 17408 + 4 * 9216;
    constexpr int L_ST = 2 * LBUF, L_VT = 2 * LBUF + 9216;
    const int chain = F.bid >> 1, vh = F.bid & 1, dir = chain & 1, h = (chain >> 1) & 7, b = chain >> 4;
    const int tid = F.tid, lane = F.lane, wave = F.wave, r = lane & 15, q = lane >> 4, mt = wave >> 1, nt = 2 * vh + (wave & 1);
    const unsigned char* recs = F.ws + WS_GREC + (size_t)chain * 256 * GREC_BYTES;
    const float* cdv = (const float*)(F.ws + WS_GCD) + chain * 256;
    bf16* od = (bf16*)(F.ws + (dir ? WS_OB : WS_OF));
    LAS unsigned char* lds = F.lds;
    v4u pre[3][5];
    const unsigned goff0 = (unsigned)((512 * vh + tid) * 16), goff1 = (unsigned)((1024 + tid) * 16);
    const int loff0 = LB_U + (32 * vh + (tid >> 4)) * 272 + (tid & 15) * 16, loff1 = LB_W + (tid >> 3) * 144 + (tid & 7) * 16;
#define GS_LOAD(s_, n_) do { const unsigned char* rp_ = recs + (size_t)(n_) * GREC_BYTES; asm volatile("global_load_dwordx4 %0, %1, off" : "=v"(pre[s_][0]) : "v"(rp_ + goff0) : "memory"); \
        _Pragma("unroll") for (int i_ = 1; i_ < 5; ++i_) asm volatile("global_load_dwordx4 %0, %1, off" : "=v"(pre[s_][i_]) : "v"(rp_ + goff1 + (size_t)(i_ - 1) * 8192) : "memory"); } while (0)
#define GS_WAIT(s_, N_) GS_WAIT2(s_, N_)
#define GS_WAIT2(s_, N_) asm volatile("s_waitcnt vmcnt(" #N_ ")" : "+v"(pre[s_][0]), "+v"(pre[s_][1]), "+v"(pre[s_][2]), "+v"(pre[s_][3]), "+v"(pre[s_][4]) :: "memory")
#define GS_STORE(s_, bufo_) do { *(LAS v4u*)(lds + (bufo_) + loff0) = pre[s_][0]; _Pragma("unroll") for (int i_ = 1; i_ < 5; ++i_) *(LAS v4u*)(lds + (bufo_) + loff1 + (i_ - 1) * 9216) = pre[s_][i_]; } while (0)
    for (int i = tid; i < 9216 / 4; i += NTHR) ((LAS unsigned*)(lds + L_ST))[i] = 0u;
    LAS float* lcd = (LAS float*)(lds + L_VT + 9216);
    if (tid < 256) lcd[tid] = cdv[tid];
    f32x4m Sacc = {0.f, 0.f, 0.f, 0.f};
    const int n_first = dir ? 255 : 0, n_step = dir ? -1 : 1;
    GS_LOAD(0, n_first); GS_WAIT(0, 0); GS_STORE(0, 0);
    GS_LOAD(1, n_first + n_step); GS_LOAD(2, n_first + 2 * n_step);
    __syncthreads();
#define GS_STEP(SL_NEXT, SL_FREE, WAITN) do { \
        const int n = n_first + it * n_step, bo = (it & 1) * LBUF, bn = ((it + 1) & 1) * LBUF; \
        if (it + 3 < 256) GS_LOAD(SL_FREE, n + 3 * n_step); \
        const float cd = lcd[n]; \
        bf16x8 aw[2], aq[2], bs[2]; \
        _Pragma("unroll") for (int ks = 0; ks < 2; ++ks) { aw[ks] = *(const LAS bf16x8*)(lds + bo + LB_W + (16 * mt + r) * 144 + ks * 64 + q * 16); aq[ks] = *(const LAS bf16x8*)(lds + bo + LB_Q + (16 * mt + r) * 144 + ks * 64 + q * 16); \
            bs[ks] = *(const LAS bf16x8*)(lds + L_ST + (16 * nt + r) * 144 + ks * 64 + q * 16); } \
        f32x4m vn = *(const LAS f32x4m*)(lds + bo + LB_U + (16 * nt + r) * 272 + (16 * mt + 4 * q) * 4), oa = (f32x4m){0.f, 0.f, 0.f, 0.f}; \
        _Pragma("unroll") for (int ks = 0; ks < 2; ++ks) { vn = __builtin_amdgcn_mfma_f32_16x16x32_bf16(aw[ks], bs[ks], vn, 0, 0, 0); oa = __builtin_amdgcn_mfma_f32_16x16x32_bf16(aq[ks], bs[ks], oa, 0, 0, 0); } \
        *(LAS v2u*)(lds + L_VT + (16 * nt + r) * 144 + (16 * mt + 4 * q) * 2) = (v2u){pk2(vn.x, vn.y), pk2(vn.z, vn.w)}; \
        LDS_BARRIER(); \
        bf16x8 aa[2], ak[2], bv[2]; \
        _Pragma("unroll") for (int ks = 0; ks < 2; ++ks) { aa[ks] = *(const LAS bf16x8*)(lds + bo + LB_A + (16 * mt + r) * 144 + ks * 64 + q * 16); ak[ks] = *(const LAS bf16x8*)(lds + bo + LB_K + (16 * mt + r) * 144 + ks * 64 + q * 16); \
            bv[ks] = *(const LAS bf16x8*)(lds + L_VT + (16 * nt + r) * 144 + ks * 64 + q * 16); } \
        Sacc = Sacc * cd; \
        _Pragma("unroll") for (int ks = 0; ks < 2; ++ks) { oa = __builtin_amdgcn_mfma_f32_16x16x32_bf16(aa[ks], bv[ks], oa, 0, 0, 0); Sacc = __builtin_amdgcn_mfma_f32_16x16x32_bf16(ak[ks], bv[ks], Sacc, 0, 0, 0); } \
          \
        if (it + 1 < 256) { GS_WAIT(SL_NEXT, WAITN); GS_STORE(SL_NEXT, bn); } \
        *(LAS v2u*)(lds + L_ST + (16 * nt + r) * 144 + (16 * mt + 4 * q) * 2) = (v2u){pk2(Sacc.x, Sacc.y), pk2(Sacc.z, Sacc.w)}; \
        { bf16* op = od + ((size_t)b * SEQ + n * 64 + 16 * mt + 4 * q) * 512 + h * 64 + 16 * nt + r; \
          op[0] = (bf16)f2bf(oa.x); op[512] = (bf16)f2bf(oa.y); op[1024] = (bf16)f2bf(oa.z); op[1536] = (bf16)f2bf(oa.w); } \
        LDS_BARRIER(); ++it; } while (0)
    int it = 0;
    GS_STEP(1, 0, 10); GS_STEP(2, 1, 14);
    for (; it < 251; ) { GS_STEP(0, 2, 18); GS_STEP(1, 0, 18); GS_STEP(2, 1, 18); }
    GS_STEP(0, 2, 18); GS_STEP(1, 0, 18);
    GS_STEP(2, 1, 0); GS_STEP(0, 2, 0); GS_STEP(1, 0, 0);
#undef GS_STEP
#undef GS_LOAD
#undef GS_STORE
#undef GS_WAIT
#undef GS_WAIT2
}

__device__ __forceinline__ void ph_gdn_fin(Frame& F, int l) {
    const int gw = F.bid * NWAVES + F.wave, NGW = F.G * NWAVES, lane = F.lane;
    const bf16* of = (const bf16*)(F.ws + WS_OF); const bf16* ob = (const bf16*)(F.ws + WS_OB);
    const bf16* proj = (const bf16*)(F.ws + WS_P); bf16* y = (bf16*)(F.ws + WS_Y);
    const float* gnp = INP(I_GDN_NORM) + l * 64 + (lane & 7) * 8;
    const f32x4 g0 = *(const f32x4*)gnp, g1 = *(const f32x4*)(gnp + 4);
    const float gn[8] = {g0.x, g0.y, g0.z, g0.w, g1.x, g1.y, g1.z, g1.w};
    for (int m = gw; m < T; m += NGW) {
        const v4u a = *(const v4u*)(of + (size_t)m * 512 + lane * 8), c = *(const v4u*)(ob + (size_t)m * 512 + lane * 8), zz = *(const v4u*)(proj + (size_t)m * DINP + C_AZ + lane * 8);
        const float o[8] = {bflo(a.x) + bflo(c.x), bfhi(a.x) + bfhi(c.x), bflo(a.y) + bflo(c.y), bfhi(a.y) + bfhi(c.y), bflo(a.z) + bflo(c.z), bfhi(a.z) + bfhi(c.z), bflo(a.w) + bflo(c.w), bfhi(a.w) + bfhi(c.w)};
        const float z[8] = {bflo(zz.x), bfhi(zz.x), bflo(zz.y), bfhi(zz.y), bflo(zz.z), bfhi(zz.z), bflo(zz.w), bfhi(zz.w)};
        float ss = 0.f;
#pragma unroll
        for (int i = 0; i < 8; ++i) ss += o[i] * o[i];
        ss += __shfl_xor(ss, 1); ss += __shfl_xor(ss, 2); ss += __shfl_xor(ss, 4);
        const float r_ = 1.0f / sqrtf(ss * (1.0f / 64.0f) + EPS);
        float v[8];
#pragma unroll
        for (int i = 0; i < 8; ++i) v[i] = o[i] * r_ * gn[i] * (z[i] * __builtin_amdgcn_rcpf(1.0f + __expf(-z[i])));
        NTST((v4u*)(y + (size_t)m * D + lane * 8), ((v4u){pk2(v[0], v[1]), pk2(v[2], v[3]), pk2(v[4], v[5]), pk2(v[6], v[7])}));
    }
}

__device__ __forceinline__ void ph_hy_mlp(Frame& F, int l) {
    LAS float* zf = (LAS float*)F.lds;
    LAS float* h1 = (LAS float*)(F.lds + 16384);
    const float* w1 = INP(I_HY_W1) + (size_t)l * 33 * 64; const float* b1 = INP(I_HY_B1) + l * 64; const float* f1 = INP(I_HY_F1) + l * 64;
    const float* w2 = INP(I_HY_W2) + (size_t)l * 64 * 64; const float* b2 = INP(I_HY_B2) + l * 64; const float* f2 = INP(I_HY_F2) + l * 64;
    bf16* h2b = (bf16*)(F.ws + WS_H2T + (size_t)l * 2 * MiB);
    const int tid = F.tid, tl = tid & 63, jg = tid >> 6;
    for (int it = F.bid; it < FL / 64; it += F.G) {
        const int t0 = it * 64;
        for (int e = tid; e < 64 * 33; e += NTHR) { const int p = e / 33, f = e % 33, t = t0 + p; float val;
            if (f == 0) val = (float)t / (float)(FL - 1);
            else { const int i = (f - 1) & 15; const float fi = 1e-4f + (float)i * ((15.0f - 1e-4f) / 15.0f); const float w = 6.283185307179586f * (float)t / (float)FL; const float a = w * fi;
                   const float ar = a * 0.15915494309189535f; val = (f <= 16) ? __builtin_amdgcn_cosf(ar) : -__builtin_amdgcn_sinf(ar); }
            zf[p * 33 + f] = val; }
        __syncthreads();
#pragma unroll
        for (int jj = 0; jj < 8; ++jj) { const int j = jg * 8 + jj; float acc = b1[j];
            for (int i = 0; i < 33; ++i) acc += zf[tl * 33 + i] * w1[i * 64 + j];
            h1[tl * 65 + j] = __builtin_amdgcn_sinf(f1[j] * acc * 0.15915494309189535f); }
        __syncthreads();
#pragma unroll
        for (int jj = 0; jj < 8; ++jj) { const int j = jg * 8 + jj; float acc = b2[j];
            for (int i = 0; i < 64; ++i) acc += h1[tl * 65 + i] * w2[i * 64 + j];
            h2b[(size_t)(t0 + tl) * 64 + j] = (bf16)f2bf(__builtin_amdgcn_sinf(f2[j] * acc * 0.15915494309189535f)); }
        __syncthreads();
    }
}

__device__ __forceinline__ void ph_hy_expand(Frame& F, int l) {
    const bf16* h2b = (const bf16*)(F.ws + WS_H2T + (size_t)l * 2 * MiB); bf16* hT = (bf16*)(F.ws + WS_HT);
    const float* w3 = INP(I_HY_W3) + (size_t)l * 64 * 2048; const float* dl = INP(I_HY_DELTAS) + (size_t)l * 2048;
    const int gw = F.bid * NWAVES + F.wave, NGW = F.G * NWAVES, lane = F.lane, r32 = lane & 31, hi = lane >> 5;
    for (int task = gw; task < 64 * 64; task += NGW) {
        const int jt = task >> 6, tg = task & 63, j0 = jt * 32;
        bf16x8 af[4];
#pragma unroll
        for (int s = 0; s < 4; ++s) { float w[8];
#pragma unroll
            for (int i = 0; i < 8; ++i) w[i] = w3[(size_t)(16 * s + 8 * hi + i) * 2048 + j0 + r32];
            af[s] = __builtin_bit_cast(bf16x8, (v4u){pk2(w[0], w[1]), pk2(w[2], w[3]), pk2(w[4], w[5]), pk2(w[6], w[7])}); }
        float ad[16];
#pragma unroll
        for (int rg = 0; rg < 16; ++rg) ad[rg] = fabsf(dl[j0 + crow(rg, hi)]);
        for (int tt = 0; tt < 8; ++tt) {
            const int t0 = (tg * 8 + tt) * 32, t = t0 + r32;
            f32x16 acc = {0};
#pragma unroll
            for (int s = 0; s < 4; ++s) { const bf16x8 bfr = *(const bf16x8*)(h2b + (size_t)t * 64 + 16 * s + 8 * hi); acc = __builtin_amdgcn_mfma_f32_32x32x16_bf16(af[s], bfr, acc, 0, 0, 0); }
            const float tn = (float)t / (float)(FL - 1);
#pragma unroll
            for (int rg = 0; rg < 16; ++rg) hT[(size_t)(j0 + crow(rg, hi)) * FL + t] = (bf16)f2bf(acc[rg] * __expf(-tn * ad[rg]));
        }
    }
}

__device__ __forceinline__ void ph_hy_tin(Frame& F, int l) {
    LAS float* tile = (LAS float*)F.lds;
    const bf16* proj = (const bf16*)(F.ws + WS_P); bf16* uT = (bf16*)(F.ws + WS_UT);
    const float* cw = INP(I_HY_CONV) + (size_t)l * 3 * 1536;
    const int tid = F.tid;
    for (int it = F.bid; it < 2 * 256 * 24; it += F.G) {
        const int b = it / (256 * 24), r = it % (256 * 24), tt = r / 24, ct = r % 24, t0 = tt * 64, c0 = ct * 64;
        for (int e = tid; e < 66 * 8; e += NTHR) { const int row = e >> 3, ck = e & 7, t = t0 - 1 + row;
            v4u w = (v4u){0u, 0u, 0u, 0u};
            if (t >= 0 && t < SEQ) w = *(const v4u*)(proj + ((size_t)b * SEQ + t) * DINP + C_B + c0 + ck * 8);
            LAS float* d = tile + row * 65 + ck * 8;
            d[0] = bflo(w.x); d[1] = bfhi(w.x); d[2] = bflo(w.y); d[3] = bfhi(w.y); d[4] = bflo(w.z); d[5] = bfhi(w.z); d[6] = bflo(w.w); d[7] = bfhi(w.w); }
        __syncthreads();
        { const int chl = tid >> 3, tq = tid & 7, ch = c0 + chl; const float w0 = cw[ch], w1 = cw[1536 + ch], w2 = cw[3072 + ch];
          float v[8];
#pragma unroll
          for (int i = 0; i < 8; ++i) { const int tl = tq * 8 + i; v[i] = w0 * tile[tl * 65 + chl] + w1 * tile[(tl + 1) * 65 + chl] + w2 * tile[(tl + 2) * 65 + chl]; }
          v4u o; o.x = pk2(v[0], v[1]); o.y = pk2(v[2], v[3]); o.z = pk2(v[4], v[5]); o.w = pk2(v[6], v[7]);
          NTST((v4u*)(uT + ((size_t)b * 1536 + ch) * SEQ + t0 + tq * 8), o); }
        __syncthreads();
    }
}

#define FA(i) ((i) + (((i) >> 6) << 2))
__device__ __forceinline__ f32x2 cmul(f32x2 a, f32x2 b) { return (f32x2){a.x * b.x - a.y * b.y, a.x * b.y + a.y * b.x}; }
template <int K> __device__ __forceinline__ f32x2 cmul16(f32x2 a, bool conj) {
    constexpr float c16[8] = {1.000000000f, 0.923879533f, 0.707106781f, 0.382683432f, 0.000000000f, -0.382683432f, -0.707106781f, -0.923879533f}, s16[8] = {0.000000000f, 0.382683432f, 0.707106781f, 0.923879533f, 1.000000000f, 0.923879533f, 0.707106781f, 0.382683432f};
    const float c = c16[K], sn = conj ? s16[K] : -s16[K];
    if (K == 0) return a;
    if (K == 4) return conj ? (f32x2){-a.y, a.x} : (f32x2){a.y, -a.x};
    return (f32x2){a.x * c - a.y * sn, a.x * sn + a.y * c};
}
__device__ __forceinline__ f32x2 cmul_pk1(f32x2 a, f32x2 b) {
    f32x2 t, d;
    asm("v_pk_mul_f32 %0, %2, %3 op_sel_hi:[0,1]\n\ts_nop 0\n\tv_pk_fma_f32 %1, %2, %3, %0 op_sel:[1,1,0] op_sel_hi:[1,0,1] neg_lo:[0,1,0]" : "=&v"(t), "=&v"(d) : "v"(a), "v"(b));
    return d;
}
__device__ __forceinline__ void cmul_pk2(f32x2 a1, f32x2 b1, f32x2 a2, f32x2 b2, f32x2& d1, f32x2& d2) {
    f32x2 t1, t2;
    asm("v_pk_mul_f32 %0, %4, %5 op_sel_hi:[0,1]\n\tv_pk_mul_f32 %1, %6, %7 op_sel_hi:[0,1]\n\t"
        "v_pk_fma_f32 %2, %4, %5, %0 op_sel:[1,1,0] op_sel_hi:[1,0,1] neg_lo:[0,1,0]\n\tv_pk_fma_f32 %3, %6, %7, %1 op_sel:[1,1,0] op_sel_hi:[1,0,1] neg_lo:[0,1,0]"
        : "=&v"(t1), "=&v"(t2), "=&v"(d1), "=&v"(d2) : "v"(a1), "v"(b1), "v"(a2), "v"(b2));
}
template <int SP, bool INV> __device__ __forceinline__ void fft_r16_pass(LAS f32x2* Z, int tid) {
    constexpr int STR = (SP >= 64) ? (SP + SP / 16) : SP;
#pragma unroll
    for (int g = 0; g < 2; ++g) {
        const int grp = tid + NTHR * g, p = grp & (SP - 1), i0 = (grp / SP) * (16 * SP) + p;
        LAS f32x2* zb = Z + FA(i0);
        f32x2 e[16];
#pragma unroll
        for (int k = 0; k < 16; ++k) e[k] = zb[k * STR];
        const float fr = (float)p * (1.0f / (16.0f * (float)SP));
        const f32x2 w1 = (f32x2){__builtin_amdgcn_cosf(fr), INV ? __builtin_amdgcn_sinf(fr) : -__builtin_amdgcn_sinf(fr)};
        const f32x2 W16 = (f32x2){0.923879533f, INV ? 0.382683432f : -0.382683432f};
        f32x2 t1[8], t2[4], t3[2], t4;
        t1[0] = w1; t1[1] = cmul_pk1(w1, W16);
        cmul_pk2(t1[1], W16, t1[1], t1[1], t1[2], t2[1]);
        cmul_pk2(t1[2], W16, w1, w1, t1[3], t2[0]);
        cmul_pk2(t1[3], W16, t1[2], t1[2], t1[4], t2[2]);
        cmul_pk2(t1[4], W16, t1[3], t1[3], t1[5], t2[3]);
        cmul_pk2(t1[5], W16, t2[0], t2[0], t1[6], t3[0]);
        cmul_pk2(t1[6], W16, t2[1], t2[1], t1[7], t3[1]);
        t4 = cmul_pk1(t3[0], t3[0]);
#define R16_BF2(a1_, b1_, T1, a2_, b2_, T2) do { if (!INV) { const f32x2 s1_ = e[a1_] + e[b1_], d1_ = e[a1_] - e[b1_], s2_ = e[a2_] + e[b2_], d2_ = e[a2_] - e[b2_]; e[a1_] = s1_; e[a2_] = s2_; cmul_pk2(d1_, T1, d2_, T2, e[b1_], e[b2_]); } \
                                               else { f32x2 u1_, u2_; cmul_pk2(e[b1_], T1, e[b2_], T2, u1_, u2_); e[b1_] = e[a1_] - u1_; e[a1_] = e[a1_] + u1_; e[b2_] = e[a2_] - u2_; e[a2_] = e[a2_] + u2_; } } while (0)
#define R16_ST1() do { R16_BF2(0, 8, t1[0], 1, 9, t1[1]); R16_BF2(2, 10, t1[2], 3, 11, t1[3]); R16_BF2(4, 12, t1[4], 5, 13, t1[5]); R16_BF2(6, 14, t1[6], 7, 15, t1[7]); } while (0)
#define R16_ST2() do { R16_BF2(0, 4, t2[0], 8, 12, t2[0]); R16_BF2(1, 5, t2[1], 9, 13, t2[1]); R16_BF2(2, 6, t2[2], 10, 14, t2[2]); R16_BF2(3, 7, t2[3], 11, 15, t2[3]); } while (0)
#define R16_ST3() do { R16_BF2(0, 2, t3[0], 4, 6, t3[0]); R16_BF2(8, 10, t3[0], 12, 14, t3[0]); R16_BF2(1, 3, t3[1], 5, 7, t3[1]); R16_BF2(9, 11, t3[1], 13, 15, t3[1]); } while (0)
#define R16_ST4() do { R16_BF2(0, 1, t4, 2, 3, t4); R16_BF2(4, 5, t4, 6, 7, t4); R16_BF2(8, 9, t4, 10, 11, t4); R16_BF2(12, 13, t4, 14, 15, t4); } while (0)
        if (!INV) { R16_ST1(); R16_ST2(); R16_ST3(); R16_ST4(); } else { R16_ST4(); R16_ST3(); R16_ST2(); R16_ST1(); }
#undef R16_BF2
#undef R16_ST1
#undef R16_ST2
#undef R16_ST3
#undef R16_ST4
#pragma unroll
        for (int k = 0; k < 16; ++k) zb[k * STR] = e[k];
    }
    __syncthreads();
}
template <bool INV> __device__ __forceinline__ void fft_r4_pass(LAS f32x2* Z, int tid) {
#pragma unroll 4
    for (int g = 0; g < 8; ++g) {
        const int i0 = (tid + NTHR * g) * 4;
        LAS f32x4* zp = (LAS f32x4*)(Z + FA(i0));
        const f32x4 u = zp[0], v = zp[1];
        const f32x2 e0 = (f32x2){u.x, u.y}, e1 = (f32x2){u.z, u.w}, e2 = (f32x2){v.x, v.y}, e3 = (f32x2){v.z, v.w};
        f32x2 r0, r1, r2, r3;
        if (!INV) { const f32x2 a0 = e0 + e2, a2 = e0 - e2, a1 = e1 + e3, d = e1 - e3; const f32x2 a3 = (f32x2){d.y, -d.x};
                    r0 = a0 + a1; r1 = a0 - a1; r2 = a2 + a3; r3 = a2 - a3; }
        else { const f32x2 s0 = e0 + e1, s1 = e0 - e1, s2 = e2 + e3, s3 = e2 - e3; const f32x2 c = (f32x2){-s3.y, s3.x};
               r0 = s0 + s2; r2 = s0 - s2; r1 = s1 + c; r3 = s1 - c; }
        zp[0] = (f32x4){r0.x, r0.y, r1.x, r1.y}; zp[1] = (f32x4){r2.x, r2.y, r3.x, r3.y};
    }
    __syncthreads();
}
__device__ __forceinline__ void fft_fwd(LAS f32x2* Z, int tid) { fft_r16_pass<1024, false>(Z, tid); fft_r16_pass<64, false>(Z, tid); fft_r16_pass<4, false>(Z, tid); fft_r4_pass<false>(Z, tid); }
__device__ __forceinline__ void fft_inv(LAS f32x2* Z, int tid) { fft_r4_pass<true>(Z, tid); fft_r16_pass<4, true>(Z, tid); fft_r16_pass<64, true>(Z, tid); fft_r16_pass<1024, true>(Z, tid); }
__device__ __forceinline__ void ld8bf(const bf16* p, float (&v)[8]) { const v4u w = *(const v4u*)p; v[0] = bflo(w.x); v[1] = bfhi(w.x); v[2] = bflo(w.y); v[3] = bfhi(w.y); v[4] = bflo(w.z); v[5] = bfhi(w.z); v[6] = bflo(w.w); v[7] = bfhi(w.w); }
__device__ __forceinline__ void ph_hy_fft(Frame& F, int l) {
    LAS f32x2* Z = (LAS f32x2*)F.lds;
    volatile LAS float* red = (volatile LAS float*)(F.lds + MISC_OFF + 64);
    const bf16* hT = (const bf16*)(F.ws + WS_HT);
    const bf16* uT = (const bf16*)(F.ws + WS_UT); float* yT = (float*)(F.ws + WS_YT);
    f32x2* scr = (f32x2*)(F.ws + WS_FSCR) + (size_t)F.bid * (4 * FL);
    f32x2* KE = scr; f32x2* KO = scr + FL; f32x2* R1 = scr + 2 * FL; f32x2* Y0 = scr + 3 * FL;
    const int tid = F.tid;
#define FQ_LOOP _Pragma("unroll 2") for (int q = 0; q < 4; ++q)
#define FQ_IDX const int ck = tid + NTHR * q, n0 = 8 * ck; LAS f32x4* z4 = (LAS f32x4*)(Z + FA(n0))
    for (int c = F.bid; c < 512; c += F.G) {
        for (int o = 0; o < 2; ++o) {
            const bf16* hf = hT + (size_t)((o * 2 + 0) * 512 + c) * FL; const bf16* hb = hT + (size_t)((o * 2 + 1) * 512 + c) * FL;
            const float bias = INP(I_HY_BIAS)[(l * 2 + o) * 512 + c];
            const bf16* v0 = uT + ((size_t)0 * 1536 + 1024 + c) * SEQ; const bf16* v1 = uT + ((size_t)1 * 1536 + 1024 + c) * SEQ;
#define FQ_LOADZ(zz) f32x4 zz[4]; if (o == 0) { float p0_[8], p1_[8]; ld8bf(v0 + n0, p0_); ld8bf(v1 + n0, p1_); _Pragma("unroll") for (int jj = 0; jj < 4; ++jj) zz[jj] = (f32x4){p0_[2 * jj], p1_[2 * jj], p0_[2 * jj + 1], p1_[2 * jj + 1]}; } \
                     else { const f32x4* y4_ = (const f32x4*)(Y0 + n0); _Pragma("unroll") for (int jj = 0; jj < 4; ++jj) zz[jj] = y4_[jj]; }
            float sc = 0.f;
#pragma nounroll
            for (int k = 0; k < 6; ++k) {
                if (k == 0) {
                    float part = 0.f;
                    FQ_LOOP { FQ_IDX; float a[8], bch[8], br[8]; ld8bf(hf + n0, a); ld8bf(hb + (FL - 8 - n0), bch);
                        br[0] = (ck >= 1) ? bf2f(hb[FL - n0]) : 0.f;
#pragma unroll
                        for (int j = 1; j < 8; ++j) br[j] = bch[8 - j];
#pragma unroll
                        for (int j = 0; j < 8; ++j) part += fabsf(a[j]) + fabsf(br[j]);
#pragma unroll
                        for (int jj = 0; jj < 4; ++jj) z4[jj] = (f32x4){a[2 * jj] + br[2 * jj], 0.f, a[2 * jj + 1] + br[2 * jj + 1], 0.f}; }
                    part = wave_sum(part);
                    if (F.lane == 0) red[F.wave] = part;
                    __syncthreads();
                    float nrm = 0.f;
#pragma unroll
                    for (int w = 0; w < NWAVES; ++w) nrm += red[w];
                    sc = 1.0f / (2.0f * (float)FL * (nrm + EPS));
                } else if (k == 1) {
                    FQ_LOOP { FQ_IDX; f32x4* k4 = (f32x4*)(KE + n0); float a[8], bch[8], br[8]; ld8bf(hf + n0, a); ld8bf(hb + (FL - 8 - n0), bch);
                        br[0] = (ck >= 1) ? bf2f(hb[FL - n0]) : 0.f;
#pragma unroll
                        for (int j = 1; j < 8; ++j) br[j] = bch[8 - j];
#pragma unroll
                        for (int jj = 0; jj < 4; ++jj) { k4[jj] = z4[jj];
                            const float d0 = a[2 * jj] - br[2 * jj], d1 = a[2 * jj + 1] - br[2 * jj + 1]; const float f0 = (float)(n0 + 2 * jj) * (0.5f / (float)FL), f1 = (float)(n0 + 2 * jj + 1) * (0.5f / (float)FL);
                            z4[jj] = (f32x4){d0 * __builtin_amdgcn_cosf(f0), -d0 * __builtin_amdgcn_sinf(f0), d1 * __builtin_amdgcn_cosf(f1), -d1 * __builtin_amdgcn_sinf(f1)}; } }
                } else if (k == 2) {
                    FQ_LOOP { FQ_IDX; f32x4* k4 = (f32x4*)(KO + n0); FQ_LOADZ(zv);
#pragma unroll
                        for (int jj = 0; jj < 4; ++jj) { k4[jj] = z4[jj]; z4[jj] = zv[jj]; } }
                } else if (k == 3 || k == 5) {
                    const f32x2* KX = (k == 3) ? KE : KO;
                    FQ_LOOP { FQ_IDX; const f32x4* k4 = (const f32x4*)(KX + n0);
#pragma unroll
                        for (int jj = 0; jj < 4; ++jj) { const f32x4 a = z4[jj], kk = k4[jj]; z4[jj] = (f32x4){a.x * kk.x - a.y * kk.y, a.x * kk.y + a.y * kk.x, a.z * kk.z - a.w * kk.w, a.z * kk.w + a.w * kk.z}; } }
                } else {
                    FQ_LOOP { FQ_IDX; f32x4* r4 = (f32x4*)(R1 + n0); FQ_LOADZ(zv);
#pragma unroll
                        for (int jj = 0; jj < 4; ++jj) { r4[jj] = z4[jj]; const float f0 = (float)(n0 + 2 * jj) * (0.5f / (float)FL), f1 = (float)(n0 + 2 * jj + 1) * (0.5f / (float)FL);
                            const float c0 = __builtin_amdgcn_cosf(f0), s0 = -__builtin_amdgcn_sinf(f0), c1 = __builtin_amdgcn_cosf(f1), s1 = -__builtin_amdgcn_sinf(f1); const f32x4 z = zv[jj];
                            z4[jj] = (f32x4){z.x * c0 - z.y * s0, z.x * s0 + z.y * c0, z.z * c1 - z.w * s1, z.z * s1 + z.w * c1}; } }
                }
                __syncthreads();
                if (k == 3 || k == 5) fft_inv(Z, tid); else fft_fwd(Z, tid);
            }
            const bf16* x0 = uT + ((size_t)0 * 1536 + o * 512 + c) * SEQ; const bf16* x1 = uT + ((size_t)1 * 1536 + o * 512 + c) * SEQ;
            FQ_LOOP { FQ_IDX; FQ_LOADZ(zv); float g0[8], g1[8]; ld8bf(x0 + n0, g0); ld8bf(x1 + n0, g1); const f32x4* r4 = (const f32x4*)(R1 + n0);
                f32x4 ov[4];
#pragma unroll
                for (int jj = 0; jj < 4; ++jj) { const float f0 = (float)(n0 + 2 * jj) * (0.5f / (float)FL), f1 = (float)(n0 + 2 * jj + 1) * (0.5f / (float)FL);
                    const float c0 = __builtin_amdgcn_cosf(f0), s0 = __builtin_amdgcn_sinf(f0), c1 = __builtin_amdgcn_cosf(f1), s1 = __builtin_amdgcn_sinf(f1);
                    const f32x4 r2 = z4[jj], r1 = r4[jj], z = zv[jj];
                    const float ax = (r1.x + (r2.x * c0 - r2.y * s0)) * sc, ay = (r1.y + (r2.x * s0 + r2.y * c0)) * sc, bx = (r1.z + (r2.z * c1 - r2.w * s1)) * sc, by = (r1.w + (r2.z * s1 + r2.w * c1)) * sc;
                    ov[jj] = (f32x4){g0[2 * jj] * (ax + z.x * bias), g1[2 * jj] * (ay + z.y * bias), g0[2 * jj + 1] * (bx + z.z * bias), g1[2 * jj + 1] * (by + z.w * bias)}; }
                if (o == 0) { f32x4* y4 = (f32x4*)(Y0 + n0);
#pragma unroll
                    for (int jj = 0; jj < 4; ++jj) y4[jj] = ov[jj]; }
                else { f32x4* ya = (f32x4*)(yT + ((size_t)0 * 512 + c) * SEQ + n0); f32x4* yb = (f32x4*)(yT + ((size_t)1 * 512 + c) * SEQ + n0);
                    NTST(ya, ((f32x4){ov[0].x, ov[0].z, ov[1].x, ov[1].z})); NTST(ya + 1, ((f32x4){ov[2].x, ov[2].z, ov[3].x, ov[3].z}));
                    NTST(yb, ((f32x4){ov[0].y, ov[0].w, ov[1].y, ov[1].w})); NTST(yb + 1, ((f32x4){ov[2].y, ov[2].w, ov[3].y, ov[3].w})); } }
            __syncthreads();
        }
    }
#undef FQ_LOOP
#undef FQ_IDX
#undef FQ_LOADZ
}

__device__ __forceinline__ void ph_hy_fin(Frame& F, int l) {
    LAS float* tile = (LAS float*)F.lds;
    const float* yT = (const float*)(F.ws + WS_YT); bf16* y = (bf16*)(F.ws + WS_Y);
    const float* hn = INP(I_HY_NORM) + l * 512;
    const int tid = F.tid, lane = F.lane;
    for (int it = F.bid; it < 2 * 512; it += F.G) {
        const int b = it >> 9, t0 = (it & 511) * 32;
        for (int e = tid; e < 512 * 8; e += NTHR) { const int ch = e >> 3, q = e & 7; const f32x4 v = *(const f32x4*)(yT + ((size_t)b * 512 + ch) * SEQ + t0 + q * 4);
            LAS float* d = tile + ch * 33 + q * 4; d[0] = v.x; d[1] = v.y; d[2] = v.z; d[3] = v.w; }
        __syncthreads();
#pragma unroll
        for (int k = 0; k < 4; ++k) { const int tl = F.wave * 4 + k; float v[8]; float ss = 0.f;
#pragma unroll
            for (int i = 0; i < 8; ++i) { v[i] = tile[(lane + 64 * i) * 33 + tl]; ss += v[i] * v[i]; }
            const float r = 1.0f / sqrtf(wave_sum(ss) * (1.0f / 512.0f) + EPS);
            bf16* yr = y + ((size_t)b * SEQ + t0 + tl) * D + 512;
#pragma unroll
            for (int i = 0; i < 8; ++i) yr[lane + 64 * i] = (bf16)f2bf(v[i] * r * hn[lane + 64 * i]); }
        __syncthreads();
    }
}

__device__ __forceinline__ void ph_at_prep(Frame& F, int l) {
    const int gw = F.bid * NWAVES + F.wave, NGW = F.G * NWAVES, lane = F.lane;
    const bf16* proj = (const bf16*)(F.ws + WS_P);
    bf16* Qp = (bf16*)(F.ws + WS_QP); bf16* Kp = (bf16*)(F.ws + WS_KP); bf16* VtC = (bf16*)(F.ws + WS_VTC); bf16* Vp = (bf16*)(F.ws + WS_VP);
    const int j = lane & 7, half = j >> 2, second = (j >> 1) & 1;
    float invf[8], qg[8], kg[8];
#pragma unroll
    for (int e = 0; e < 8; ++e) { invf[e] = exp2f(-(float)(8 * (j & 1) + e) * (1.0f / 16.0f) * 13.287712379549449f) * 0.15915494309189535f;
        qg[e] = INP(I_GA_QN)[l * 64 + 8 * j + e]; kg[e] = INP(I_GA_KN)[l * 64 + 8 * j + e]; }
#define AP_ROW(w_, gain_, scale_, dst_, pos_) do { const float x_[8] = {bflo(w_.x), bfhi(w_.x), bflo(w_.y), bfhi(w_.y), bflo(w_.z), bfhi(w_.z), bflo(w_.w), bfhi(w_.w)}; \
        float ss_ = 0.f; _Pragma("unroll") for (int e = 0; e < 8; ++e) ss_ += x_[e] * x_[e]; \
        ss_ += __shfl_xor(ss_, 1); ss_ += __shfl_xor(ss_, 2); ss_ += __shfl_xor(ss_, 4); \
        const float r_ = 1.0f / sqrtf(ss_ * (1.0f / 64.0f) + EPS); float o_[8]; \
        _Pragma("unroll") for (int e = 0; e < 8; ++e) { const float xn_ = x_[e] * r_ * gain_[e], other_ = __shfl_xor(xn_, 2), rev_ = (pos_) * invf[e]; \
            const float sn_ = __builtin_amdgcn_sinf(rev_), cs_ = __builtin_amdgcn_cosf(rev_); o_[e] = (second ? (xn_ * cs_ + other_ * sn_) : (xn_ * cs_ - other_ * sn_)) * (scale_); } \
        NTST((v4u*)(dst_), ((v4u){pk2(o_[0], o_[1]), pk2(o_[2], o_[3]), pk2(o_[4], o_[5]), pk2(o_[6], o_[7])})); } while (0)
    for (int m = gw; m < T; m += NGW) {
        const int t = m % SEQ; const float pos = (float)(half ? (t & 63) : (t >> 6));
        const v4u w = *(const v4u*)(proj + (size_t)m * DINP + C_DQ + lane * 8);
        AP_ROW(w, qg, C2, Qp + (size_t)m * 512 + lane * 8, pos);
    }
    for (int m4 = gw * 4; m4 < T; m4 += NGW * 4) {
        const int m = m4 + (lane >> 4), hh = (lane >> 3) & 1, t = m % SEQ; const float pos = (float)(half ? (t & 63) : (t >> 6));
        const bf16* pr = proj + (size_t)m * DINP + C_DKV + hh * 64 + j * 8;
        const v4u w = *(const v4u*)pr, vv = *(const v4u*)(pr + 128);
        AP_ROW(w, kg, 1.0f, Kp + (size_t)m * 128 + hh * 64 + j * 8, pos);
        NTST((v4u*)(Vp + (size_t)m * 128 + hh * 64 + j * 8), vv);
    }
#undef AP_ROW
    for (int u = gw; u < 2 * 2 * 256; u += NGW) {
        const int b = u >> 9, kh = (u >> 8) & 1, t = (u & 255) * 64 + lane;
        const v4u* src = (const v4u*)(proj + ((size_t)b * SEQ + t) * DINP + C_CKV + 128 + kh * 64);
        const int kq = t & 15, tp = (t & ~15) | (8 * ((kq >> 2) & 1) + 4 * (kq >> 3) + (kq & 3));
        bf16* dst = VtC + (size_t)(b * 2 + kh) * 64 * SEQ + tp;
#pragma unroll
        for (int i = 0; i < 8; ++i) { const v4u w = src[i]; const unsigned ww[4] = {w.x, w.y, w.z, w.w};
#pragma unroll
            for (int k = 0; k < 4; ++k) { dst[(size_t)(8 * i + 2 * k) * SEQ] = (bf16)(ww[k] & 0xffffu); dst[(size_t)(8 * i + 2 * k + 1) * SEQ] = (bf16)(ww[k] >> 16); } }
    }
}
template <bool SWA>
__device__ __forceinline__ void attn_wave(const bf16* Q, int qpitch, const bf16* K, int kpitch, const bf16* Vt, bf16* O, int q0, int lane, float slope2, float sink2, float qscale) {
    const int r32 = lane & 31, hi = lane >> 5;
    bf16x8 qf[4];
#pragma unroll
    for (int s = 0; s < 4; ++s) qf[s] = *(const bf16x8*)(Q + (size_t)(q0 + r32) * qpitch + 16 * s + 8 * hi);
    f32x16 o0 = {0}, o1 = {0};
    float m_run = -1e30f, l_run = 0.f;
    int kt_lo, kt_hi;
    if (SWA) { kt_lo = (q0 - 128) / 32; if (kt_lo < 0) kt_lo = 0; kt_hi = (q0 + 31 + 128) / 32; if (kt_hi > SEQ / 32 - 1) kt_hi = SEQ / 32 - 1; }
    else { kt_lo = 0; kt_hi = SEQ / 32 - 1; }
    const int qpos = q0 + r32;
    for (int kt = kt_lo; kt <= kt_hi; ++kt) {
        const int k0 = kt * 32;
        f32x16 st = {0};
#pragma unroll
        for (int s = 0; s < 4; ++s) { const bf16x8 kf = *(const bf16x8*)(K + (size_t)(k0 + r32) * kpitch + 16 * s + 8 * hi);
            st = __builtin_amdgcn_mfma_f32_32x32x16_bf16(kf, qf[s], st, 0, 0, 0); }
        float mx = -1e30f;
        const bool edge = SWA && (k0 < q0 - 96 || k0 > q0 + 96);
        const float fqk = (float)(qpos - k0 - 4 * hi);
#pragma unroll
        for (int r = 0; r < 16; ++r) {
            float v = st[r];
            if (SWA) { const float td = __builtin_fabsf(fqk - (float)((r & 3) + 8 * (r >> 2))); v = __builtin_fmaf(v, qscale, -slope2 * td); if (edge && td > 128.f) v = -1e30f; }
            st[r] = v; mx = fmaxf(mx, v);
        }
        mx = fmaxf(mx, __shfl_xor(mx, 32));
        const float m_new = fmaxf(m_run, mx);
        const float alpha = __builtin_amdgcn_exp2f(m_run - m_new);
        float rs = 0.f;
#pragma unroll
        for (int r = 0; r < 16; ++r) { const float p = __builtin_amdgcn_exp2f(st[r] - m_new); st[r] = p; rs += p; }
        rs += __shfl_xor(rs, 32);
        l_run = l_run * alpha + rs; m_run = m_new;
#pragma unroll
        for (int r = 0; r < 16; ++r) { o0[r] *= alpha; o1[r] *= alpha; }
#pragma unroll
        for (int s = 0; s < 2; ++s) {
            v4u pw; pw.x = pk2(st[8 * s + 0], st[8 * s + 1]); pw.y = pk2(st[8 * s + 2], st[8 * s + 3]); pw.z = pk2(st[8 * s + 4], st[8 * s + 5]); pw.w = pk2(st[8 * s + 6], st[8 * s + 7]);
            const bf16x8 pf = __builtin_bit_cast(bf16x8, pw);
#pragma unroll
            for (int db = 0; db < 2; ++db) {
                const bf16x8 vf = *(const bf16x8*)(Vt + (size_t)(db * 32 + r32) * SEQ + k0 + 16 * s + 8 * hi);
                if (db == 0) o0 = __builtin_amdgcn_mfma_f32_32x32x16_bf16(vf, pf, o0, 0, 0, 0);
                else o1 = __builtin_amdgcn_mfma_f32_32x32x16_bf16(vf, pf, o1, 0, 0, 0);
            }
        }
    }
    float den = l_run;
    if (SWA) den += exp2f(sink2 - m_run);
    const float inv = 1.0f / den;
    bf16* orow = O + (size_t)(q0 + r32) * 512;
#pragma unroll
    for (int g = 0; g < 4; ++g) {
        v2u w0, w1;
        w0.x = pk2(o0[4 * g] * inv, o0[4 * g + 1] * inv); w0.y = pk2(o0[4 * g + 2] * inv, o0[4 * g + 3] * inv);
        w1.x = pk2(o1[4 * g] * inv, o1[4 * g + 1] * inv); w1.y = pk2(o1[4 * g + 2] * inv, o1[4 * g + 3] * inv);
        *(v2u*)(orow + 8 * g + 4 * hi) = w0; *(v2u*)(orow + 32 + 8 * g + 4 * hi) = w1;
    }
}
__device__ __forceinline__ void ph_at_global(Frame& F, int l) {
    typedef attn_body::bf16 abf;
    const abf* Qp = (const abf*)(F.ws + WS_QP); const abf* Kp = (const abf*)(F.ws + WS_KP); const abf* Vp = (const abf*)(F.ws + WS_VP); abf* og = (abf*)(F.ws + WS_OGD);
    float gq = fabsf(INP(I_GA_QN)[l * 64 + F.lane]), gk = fabsf(INP(I_GA_KN)[l * 64 + F.lane]);
#pragma unroll
    for (int o = 1; o < 64; o <<= 1) { gq = fmaxf(gq, __shfl_xor(gq, o)); gk = fmaxf(gk, __shfl_xor(gk, o)); }
    const float mshift = 64.0f * C2 * gq * gk;
    for (int i = 0; ; ++i) {
        int b, hq, qb;
        if (F.G == 256) { if (i >= 4) break; const int x = F.bid & 7, ul = (F.bid >> 3) * 4 + i; b = x >> 2; hq = ((x >> 1) & 1) * 4 + (x & 1) * 2 + (ul >> 6); qb = ul & 63; }
        else { const int u = F.bid + i * F.G; if (u >= 1024) break; b = u >> 9; hq = (u >> 6) & 7; qb = u & 63; }
        const int kh = hq >> 2;
        attn_body::attn_unit<8, 512, 128, 128, 512, true>(qb * 256, SEQ / 64, Qp + (size_t)b * SEQ * 512 + hq * 64, Kp + (size_t)b * SEQ * 128 + kh * 64,
                                                     Vp + (size_t)b * SEQ * 128 + kh * 64, og + (size_t)b * SEQ * 512 + hq * 64, (char*)F.lds, mshift);
    }
}
__device__ __forceinline__ void ph_at_swa(Frame& F, int l, int u_lo, int u_hi) {
    const bf16* proj = (const bf16*)(F.ws + WS_P); const bf16* VtC = (const bf16*)(F.ws + WS_VTC); bf16* og = (bf16*)(F.ws + WS_OGC);
    for (int u = u_lo + F.bid; u < u_hi; u += F.G) {
        const int b = u >> 9, hq = (u >> 6) & 7, qt = u & 63, kh = hq >> 2;
        const float slope = exp2f(-(float)(hq + 1)); const float sink = INP(I_SWA_SINK)[l * 8 + hq];
        attn_wave<true>(proj + (size_t)b * SEQ * DINP + C_CQ + hq * 64, DINP, proj + (size_t)b * SEQ * DINP + C_CKV + kh * 64, DINP, VtC + (size_t)(b * 2 + kh) * 64 * SEQ,
                        og + (size_t)b * SEQ * 512 + hq * 64, qt * 256 + F.wave * 32, F.lane, slope * LOG2E, sink * LOG2E, C2);
    }
}
__device__ __forceinline__ void ph_at_fin(Frame& F, int l) {
    const int gw = F.bid * NWAVES + F.wave, NGW = F.G * NWAVES, lane = F.lane;
    bf16* y = (bf16*)(F.ws + WS_Y);
    const float* gnc = INP(I_SWA_NORM) + l * 512 + lane * 8; const float* gnd = INP(I_GA_NORM) + l * 512 + lane * 8;
    const f32x4 gc0 = *(const f32x4*)gnc, gc1 = *(const f32x4*)(gnc + 4), gd0 = *(const f32x4*)gnd, gd1 = *(const f32x4*)(gnd + 4);
    for (int m0 = gw * 2; m0 < T; m0 += NGW * 2) {
        v4u w[4];
#pragma unroll
        for (int k = 0; k < 4; ++k) w[k] = *(const v4u*)((const bf16*)(F.ws + ((k & 1) ? WS_OGD : WS_OGC)) + (size_t)(m0 + (k >> 1)) * 512 + lane * 8);
#pragma unroll
        for (int k = 0; k < 4; ++k) { const int grp = k & 1, m = m0 + (k >> 1);
            float v[8] = {bflo(w[k].x), bfhi(w[k].x), bflo(w[k].y), bfhi(w[k].y), bflo(w[k].z), bfhi(w[k].z), bflo(w[k].w), bfhi(w[k].w)};
            float ss = 0.f;
#pragma unroll
            for (int i = 0; i < 8; ++i) ss += v[i] * v[i];
            const float r = 1.0f / sqrtf(wave_sum(ss) * (1.0f / 512.0f) + EPS);
            const f32x4 g0 = grp ? gd0 : gc0, g1 = grp ? gd1 : gc1;
            v4u o; o.x = pk2(v[0] * r * g0.x, v[1] * r * g0.y); o.y = pk2(v[2] * r * g0.z, v[3] * r * g0.w); o.z = pk2(v[4] * r * g1.x, v[5] * r * g1.y); o.w = pk2(v[6] * r * g1.z, v[7] * r * g1.w);
            NTST((v4u*)(y + (size_t)m * D + 1024 + grp * 512 + lane * 8), o); }
    }
}

__device__ __forceinline__ void ph_moe_route(Frame& F, int l) {
    LAS float* scr = (LAS float*)(F.lds + F.wave * 16640);
    const int gw = F.bid * NWAVES + F.wave, NGW = F.G * NWAVES, lane = F.lane;
    constexpr int IT_G = (D / 64) * (DE / 64), IT_D = (DE / 64) * (D / 64);
    for (int it = gw; it < NE * (2 * IT_G + IT_D); it += NGW) {
        const int e = it / (2 * IT_G + IT_D); int r = it % (2 * IT_G + IT_D);
        if (r < 2 * IT_G) { const int up = r / IT_G; r %= IT_G; const int nblk = DE / 64, kb = r / nblk, nb = r % nblk, j0 = nb * 64;
            const float* W = (up ? INP(I_MOE_UP) : INP(I_MOE_GATE)) + ((size_t)l * NE + e) * D * DE;
            transpose_tile64(W, DE, kb * 64, j0, (bf16*)(F.ws + WS_GUT) + (size_t)e * 1024 * D, D, (j0 >> 7) * 256 + up * 128 + (j0 & 127), scr, lane); }
        else { r -= 2 * IT_G; const int nblk = D / 64, kb = r / nblk, nb = r % nblk;
            const float* W = INP(I_MOE_DOWN) + ((size_t)l * NE + e) * DE * D;
            transpose_tile64(W, D, kb * 64, nb * 64, (bf16*)(F.ws + WS_DT) + (size_t)e * D * DE, DE, nb * 64, scr, lane); }
    }
    const float* x = F.out; const float* g = INP(I_NORM_FFN) + (size_t)l * D;
    const float* wg = (const float*)(F.ws + WS_WRT) + (size_t)l * D * 64;
    bf16* xn = (bf16*)(F.ws + WS_XN); int* info = (int*)(F.ws + WS_INFO); int* elist = (int*)(F.ws + WS_ELIST);
    unsigned* cnt = (unsigned*)(F.ctl + CW_CNT + l * 64);
    LAS float* red = (LAS float*)F.lds;
    LAS float* part = (LAS float*)(F.lds + 36864);
    LAS float* fin = (LAS float*)(F.lds + 36864 + 1024);
    LAS float* rsd = (LAS float*)(F.lds + 36864 + 1024 + 4736);
    const int wave = F.wave, i32 = lane & 31, kk = lane >> 5;
    __syncthreads();
    for (int tile = F.bid; tile < T / 32; tile += F.G) {
        const int t0 = tile * 32;
        const float* xp = x + (size_t)(t0 + i32) * D + 256 * wave + 4 * kk;
        f32x4 x4[32]; float ss = 0.f;
#pragma unroll
        for (int m = 0; m < 32; ++m) x4[m] = *(const f32x4*)(xp + 8 * m);
        f32x16 acc0 = {0}, acc1 = {0};
        const float* wp = wg + (size_t)(256 * wave + 4 * kk) * 64 + i32;
        float bq[5][8];
        const float* wpm = wp;
#define RT_LOADB(slot_) do { _Pragma("unroll") for (int s = 0; s < 4; ++s) { bq[slot_][2 * s] = wpm[s * 64]; bq[slot_][2 * s + 1] = wpm[s * 64 + 32]; } wpm += 8 * 64; asm volatile("" : "+v"(wpm)); } while (0)
        RT_LOADB(0); RT_LOADB(1); RT_LOADB(2); RT_LOADB(3);
#pragma unroll
        for (int m = 0; m < 32; ++m) {
            if (m + 4 < 32) RT_LOADB((m + 4) % 5);
            __builtin_amdgcn_sched_barrier(0);
            ss += (x4[m].x * x4[m].x + x4[m].y * x4[m].y) + (x4[m].z * x4[m].z + x4[m].w * x4[m].w);
#pragma unroll
            for (int s = 0; s < 4; ++s) { acc0 = __builtin_amdgcn_mfma_f32_32x32x2f32(x4[m][s], bq[m % 5][2 * s], acc0, 0, 0, 0); acc1 = __builtin_amdgcn_mfma_f32_32x32x2f32(x4[m][s], bq[m % 5][2 * s + 1], acc1, 0, 0, 0); }
            __builtin_amdgcn_sched_barrier(0);
        }
#undef RT_LOADB
        ss += __shfl_xor(ss, 32);
        if (kk == 0) part[wave * 32 + i32] = ss;
#pragma unroll
        for (int rg = 0; rg < 16; ++rg) { const int row = crow(rg, kk); red[(wave * 32 + row) * 36 + i32] = acc0[rg]; if (i32 < 4) red[(wave * 32 + row) * 36 + 32 + i32] = acc1[rg]; }
        __syncthreads();
        for (int e_ = F.tid; e_ < 32 * 36; e_ += NTHR) { const int row = e_ / 36, col = e_ % 36; float a = 0.f;
#pragma unroll
            for (int w = 0; w < 8; ++w) a += red[(w * 32 + row) * 36 + col];
            fin[row * 37 + col] = a; }
        if (F.tid < 32) { float a = 0.f;
#pragma unroll
            for (int w = 0; w < 8; ++w) a += part[w * 32 + F.tid];
            rsd[F.tid] = 1.0f / sqrtf(a * (1.0f / D) + EPS); }
        __syncthreads();
        if (F.tid < 32) {
            const int m = t0 + F.tid; const float rstd = rsd[F.tid]; const LAS float* lg = fin + F.tid * 37;
            float gl[4];
#pragma unroll
            for (int q = 0; q < 4; ++q) gl[q] = lg[32 + q] * rstd + INP(I_MOE_BG)[l * 4 + q];
            int gi = 0; float gmax = gl[0];
#pragma unroll
            for (int q = 1; q < 4; ++q) if (gl[q] > gmax) { gmax = gl[q]; gi = q; }
            float gsum = 0.f;
#pragma unroll
            for (int q = 0; q < 4; ++q) gsum += expf(gl[q] - gmax);
            const float g_w = 1.0f / gsum;
            float el[8];
#pragma unroll
            for (int q = 0; q < 8; ++q) el[q] = lg[gi * 8 + q] * rstd + INP(I_MOE_BE)[l * 32 + gi * 8 + q];
            int i1 = 0; float v1 = el[0];
#pragma unroll
            for (int q = 1; q < 8; ++q) if (el[q] > v1) { v1 = el[q]; i1 = q; }
            int i2 = -1; float v2 = -3.0e38f;
#pragma unroll
            for (int q = 0; q < 8; ++q) if (q != i1 && el[q] > v2) { v2 = el[q]; i2 = q; }
            const float ex = expf(v2 - v1); const float w1 = g_w / (1.0f + ex), w2 = g_w * ex / (1.0f + ex);
            const int e1 = gi * 8 + i1, e2 = gi * 8 + i2;
            const unsigned s1 = __hip_atomic_fetch_add(cnt + e1, 1u, RLX_AGENT), s2 = __hip_atomic_fetch_add(cnt + e2, 1u, RLX_AGENT);
            int* rec = info + (size_t)m * 8; rec[0] = e1; rec[1] = e2; rec[2] = (int)s1; rec[3] = (int)s2; rec[4] = __builtin_bit_cast(int, w1); rec[5] = __builtin_bit_cast(int, w2);
            elist[(size_t)e1 * T + s1] = m; elist[(size_t)e2 * T + s2] = m;
        }
        { const float rstd = rsd[i32]; const float* gp = g + 256 * wave + 4 * kk; LAS unsigned char* stg = F.lds + 49152 + wave * 4608;
#pragma unroll
          for (int c = 0; c < 4; ++c) {
#pragma unroll
              for (int mm = 0; mm < 8; ++mm) { const int m = 8 * c + mm; const f32x4 gv = *(const f32x4*)(gp + 8 * m); const f32x4 o = x4[m] * rstd * gv;
                  *(LAS v2u*)(stg + i32 * 144 + mm * 16 + kk * 8) = (v2u){pk2(o.x, o.y), pk2(o.z, o.w)}; }
              LDS_WAIT();
#pragma unroll
              for (int q = 0; q < 4; ++q) { const int row = 8 * q + (lane >> 3), ch = lane & 7; const v4u v = *(const LAS v4u*)(stg + row * 144 + ch * 16);
                  *(v4u*)(xn + (size_t)(t0 + row) * D + 256 * wave + 64 * c + 8 * ch) = v; }
              LDS_WAIT(); } }
        __syncthreads();
    }
}
__device__ __forceinline__ int moe_bases(const unsigned* cnt, int lane, int& padded) {
    const int c = (lane < 32) ? (int)__hip_atomic_load(cnt + (lane & 31), RLX_AGENT) : 0;
    padded = (c + 255) & ~255;
    int incl = padded;
#pragma unroll
    for (int o = 1; o < 32; o <<= 1) { const int up = __shfl_up(incl, o); if (lane >= o) incl += up; }
    return incl - padded;
}
__device__ __forceinline__ int moe_tile_table(Frame& F, int l) {
    LAS int* tile_e = (LAS int*)(F.lds + TILE_E_OFF);
    const unsigned* cnt = (const unsigned*)(F.ctl + CW_CNT + l * 64);
    int padded; const int base = moe_bases(cnt, F.lane, padded);
    if (F.wave == 0 && F.lane < 32) { for (int ti = base >> 8; ti < ((base + padded) >> 8); ++ti) tile_e[ti] = F.lane;
        tile_e[320 + F.lane] = base >> 8; tile_e[352 + F.lane] = (int)__hip_atomic_load(cnt + F.lane, RLX_AGENT); }
    const int total = __builtin_amdgcn_readfirstlane(__shfl(base + padded, 31));
    __syncthreads();
    return total >> 8;
}
__device__ __forceinline__ void ph_combine(Frame& F, int l) {
    const int gw = F.bid * NWAVES + F.wave, NGW = F.G * NWAVES, lane = F.lane;
    const bf16* ob = (const bf16*)(F.ws + WS_P); const int* info = (const int*)(F.ws + WS_INFO);
    const bool last = (l == 1);
    const float* g = last ? INP(I_NORM_FINAL) : (INP(I_NORM_MIX) + D);
    bf16* xn = (bf16*)(F.ws + WS_XN);
    int padded_; const int base = moe_bases((const unsigned*)(F.ctl + CW_CNT + l * 64), lane, padded_);
    for (int m = gw; m < T; m += NGW) {
        const int* rec = info + (size_t)m * 8;
        const float w1 = __builtin_bit_cast(float, rec[4]), w2 = __builtin_bit_cast(float, rec[5]); const int p1 = __shfl(base, rec[0]) + rec[2], p2 = __shfl(base, rec[1]) + rec[3];
        float* xr = F.out + (size_t)m * D;
        f32x4 v[8]; float s = 0.f;
#pragma unroll
        for (int j = 0; j < 8; ++j) { v[j] = ((const f32x4*)xr)[lane + 64 * j];
            const v2u a = ((const v2u*)(ob + (size_t)p1 * D))[lane + 64 * j], c = ((const v2u*)(ob + (size_t)p2 * D))[lane + 64 * j];
            v[j].x += w1 * bflo(a.x) + w2 * bflo(c.x); v[j].y += w1 * bfhi(a.x) + w2 * bfhi(c.x); v[j].z += w1 * bflo(a.y) + w2 * bflo(c.y); v[j].w += w1 * bfhi(a.y) + w2 * bfhi(c.y);
            s += (v[j].x * v[j].x + v[j].y * v[j].y) + (v[j].z * v[j].z + v[j].w * v[j].w); }
        const float rstd = 1.0f / sqrtf(wave_sum(s) * (1.0f / D) + EPS);
#pragma unroll
        for (int j = 0; j < 8; ++j) { const f32x4 gv = ((const f32x4*)g)[lane + 64 * j];
            if (last) NTST((f32x4*)xr + lane + 64 * j, v[j] * rstd * gv);
            else { NTST((f32x4*)xr + lane + 64 * j, v[j]); const f32x4 o = v[j] * rstd * gv; v2u w; w.x = pk2(o.x, o.y); w.y = pk2(o.z, o.w); ((v2u*)(xn + (size_t)m * D))[lane + 64 * j] = w; } }
    }
}

constexpr int NPH = 11;
constexpr int N_PHASES = 1 + 2 * NPH;
struct Args { const float* in[N_INPUTS]; float* out; unsigned char* ws; int ph_lo, ph_hi, use_bar, pad; };

#define PH_BEGIN() do { \
        const CAS cfp* ip_ = (const CAS cfp*)__builtin_amdgcn_kernarg_segment_ptr(); asm volatile("" : "+s"(ip_)); F.in = ip_; \
        size_t zo_ = 0; asm volatile("" : "+s"(zo_));     \
        F.ws = args.ws + zo_; F.ctl = (gu32*)(args.ws + zo_); F.out = args.out + zo_; \
        int t_ = threadIdx.x; asm volatile("" : "+v"(t_)); F.tid = t_; F.lane = t_ & 63; F.wave = __builtin_amdgcn_readfirstlane(t_ >> 6); \
        int b_ = blockIdx.x; asm volatile("" : "+s"(b_)); F.bid = b_; int g_ = gridDim.x; asm volatile("" : "+s"(g_)); F.G = g_; \
    } while (0)
#ifndef SWA_EARLY
#define SWA_EARLY 768
#endif
#ifndef PH_MASK
#define PH_MASK 0xFFFFFFFFu
#endif
#define IN(k) (lo <= (k) && (k) < hi)
#define INL(j) (IN(pb + (j)) && ((PH_MASK >> (1 + (j))) & 1u))
#define SEAM(k) do { if (IN(k) && IN((k) + 1)) { XcdBarrier b2_ = bar; asm volatile("" : "+s"(b2_.bar)); xcd_barrier(b2_); } } while (0)

__device__ __forceinline__ void group_barrier(unsigned* ctr, unsigned target) {
    asm volatile("s_waitcnt vmcnt(0)" ::: "memory");
    __syncthreads();
    if (threadIdx.x == 0) {
        __builtin_amdgcn_fence(__ATOMIC_RELEASE, "agent");
        asm volatile("s_waitcnt vmcnt(0)" ::: "memory");
        (void)xb_add(ctr, 1u);
        unsigned sp = 0u; while (xb_ld(ctr) < target) { __builtin_amdgcn_s_sleep(1); if (++sp > (1u << 22)) break; }
        __builtin_amdgcn_fence(__ATOMIC_ACQUIRE, "agent");
        asm volatile("s_waitcnt vmcnt(0)" ::: "memory");
    }
    __syncthreads();
}
__device__ __forceinline__ void run_layer(Frame& F, const Args& args, const XcdBarrier& bar, const int lo, const int hi, const int l) {
    const int pb = 1 + l * NPH;
    if (INL(0)) { PH_BEGIN();
        { pg8::Gemm g{(const bf16*)(F.ws + WS_XN), (const bf16*)(F.ws + WS_WIN + l * WIN_BYTES), T, DIN_FULL, D}; pg8::StaticOrder S; S.init(T, DIN_FULL, F.G, F.bid);
          pg8::EpiBf16L E{(bf16*)(F.ws + WS_P), DINP};
          pg8::gemm_phase<pg8::EpiBf16L, pg8::StaticOrder, true, true>(F.lds, g, S, E); }
        __syncthreads(); PH_BEGIN(); ph_in_rem(F, l);
    } SEAM(pb + 0);
    if (INL(1)) { PH_BEGIN(); ph_gdn_prep(F, l); } SEAM(pb + 1);
    if (INL(2)) {
        PH_BEGIN();
        const bool split = F.G > N_SCAN_WG;
        if (!split || F.bid < N_SCAN_WG) ph_gdn_scan(F);
        if (!split || F.bid >= N_SCAN_WG) {
            __syncthreads(); PH_BEGIN();
            if (split) { F.bid -= N_SCAN_WG; F.G -= N_SCAN_WG; }
            ph_hy_expand(F, l); ph_hy_tin(F, l); __syncthreads(); PH_BEGIN(); if (split) { F.bid -= N_SCAN_WG; F.G -= N_SCAN_WG; } ph_at_prep(F, l);
            if (args.use_bar) { const unsigned npart = (unsigned)(split ? gridDim.x - N_SCAN_WG : gridDim.x); group_barrier((unsigned*)(F.ctl + CW_SUB), npart * (unsigned)(l + 1)); }
            PH_BEGIN(); if (split) { F.bid -= N_SCAN_WG; F.G -= N_SCAN_WG; } ph_at_swa(F, l, 0, SWA_EARLY);
        }
    } SEAM(pb + 2);
    if (INL(3)) { PH_BEGIN(); ph_hy_fft(F, l); } SEAM(pb + 3);
    if (INL(4)) { PH_BEGIN(); ph_at_global(F, l); __syncthreads(); PH_BEGIN(); ph_at_swa(F, l, SWA_EARLY, 1024); } SEAM(pb + 4);
    if (INL(5)) { PH_BEGIN(); ph_gdn_fin(F, l); ph_hy_fin(F, l); __syncthreads(); PH_BEGIN(); ph_at_fin(F, l); } SEAM(pb + 5);
    if (INL(6)) { PH_BEGIN();
        pg8::Gemm g{(const bf16*)(F.ws + WS_Y), (const bf16*)(F.ws + WS_WOUT + l * WOUT_BYTES), T, D, D}; pg8::StaticOrder S; S.init(T, D, F.G, F.bid);
        pg8::EpiResF32 E{(l == 0) ? INP(I_X) : (const float*)F.out, F.out, D};
        pg8::gemm_phase<pg8::EpiResF32, pg8::StaticOrder, true, true>(F.lds, g, S, E);
    } SEAM(pb + 6);
    if (INL(7)) { PH_BEGIN(); ph_moe_route(F, l); } SEAM(pb + 7);
    if (INL(8)) { PH_BEGIN();
        const int ntiles = moe_tile_table(F, l);
        pg8::Gemm g{(const bf16*)(F.ws + WS_XN), (const bf16*)(F.ws + WS_GUT), MOE_ROWS, 1024, D};
        const LAS int* tt = (const LAS int*)(F.lds + TILE_E_OFF);
        pg8::MoeGatherOrder<4, T, (unsigned)(D * 2)> S{tt, tt + 320, tt + 352, (const int*)(F.ws + WS_ELIST), ntiles, F.G, F.bid};
        pg8::EpiSwiGLU E{(bf16*)(F.ws + WS_MOE_H), DE};
        pg8::gemm_phase<pg8::EpiSwiGLU, pg8::MoeGatherOrder<4, T, (unsigned)(D * 2)>, true, true>(F.lds, g, S, E);
    } SEAM(pb + 8);
    if (INL(9)) { PH_BEGIN();
        const int ntiles = moe_tile_table(F, l);
        pg8::Gemm g{(const bf16*)(F.ws + WS_MOE_H), (const bf16*)(F.ws + WS_DT), MOE_ROWS, D, DE};
        pg8::MoeOrder<8> S{(const LAS int*)(F.lds + TILE_E_OFF), ntiles, F.G, F.bid};
        pg8::EpiBf16L E{(bf16*)(F.ws + WS_P), D};
        pg8::gemm_phase<pg8::EpiBf16L, pg8::MoeOrder<8>, false, true>(F.lds, g, S, E);
    } SEAM(pb + 9);
    if (INL(10)) { PH_BEGIN(); ph_combine(F, l); }
    if (l == 0) SEAM(pb + 10);
}

__global__ void __launch_bounds__(NTHR, 2) mk_fwd(Args args) {
    extern __shared__ __attribute__((aligned(16))) unsigned char lds[];
    Frame F;
    F.lds = (LAS unsigned char*)lds;
    F.MISC = (volatile LAS unsigned*)(F.lds + MISC_OFF);
    F.tid = threadIdx.x; F.lane = F.tid & 63; F.wave = __builtin_amdgcn_readfirstlane(F.tid >> 6);
    F.G = gridDim.x; F.bid = blockIdx.x;
    PH_BEGIN();
    for (int u = F.tid; u < (LDS_BYTES - MISC_OFF) / 4; u += NTHR) ((LAS unsigned*)(F.lds + MISC_OFF))[u] = 0u;
    __syncthreads();
    XcdBarrier bar; bar.bar = (unsigned*)(F.ctl + CW_BAR); bar.x = 0; bar.st = nullptr;
    if (args.use_bar) bar = xcd_barrier_post((unsigned*)(F.ctl + CW_BAR), F.MISC + 8);
    const int lo = args.ph_lo, hi = args.ph_hi;

    if (IN(0) && (PH_MASK & 1u)) { PH_BEGIN(); ph_prologue(F);
#pragma nounroll
        for (int l2 = 0; l2 < 2; ++l2) { asm volatile("" : "+s"(l2)); __syncthreads(); PH_BEGIN(); ph_hy_mlp(F, l2); } }
    SEAM(0);

#pragma nounroll
    for (int l = 0; l < 2; ++l) { asm volatile("" : "+s"(l)); run_layer(F, args, bar, lo, hi, l); }
}
#undef IN
#undef INL
#undef SEAM

#ifndef MK_ONE_LAUNCH
#define MK_ONE_LAUNCH 1
#endif
extern "C" void kernel_launch(void* const* d_in, const int* in_sizes, int n_in, void* d_out, int out_size, void* d_ws, size_t ws_size, hipStream_t stream) {
    static int grid = 0;
    if (grid == 0) {
        if (n_in != N_INPUTS || out_size != T * D || ws_size < WS_END) { fprintf(stderr, "kernel_launch: unexpected shapes (n_in %d out %d ws %zu)\n", n_in, out_size, ws_size); grid = -1; return; }
        if (hipFuncSetAttribute((const void*)mk_fwd, hipFuncAttributeMaxDynamicSharedMemorySize, LDS_BYTES) != hipSuccess) { fprintf(stderr, "kernel_launch: hipFuncSetAttribute failed\n"); grid = -1; return; }
        int dev = 0, cus = 0, per_cu = 0;
        hipGetDevice(&dev); hipDeviceGetAttribute(&cus, hipDeviceAttributeMultiprocessorCount, dev);
        hipOccupancyMaxActiveBlocksPerMultiprocessor(&per_cu, (const void*)mk_fwd, NTHR, LDS_BYTES);
        (void)hipGetLastError();
        grid = (cus >= 256) ? 256 : cus;
        if (per_cu < 1) fprintf(stderr, "kernel_launch: occupancy query reports %d\n", per_cu);
    }
    if (grid < 0) return;
    hipMemsetAsync((char*)d_ws + WS_CTL, 0, CTL_ZERO_BYTES, stream);
    Args a{};
    for (int i = 0; i < N_INPUTS; ++i) a.in[i] = (const float*)d_in[i];
    a.out = (float*)d_out; a.ws = (unsigned char*)d_ws; a.pad = 0;
#if MK_ONE_LAUNCH
    a.ph_lo = 0; a.ph_hi = N_PHASES; a.use_bar = 1;
    hipLaunchKernelGGL(mk_fwd, dim3(grid), dim3(NTHR), LDS_BYTES, stream, a);
#else
    for (int p = 0; p < N_PHASES; ++p) { a.ph_lo = p; a.ph_hi = p + 1; a.use_bar = 0; hipLaunchKernelGGL(mk_fwd, dim3(grid), dim3(NTHR), LDS_BYTES, stream, a); }
#endif
}
```
